# Optimizing an MI355X kernel written in HIP

```python
import jax, jax.numpy as jnp
from jax import lax
import numpy as np

D_MODEL = 1024
BATCH = 4
SEQ = 4096
DEPTH = 1

HEAD_DIM = 64
N_META = 16
BLOCK = 128
PAD = BLOCK - N_META
FOX_HEADS = 8
SWA_HEADS = 8
SWA_KV_HEADS = 2
WINDOW = 128
N_EXPERTS = 32
TOP_K = 4
D_FF = 1024
SWIGLU_LIMIT = 7.0
SWIGLU_ALPHA = 1.702
RMS_EPS = 1e-6
NEG_INF = -1e30
MOE_BLOCK = 128

FOX_W = FOX_HEADS * HEAD_DIM
SWA_QW = SWA_HEADS * HEAD_DIM
SWA_KW = SWA_KV_HEADS * HEAD_DIM
SPLITS = [FOX_W, FOX_W, FOX_W, FOX_HEADS, SWA_QW, SWA_KW, SWA_KW, D_MODEL, D_MODEL]
IN_WIDTH = 3 * FOX_W + FOX_HEADS + SWA_QW + 2 * SWA_KW + 2 * D_MODEL

kernel_name = "hybrid_fox_swa_sink_moe_block"


def _rmsnorm(t, gain):
    tf = t.astype(jnp.float32)
    y = tf * lax.rsqrt(jnp.mean(tf * tf, axis=-1, keepdims=True) + RMS_EPS)
    return (y * gain.astype(jnp.float32)).astype(t.dtype)


def _pad_front(t):
    return jnp.pad(t, ((0, 0), (PAD, 0)) + ((0, 0),) * (t.ndim - 2))


def _fox_attention(q, k, v, log_f):
    B, Lp, H, d = q.shape
    nb = Lp // BLOCK
    F = jnp.cumsum(log_f, axis=1)
    FT = F.transpose(0, 2, 1)
    pos = jnp.arange(Lp)
    key_ok = pos >= PAD
    qb = q.reshape(B, nb, BLOCK, H, d).transpose(1, 0, 2, 3, 4)
    Fb = F.reshape(B, nb, BLOCK, H).transpose(1, 0, 3, 2)
    scale = HEAD_DIM ** -0.5

    def one_block(args):
        qi, Fi, i = args
        s = jnp.einsum('bqhd,bkhd->bhqk', qi, k, preferred_element_type=jnp.float32) * scale
        s = s + Fi[..., :, None] - FT[:, :, None, :]
        qpos = i * BLOCK + jnp.arange(BLOCK)
        mask = (pos[None, :] <= qpos[:, None]) & key_ok[None, :]
        s = jnp.where(mask[None, None], s, NEG_INF)
        p = jax.nn.softmax(s, axis=-1)
        return jnp.einsum('bhqk,bkhd->bqhd', p.astype(v.dtype), v)

    out = lax.map(one_block, (qb, Fb, jnp.arange(nb)))
    return out.transpose(1, 0, 2, 3, 4).reshape(B, Lp, H, d)


def _swa_attention(q, k, v, sinks, slopes):
    B, Lp, H, d = q.shape
    G = k.shape[2]
    R = H // G
    nb = Lp // BLOCK
    qb = q.reshape(B, nb, BLOCK, G, R, d)

    def with_prev(t):
        tb = t.reshape(B, nb, BLOCK, G, d)
        prev = jnp.pad(tb[:, :-1], ((0, 0), (1, 0), (0, 0), (0, 0), (0, 0)))
        return jnp.concatenate([prev, tb], axis=2)

    kk, vv = with_prev(k), with_prev(v)
    s = jnp.einsum('bnqgrd,bnkgd->bngrqk', qb, kk, preferred_element_type=jnp.float32) * (HEAD_DIM ** -0.5)
    blk = jnp.arange(nb)[:, None]
    qpos = blk * BLOCK + jnp.arange(BLOCK)[None, :]
    kpos = blk * BLOCK - BLOCK + jnp.arange(2 * BLOCK)[None, :]
    dist = qpos[:, :, None] - kpos[:, None, :]
    mask = (dist >= 0) & (dist < WINDOW) & (kpos[:, None, :] >= PAD)
    s = s - slopes.reshape(G, R)[None, None, :, :, None, None] * dist.astype(jnp.float32)[None, :, None, None]
    s = jnp.where(mask[None, :, None, None], s, NEG_INF)
    sink = jnp.broadcast_to(sinks.astype(jnp.float32).reshape(G, R)[None, None, :, :, None, None], s.shape[:-1] + (1,))
    p = jax.nn.softmax(jnp.concatenate([s, sink], axis=-1), axis=-1)[..., :-1]
    o = jnp.einsum('bngrqk,bnkgd->bnqgrd', p.astype(v.dtype), vv)
    return o.reshape(B, Lp, H, d)


def _moe(h, w_router, b_router, w_up, b_up, w_down, b_down):
    N, D = h.shape
    logits = jnp.matmul(h, w_router).astype(jnp.float32) + b_router.astype(jnp.float32)
    top_val, top_idx = lax.top_k(logits, TOP_K)
    gates = jax.nn.softmax(top_val, axis=-1)
    n_assign = N * TOP_K
    flat_e = top_idx.reshape(-1)
    flat_tok = jnp.arange(n_assign) // TOP_K
    order = jnp.argsort(flat_e)
    se, stok, sw = flat_e[order], flat_tok[order], gates.reshape(-1)[order]
    counts = jnp.bincount(flat_e, length=N_EXPERTS)
    padded = (counts + MOE_BLOCK - 1) // MOE_BLOCK * MOE_BLOCK
    pend = jnp.cumsum(padded)
    pstart = pend - padded
    start = jnp.cumsum(counts) - counts
    dest = pstart[se] + jnp.arange(n_assign) - start[se]
    n_blocks = -(-n_assign // MOE_BLOCK) + N_EXPERTS
    n_rows = n_blocks * MOE_BLOCK
    row_tok = jnp.zeros((n_rows,), jnp.int32).at[dest].set(stok)
    row_w = jnp.zeros((n_rows,), jnp.float32).at[dest].set(sw)
    block_e = jnp.minimum(jnp.searchsorted(pend, jnp.arange(n_blocks) * MOE_BLOCK, side='right'), N_EXPERTS - 1)
    xs = h[row_tok].reshape(n_blocks, MOE_BLOCK, D)

    def expert_block(args):
        xb, e = args
        gu = jnp.matmul(xb, w_up[e]) + b_up[e]
        g, u = gu[:, :D_FF], gu[:, D_FF:]
        g = jnp.minimum(g, SWIGLU_LIMIT)
        u = jnp.clip(u, -SWIGLU_LIMIT, SWIGLU_LIMIT)
        act = (u + 1.0) * (g * jax.nn.sigmoid(SWIGLU_ALPHA * g))
        return jnp.matmul(act, w_down[e]) + b_down[e]

    ys = lax.map(expert_block, (xs, block_e)).reshape(n_rows, D)
    return jnp.zeros_like(h).at[row_tok].add(ys * row_w[:, None].astype(ys.dtype))


def setup_inputs(seed: int = 0) -> dict:
    key = jax.random.key(seed)
    ks = jax.random.split(key, 20)
    f32 = jnp.float32
    nrm = lambda k, shape, scale: jax.random.normal(k, shape, f32) * scale
    return {
        "x": nrm(ks[0], (BATCH, SEQ, D_MODEL), 1.0),
        "meta_tokens": nrm(ks[1], (N_META, D_MODEL), 1.0),
        "norm1_gain": 1.0 + nrm(ks[2], (DEPTH, D_MODEL), 0.02),
        "w_in": nrm(ks[3], (DEPTH, D_MODEL, IN_WIDTH), D_MODEL ** -0.5),
        "b_forget": jax.random.uniform(ks[4], (DEPTH, FOX_HEADS), f32, 1.0, 4.0),
        "fox_q_gain": 1.0 + nrm(ks[5], (DEPTH, HEAD_DIM), 0.02),
        "fox_k_gain": 1.0 + nrm(ks[6], (DEPTH, HEAD_DIM), 0.02),
        "swa_q_gain": 1.0 + nrm(ks[7], (DEPTH, HEAD_DIM), 0.02),
        "swa_k_gain": 1.0 + nrm(ks[8], (DEPTH, HEAD_DIM), 0.02),
        "swa_sinks": nrm(ks[9], (DEPTH, SWA_HEADS), 0.5),
        "w_fox_out": nrm(ks[10], (DEPTH, FOX_W, D_MODEL), FOX_W ** -0.5),
        "w_swa_out": nrm(ks[11], (DEPTH, SWA_QW, D_MODEL), SWA_QW ** -0.5),
        "w_out": nrm(ks[12], (DEPTH, D_MODEL, D_MODEL), D_MODEL ** -0.5),
        "norm2_gain": 1.0 + nrm(ks[13], (DEPTH, D_MODEL), 0.02),
        "w_router": nrm(ks[14], (DEPTH, D_MODEL, N_EXPERTS), D_MODEL ** -0.5),
        "b_router": nrm(ks[15], (DEPTH, N_EXPERTS), 0.01),
        "w_up": nrm(ks[16], (DEPTH, N_EXPERTS, D_MODEL, 2 * D_FF), D_MODEL ** -0.5),
        "b_up": nrm(ks[17], (DEPTH, N_EXPERTS, 2 * D_FF), 0.01),
        "w_down": nrm(ks[18], (DEPTH, N_EXPERTS, D_FF, D_MODEL), D_FF ** -0.5),
        "b_down": nrm(ks[19], (DEPTH, N_EXPERTS, D_MODEL), 0.01),
    }


def reference(x, meta_tokens, norm1_gain, w_in, b_forget, fox_q_gain, fox_k_gain, swa_q_gain, swa_k_gain, swa_sinks, w_fox_out, w_swa_out, w_out, norm2_gain, w_router, b_router, w_up, b_up, w_down, b_down):
    B = x.shape[0]
    meta = jnp.broadcast_to(meta_tokens[None].astype(x.dtype), (B, N_META, D_MODEL))
    hres = jnp.concatenate([meta, x], axis=1)
    L = hres.shape[1]
    slopes = jnp.exp2(-8.0 * (jnp.arange(SWA_HEADS, dtype=jnp.float32) + 1.0) / SWA_HEADS)
    cuts = np.cumsum(SPLITS)[:-1].tolist()

    def head_rms(t, n_heads, gain):
        return _rmsnorm(t.reshape(B, L, n_heads, HEAD_DIM), gain)

    for l in range(DEPTH):
        h = _rmsnorm(hres, norm1_gain[l])
        proj = jnp.matmul(h, w_in[l])
        fq, fk, fv, flog, sq, sk, sv, ga, gb = jnp.split(proj, cuts, axis=-1)
        fq = head_rms(fq, FOX_HEADS, fox_q_gain[l])
        fk = head_rms(fk, FOX_HEADS, fox_k_gain[l])
        fv = fv.reshape(B, L, FOX_HEADS, HEAD_DIM)
        log_f = jax.nn.log_sigmoid(flog.astype(jnp.float32) + b_forget[l].astype(jnp.float32))
        sq = head_rms(sq, SWA_HEADS, swa_q_gain[l])
        sk = head_rms(sk, SWA_KV_HEADS, swa_k_gain[l])
        sv = sv.reshape(B, L, SWA_KV_HEADS, HEAD_DIM)

        o_a = _fox_attention(_pad_front(fq), _pad_front(fk), _pad_front(fv), _pad_front(log_f))
        o_a = o_a[:, PAD:].reshape(B, L, FOX_W)
        o_b = _swa_attention(_pad_front(sq), _pad_front(sk), _pad_front(sv), swa_sinks[l], slopes)
        o_b = o_b[:, PAD:].reshape(B, L, SWA_QW)

        mix = jax.nn.sigmoid(ga) * jnp.matmul(o_a, w_fox_out[l]) + jax.nn.sigmoid(gb) * jnp.matmul(o_b, w_swa_out[l])
        hres = hres + jnp.matmul(mix, w_out[l])

        h2 = _rmsnorm(hres, norm2_gain[l]).reshape(B * L, D_MODEL)
        hres = hres + _moe(h2, w_router[l], b_router[l], w_up[l], b_up[l], w_down[l], b_down[l]).reshape(B, L, D_MODEL)

    return hres[:, N_META:]
```

```cpp
#include <hip/hip_runtime.h>
#include <cstdio>
#include <cstdint>

#define GAS __attribute__((address_space(1)))
#define LAS __attribute__((address_space(3)))
typedef unsigned short bf16_t;
typedef short bf16x8 __attribute__((ext_vector_type(8)));
typedef float f32x4 __attribute__((ext_vector_type(4)));
typedef float f32x2 __attribute__((ext_vector_type(2)));
typedef unsigned u32x4 __attribute__((ext_vector_type(4)));
typedef unsigned u32x2 __attribute__((ext_vector_type(2)));
typedef GAS unsigned gu32;
typedef int i32x4 __attribute__((ext_vector_type(4)));
typedef int i32x8 __attribute__((ext_vector_type(8)));
#define RLX_AGENT __ATOMIC_RELAXED, __HIP_MEMORY_SCOPE_AGENT
#define LDS_WAIT() asm volatile("s_waitcnt lgkmcnt(0)" ::: "memory")
#define VM_WAIT() asm volatile("s_waitcnt vmcnt(0)" ::: "memory")

constexpr int NB = 4, SEQ = 4096, DM = 1024, NTOK = NB * SEQ, NMETA = 16, MROWS = 16640, LP = 4224;
constexpr int HD = 64, NE = 32, INW = 4360, NPHYS = 4352;
constexpr int MAXTILES = 288, MAXROWS = MAXTILES * 256, ECAP = 16384;
constexpr float RMS_EPS = 1e-6f, LOG2E = 1.4426950408889634f, C2 = 0.125f * LOG2E, BIGB = 1e30f;
constexpr int NWAVES = 8;
constexpr float SC_W = 256.f, SC_H = 16.f, SC_A = 4.f, SC_Y = 64.f;

constexpr size_t MiB = 1u << 20;
constexpr size_t WS_CTL = 0, CTL_ZERO_BYTES = 1 * MiB;
constexpr size_t WS_WIN = 2 * MiB, WS_WFO = 11 * MiB, WS_WSO = 12 * MiB, WS_WOUT = 13 * MiB, WS_WUP = 16 * MiB, WS_WDN = 144 * MiB;
constexpr size_t WS_XN = 208 * MiB, WS_LOGF = 241 * MiB, WS_FB = 242 * MiB, WS_SBIAS = 243 * MiB;
constexpr size_t WS_FQ = 244 * MiB, WS_FK = 260 * MiB, WS_FV = 277 * MiB, WS_SQ = 294 * MiB, WS_SK = 310 * MiB, WS_SV = 315 * MiB;
constexpr size_t WS_GA = 320 * MiB, WS_GB = 352 * MiB, WS_OA = 384 * MiB, WS_OB = 400 * MiB, WS_MIX = 416 * MiB, WS_HRES = 448 * MiB, WS_H2 = 512 * MiB;
constexpr size_t WS_TOKDEST = 544 * MiB, WS_ROWTOK = 545 * MiB, WS_ROWW = 547 * MiB, WS_ACT = 550 * MiB, WS_YS = 694 * MiB, WS_END = 838 * MiB;
constexpr int CW_TMO = 0, CW_CODE = 1, CW_BAR = 4096, CW_CNT = 8192, CW_QUEUE = 12288;

constexpr int RING_OFF = 0, RING_BYTES = 131072;
constexpr int ROWS_OFF = RING_BYTES;
constexpr int ROWS_BYTES = 10 * 1024;
constexpr int LDSCTL_OFF = ROWS_OFF + ROWS_BYTES;
constexpr int MISC_OFF = LDSCTL_OFF;
constexpr int TAB_OFF = MISC_OFF + 256;
constexpr int UTAB_OFF = TAB_OFF + 1024;
constexpr int LDS_BYTES = 147456;
static_assert(UTAB_OFF + 256 <= LDS_BYTES, "LDS map");

__device__ __forceinline__ unsigned f2bf(float f) { unsigned u = __builtin_bit_cast(unsigned, f); return (u + 0x7fffu + ((u >> 16) & 1u)) >> 16; }
__device__ __forceinline__ unsigned pk2(float lo, float hi) { return f2bf(lo) | (f2bf(hi) << 16); }
__device__ __forceinline__ float bf2f(unsigned short b) { return __builtin_bit_cast(float, (unsigned)b << 16); }
__device__ __forceinline__ float bflo(unsigned w) { return __builtin_bit_cast(float, w << 16); }
__device__ __forceinline__ float bfhi(unsigned w) { return __builtin_bit_cast(float, w & 0xffff0000u); }
__device__ __forceinline__ float wave_sum(float v) {
#pragma unroll
    for (int o = 1; o < 64; o <<= 1) v += __shfl_xor(v, o);
    return v;
}
__device__ __forceinline__ float wave_max(float v) {
#pragma unroll
    for (int o = 1; o < 64; o <<= 1) v = fmaxf(v, __shfl_xor(v, o));
    return v;
}
__device__ __forceinline__ int fresh_tid() { int t = threadIdx.x; asm volatile("" : "+v"(t)); return t; }
__device__ __forceinline__ unsigned pk4_fp8(float a, float b, float c, float d) { int w = __builtin_amdgcn_cvt_pk_fp8_f32(a, b, 0, false); w = __builtin_amdgcn_cvt_pk_fp8_f32(c, d, w, true); return (unsigned)w; }
__device__ __forceinline__ float sigmoidf_fast(float x) { return __builtin_amdgcn_rcpf(1.f + __builtin_amdgcn_exp2f(-x * LOG2E)); }

namespace pg8 {
constexpr int BM = 256, BK = 64, HALF = 128, HTB = HALF * BK * 2, STAGE_BYTES = 8 * HTB;
__host__ __device__ __forceinline__ int lds_byte(int r, int c) { const int st = (r >> 4) * 2 + (c >> 5), rr = r & 15, cc = c & 31, ob = rr * 64 + cc * 2; return st * 1024 + (ob ^ (((ob >> 9) & 1) << 5)); }
__host__ __device__ __forceinline__ void stage_rc(int b, int& R, int& C) { const int st = b / 1024, sb = b % 1024, swz = sb ^ (((sb >> 9) & 1) << 5); R = (st >> 1) * 16 + swz / 64; C = (st & 1) * 32 + (swz % 64) / 2; }
__host__ __device__ __forceinline__ int perm32(int rho) { const int n = rho >> 4, i = rho & 15; return 8 * (i >> 2) + 4 * n + (i & 3); }

struct Unit { const char* A; const char* B; int rows_lds; int i0, i1, i2, i3; };

template <int PB, bool FP8, bool GATHER, class Epi, class Sched, bool MASKQ = false>
__device__ __forceinline__ void gemm_phase(LAS unsigned char* lds, const Sched& S, const Epi& E) {
    int tid_ = threadIdx.x; asm volatile("" : "+v"(tid_));
    const int tid = tid_, wid = __builtin_amdgcn_readfirstlane(tid >> 6), lane = tid & 63, wr = wid >> 2, wc = wid & 3, fr = lane & 15, fq = lane >> 4;
    constexpr int nt = PB / 128;
    int Rs[2], Cs[2]; unsigned voffB[2];
#pragma unroll
    for (int i = 0; i < 2; ++i) { int R, C; stage_rc(tid * 16 + i * 8192, R, C); Rs[i] = R; Cs[i] = C; const int Rb = (R & ~31) + perm32(R & 31); voffB[i] = (unsigned)(Rb * PB + C * 2); }
    constexpr size_t kstep = (size_t)(BK * 2);
    constexpr size_t hstep = (size_t)HALF * PB;
    const unsigned ldsw = (unsigned)wid * 1024u;
    const int aoff = lds_byte(wr * 64 + fr, fq * 8), boff = lds_byte(wc * 32 + fr, fq * 8);
#define PG8_SA(b, h) (((b) * 2 + (h)) * HTB)
#define PG8_SB(b, h) ((4 + (b) * 2 + (h)) * HTB)
#define PG8_STAGE(bufoff, gbase, v0, v1) do { \
        __builtin_amdgcn_global_load_lds((const unsigned*)((const char*)(gbase) + (v0)), (LAS unsigned*)(lds + (bufoff) + ldsw), 16, 0, 0); \
        __builtin_amdgcn_global_load_lds((const unsigned*)((const char*)(gbase) + (v1)), (LAS unsigned*)(lds + (bufoff) + ldsw + 8192), 16, 0, 0); } while (0)
#define PG8_STB(bufoff, gbase) PG8_STAGE(bufoff, gbase, voffB[0], voffB[1])
#define PG8_LDA(dst, b, h) do { _Pragma("unroll") for (int m = 0; m < 4; ++m) _Pragma("unroll") for (int k = 0; k < 2; ++k) dst[m][k] = *(const LAS bf16x8*)(lds + PG8_SA(b, h) + aoff + m * 2048 + k * 1024); } while (0)
#define PG8_LDB(dst, b, h) do { _Pragma("unroll") for (int n = 0; n < 2; ++n) _Pragma("unroll") for (int k = 0; k < 2; ++k) dst[n][k] = *(const LAS bf16x8*)(lds + PG8_SB(b, h) + boff + n * 2048 + k * 1024); } while (0)
#define PG8_CAT(x0, x1) __builtin_shufflevector(__builtin_bit_cast(i32x4, x0), __builtin_bit_cast(i32x4, x1), 0, 1, 2, 3, 4, 5, 6, 7)
#define PG8_MMA(ai, bj, At, Bt) do { __builtin_amdgcn_s_setprio(1); _Pragma("unroll") for (int m = 0; m < 4; ++m) _Pragma("unroll") for (int n = 0; n < 2; ++n) { \
        if constexpr (FP8) { asm volatile("v_mfma_scale_f32_16x16x128_f8f6f4 %0, %1, %2, %0, %3, %3 op_sel_hi:[0,0,0]" : "+v"(acc[ai][bj][m][n]) : "v"(PG8_CAT(Bt[n][0], Bt[n][1])), "v"(PG8_CAT(At[m][0], At[m][1])), "v"(scl)); }   \
        else { _Pragma("unroll") for (int k = 0; k < 2; ++k) acc[ai][bj][m][n] = __builtin_amdgcn_mfma_f32_16x16x32_bf16(Bt[n][k], At[m][k], acc[ai][bj][m][n], 0, 0, 0); } } \
        __builtin_amdgcn_s_setprio(0); } while (0)
#define PG8_MMAQ(ai, bj, At, Bt) do { if (!MASKQ || ((qm >> ((ai) * 2 + (bj))) & 1)) PG8_MMA(ai, bj, At, Bt); } while (0)
#define PG8_WAIT_V(n) asm volatile("s_waitcnt vmcnt(" #n ")" ::: "memory")
#define PG8_WAIT_L(n) asm volatile("s_waitcnt lgkmcnt(" #n ")" ::: "memory")
#define PG8_BAR __builtin_amdgcn_s_barrier()
#define PG8_SCHED __builtin_amdgcn_sched_barrier(0)
#define PG8_SETA(v, u) do { _Pragma("unroll") for (int h = 0; h < 2; ++h) _Pragma("unroll") for (int i = 0; i < 2; ++i) { \
        if constexpr (GATHER) { const int tk = *(const LAS int*)(lds + (u).rows_lds + 4 * (h * HALF + Rs[i])); v[h][i] = (unsigned)(tk * PB + Cs[i] * 2); } \
        else v[h][i] = (unsigned)((h * HALF + Rs[i]) * PB + Cs[i] * 2); } } while (0)
    Unit cur, nxt; int ui = 0; bool relax_prev = false;
    if (!S.next(0, cur)) return;
    int qm = MASKQ ? __builtin_amdgcn_readfirstlane((cur.i1 >> 8) ? (cur.i1 >> 8) : 15) : 15; (void)qm;
    int scl = 0x7F7F7F7F; asm volatile("" : "+v"(scl));
    f32x4 acc[2][2][4][2];
#pragma unroll
    for (int a = 0; a < 2; ++a)
#pragma unroll
        for (int b = 0; b < 2; ++b)
#pragma unroll
            for (int m = 0; m < 4; ++m)
#pragma unroll
                for (int n = 0; n < 2; ++n) acc[a][b][m][n] = (f32x4){0.f, 0.f, 0.f, 0.f};
    bf16x8 At[4][2], B0[2][2], B1[2][2];
    unsigned vAc[2][2], vAn[2][2];
    PG8_SETA(vAc, cur);
    if constexpr (GATHER) { PG8_WAIT_L(0); }
    const char* cA = cur.A; const char* cB = cur.B;
    PG8_STB(PG8_SB(0, 0), cB); PG8_STB(PG8_SB(0, 1), cB + hstep); PG8_STAGE(PG8_SA(0, 0), cA, vAc[0][0], vAc[0][1]); PG8_STAGE(PG8_SA(0, 1), cA, vAc[1][0], vAc[1][1]);
    if (wr == 1) PG8_BAR;
    PG8_WAIT_V(2); PG8_BAR;
    PG8_STB(PG8_SB(1, 0), cB + kstep); PG8_STAGE(PG8_SA(1, 0), cA + kstep, vAc[0][0], vAc[0][1]); PG8_STB(PG8_SB(1, 1), cB + hstep + kstep);
    PG8_WAIT_V(6); PG8_BAR;
    for (;;) {
        const bool has_next = S.next(ui + 1, nxt);
        const char* nA = has_next ? nxt.A : cA; const char* nB = has_next ? nxt.B : cB;
        if constexpr (GATHER) { if (has_next) { PG8_SETA(vAn, nxt); } else {
#pragma unroll
            for (int h = 0; h < 2; ++h)
#pragma unroll
                for (int i = 0; i < 2; ++i) vAn[h][i] = vAc[h][i]; } }
#pragma unroll 1
        for (int t = 0; t < nt; t += 2) {
            const bool last = (t == nt - 2);
            const bool first = (t == 0) && (ui > 0), relax = first && relax_prev;
            const char* a1 = cA + (size_t)(t + 1) * kstep;
            const char* a2 = last ? nA : cA + (size_t)(t + 2) * kstep; const char* b2 = last ? nB : cB + (size_t)(t + 2) * kstep;
            const char* a3 = a2 + kstep; const char* b3 = b2 + kstep;
            unsigned w00, w01, w10, w11;
            if constexpr (GATHER) { w00 = last ? vAn[0][0] : vAc[0][0]; w01 = last ? vAn[0][1] : vAc[0][1]; w10 = last ? vAn[1][0] : vAc[1][0]; w11 = last ? vAn[1][1] : vAc[1][1]; }
            else { w00 = vAc[0][0]; w01 = vAc[0][1]; w10 = vAc[1][0]; w11 = vAc[1][1]; }
#define PG8_WAIT_VR() do { if (relax) asm volatile("s_waitcnt vmcnt(%0)" :: "n"(8 + Epi::NS) : "memory"); else PG8_WAIT_V(8); } while (0)
            PG8_LDB(B0, 0, 0); PG8_LDB(B1, 0, 1); PG8_SCHED; PG8_LDA(At, 0, 0); if (!first) PG8_STAGE(PG8_SA(1, 1), a1, vAc[1][0], vAc[1][1]);
            PG8_WAIT_VR(); PG8_WAIT_L(0); PG8_BAR; PG8_MMAQ(0, 0, At, B0); PG8_MMAQ(0, 1, At, B1); PG8_BAR; PG8_SCHED;
            PG8_LDA(At, 0, 1); PG8_STB(PG8_SB(0, 0), b2); PG8_STB(PG8_SB(0, 1), b2 + hstep); PG8_STAGE(PG8_SA(0, 0), a2, w00, w01);
            PG8_WAIT_VR(); PG8_WAIT_L(0); PG8_BAR; PG8_MMAQ(1, 0, At, B0); PG8_MMAQ(1, 1, At, B1); PG8_BAR; PG8_SCHED;
            PG8_LDB(B0, 1, 0); PG8_LDB(B1, 1, 1); PG8_SCHED; PG8_LDA(At, 1, 0); PG8_STAGE(PG8_SA(0, 1), a2, w10, w11);
            PG8_WAIT_VR(); PG8_WAIT_L(0); PG8_BAR; PG8_MMAQ(0, 0, At, B0); PG8_MMAQ(0, 1, At, B1); PG8_BAR; PG8_SCHED;
            PG8_LDA(At, 1, 1); PG8_STB(PG8_SB(1, 0), b3); PG8_STB(PG8_SB(1, 1), b3 + hstep); PG8_STAGE(PG8_SA(1, 0), a3, w00, w01);
            PG8_WAIT_V(8); PG8_WAIT_L(0); PG8_BAR; PG8_MMAQ(1, 0, At, B0); PG8_MMAQ(1, 1, At, B1); PG8_BAR; PG8_SCHED;
#undef PG8_WAIT_VR
        }
        if (has_next) { if constexpr (GATHER) PG8_STAGE(PG8_SA(1, 1), nA + kstep, vAn[1][0], vAn[1][1]); else PG8_STAGE(PG8_SA(1, 1), nA + kstep, vAc[1][0], vAc[1][1]); }
        asm volatile("" ::: "memory");
        relax_prev = E.relax_ok(cur);
        if (wr == 0) PG8_BAR;
        if constexpr (FP8) asm volatile("s_nop 15\n\ts_nop 7" ::: "memory");
        E(acc, cur, wr, wc, fr, fq);
        if (!has_next) break;
        if (!E.keep_acc(cur)) {
#pragma unroll
        for (int a = 0; a < 2; ++a)
#pragma unroll
            for (int b = 0; b < 2; ++b)
#pragma unroll
                for (int m = 0; m < 4; ++m)
#pragma unroll
                    for (int n = 0; n < 2; ++n) acc[a][b][m][n] = (f32x4){0.f, 0.f, 0.f, 0.f};
        }
        cur = nxt; cA = nA; cB = nB; ++ui;
        if constexpr (MASKQ) qm = __builtin_amdgcn_readfirstlane((cur.i1 >> 8) ? (cur.i1 >> 8) : 15);
        if constexpr (GATHER) {
#pragma unroll
            for (int h = 0; h < 2; ++h)
#pragma unroll
                for (int i = 0; i < 2; ++i) vAc[h][i] = vAn[h][i]; }
        if (wr == 1) PG8_BAR;
    }
    PG8_WAIT_V(0);
    PG8_BAR;
#undef PG8_SA
#undef PG8_SB
#undef PG8_STAGE
#undef PG8_STB
#undef PG8_LDA
#undef PG8_LDB
#undef PG8_MMA
#undef PG8_MMAQ
#undef PG8_CAT
#undef PG8_WAIT_V
#undef PG8_WAIT_L
#undef PG8_BAR
#undef PG8_SCHED
#undef PG8_SETA
}
}

namespace attn {
using s16x4 = __attribute__((ext_vector_type(4))) short;
using f32x16 = __attribute__((ext_vector_type(16))) float;
constexpr int NW = 8, QBLK = 32, QB = QBLK * NW, KVBLK = 64, QP = 512;
__device__ __forceinline__ int crow(int r, int hi) { return (r & 3) + 8 * (r >> 2) + 4 * hi; }
#define SBAR() __builtin_amdgcn_sched_barrier(0)
__device__ __forceinline__ void cmask(f32x16& p0, f32x16& p1, int jb, int qrel, int hi) {
  const float NEG = -INFINITY; int kb = 64 * jb + 4 * hi;
  #pragma unroll
  for (int r = 0; r < 16; ++r) { int kv = kb + (r & 3) + 8 * (r >> 2); if (kv > qrel) p0[r] = NEG; if (kv + 32 > qrel) p1[r] = NEG; }
}
__device__ __forceinline__ void wmask(f32x16& p0, f32x16& p1, int t, int qrel, int hi) {
  const float NEG = -INFINITY; int kb = 64 * t + 4 * hi;
  #pragma unroll
  for (int r = 0; r < 16; ++r) { int kv = kb + (r & 3) + 8 * (r >> 2); if (kv <= qrel) p0[r] = NEG; if (kv + 32 <= qrel) p1[r] = NEG; }
}
constexpr int NSLOT = 3, SLOTB = 8192;
constexpr int LDS_K = 0, LDS_V = NSLOT * SLOTB, LDS_WS = 2 * NSLOT * SLOTB, LDS_OST = LDS_WS + NW * 64 * 4, LDS_BIAS = LDS_OST + NW * 4096, LDS_BYTES = LDS_BIAS + LP * 4;
__device__ __forceinline__ void glds16(const void* gsrc, unsigned lds_dst) { unsigned keep;
  asm volatile("s_mov_b32 %0, m0\n\ts_mov_b32 m0, %2\n\ts_nop 0\n\tglobal_load_lds_dwordx4 %1, off\n\ts_mov_b32 m0, %0" : "=&s"(keep) : "v"(gsrc), "s"(lds_dst) : "memory"); }
__device__ __forceinline__ float max3f(float a, float b, float c) { float r; asm("v_max3_f32 %0, %1, %2, %3" : "=v"(r) : "v"(a), "v"(b), "v"(c)); return r; }
__device__ __forceinline__ float max2f(float a, float b) { float r; asm("v_max_f32_e32 %0, %1, %2" : "=v"(r) : "v"(a), "v"(b)); return r; }
__device__ __forceinline__ float fadd_s(float a, float b) { float r; asm("v_add_f32_e32 %0, %1, %2" : "=v"(r) : "v"(a), "v"(b)); return r; }
__device__ __forceinline__ float fsub_s(float a, float b) { float r; asm("v_sub_f32_e32 %0, %1, %2" : "=v"(r) : "v"(a), "v"(b)); return r; }
typedef float f32x2_t __attribute__((ext_vector_type(2))); typedef __bf16 bf16x2_t __attribute__((ext_vector_type(2)));
__device__ __forceinline__ unsigned cvtpk_s(float lo, float hi) { f32x2_t v = {lo, hi}; bf16x2_t b = __builtin_convertvector(v, bf16x2_t); return __builtin_bit_cast(unsigned, b); }
#define WAIT_BAR(N) asm volatile("s_waitcnt vmcnt(" #N ") lgkmcnt(0)\n\ts_barrier" ::: "memory")
typedef __attribute__((address_space(3))) const char* lds_cptr;
typedef short v4i16_t __attribute__((ext_vector_type(4)));
__device__ __forceinline__ void qkt(f32x16& p0, f32x16& p1, lds_cptr Kslot, const bf16x8* qr, int r32, int hi) {
  lds_cptr kb = Kslot + hi * 1024 + r32 * 16;
  #pragma unroll
  for (int d0 = 0; d0 < 4; ++d0) {
    const bf16x8 b0 = *(const LAS bf16x8*)(kb + d0 * 2048);
    const bf16x8 b1 = *(const LAS bf16x8*)(kb + d0 * 2048 + 512);
    p0 = __builtin_amdgcn_mfma_f32_32x32x16_bf16(b0, qr[d0], p0, 0, 0, 0); p1 = __builtin_amdgcn_mfma_f32_32x32x16_bf16(b1, qr[d0], p1, 0, 0, 0); }
}
__device__ __forceinline__ void kload8(bf16x8* kf, lds_cptr kp) {
  kf[0] = *(const LAS bf16x8*)(kp);        kf[1] = *(const LAS bf16x8*)(kp + 512);
  kf[2] = *(const LAS bf16x8*)(kp + 2048); kf[3] = *(const LAS bf16x8*)(kp + 2560);
  kf[4] = *(const LAS bf16x8*)(kp + 4096); kf[5] = *(const LAS bf16x8*)(kp + 4608);
  kf[6] = *(const LAS bf16x8*)(kp + 6144); kf[7] = *(const LAS bf16x8*)(kp + 6656);
}
__device__ __forceinline__ void kload2(bf16x8* kf, lds_cptr kp, int j) { kf[2 * j] = *(const LAS bf16x8*)(kp + j * 2048); kf[2 * j + 1] = *(const LAS bf16x8*)(kp + j * 2048 + 512); }
__device__ __forceinline__ s16x4 vtr(lds_cptr p) { return __builtin_bit_cast(s16x4, __builtin_amdgcn_ds_read_tr16_b64_v4i16((LAS v4i16_t*)p)); }
__device__ __forceinline__ float rowmax(const f32x16& p0, const f32x16& p1) {
  float a = max3f(p0[0], p0[1], p1[0]), b = max3f(p0[2], p0[3], p1[1]); a = max3f(a, p1[2], p1[3]);
  #pragma unroll
  for (int r = 4; r < 16; r += 4) { a = max3f(a, p0[r], p0[r + 1]); b = max3f(b, p0[r + 2], p0[r + 3]); a = max3f(a, p1[r], p1[r + 1]); b = max3f(b, p1[r + 2], p1[r + 3]); }
  const float m = max2f(a, b);
  auto rr = __builtin_amdgcn_permlane32_swap(__float_as_uint(m), __float_as_uint(m), false, false);
  return max2f(__uint_as_float(rr[0]), __uint_as_float(rr[1]));
}
__device__ __forceinline__ void pv(f32x16* o, int vb, bf16x8 pa0, bf16x8 pa1, bf16x8 pa2, bf16x8 pa3) {
  #pragma unroll
  for (int d0 = 0; d0 < 2; ++d0) { s16x4 lo[4], hi[4];
    #pragma unroll
    for (int ks = 0; ks < 4; ++ks) {
      asm volatile("ds_read_b64_tr_b16 %0,%1 offset:%c2" : "=&v"(lo[ks]) : "v"(vb), "i"(d0 * 4096 + ks * 1024) : "memory");
      asm volatile("ds_read_b64_tr_b16 %0,%1 offset:%c2" : "=&v"(hi[ks]) : "v"(vb), "i"(d0 * 4096 + ks * 1024 + 512) : "memory"); }
    asm volatile("s_waitcnt lgkmcnt(0)" ::: "memory"); SBAR();
    #define PK(k) (bf16x8){lo[k][0], lo[k][1], lo[k][2], lo[k][3], hi[k][0], hi[k][1], hi[k][2], hi[k][3]}
    o[d0] = __builtin_amdgcn_mfma_f32_32x32x16_bf16(pa0, PK(0), o[d0], 0, 0, 0);
    o[d0] = __builtin_amdgcn_mfma_f32_32x32x16_bf16(pa1, PK(1), o[d0], 0, 0, 0);
    o[d0] = __builtin_amdgcn_mfma_f32_32x32x16_bf16(pa2, PK(2), o[d0], 0, 0, 0);
    o[d0] = __builtin_amdgcn_mfma_f32_32x32x16_bf16(pa3, PK(3), o[d0], 0, 0, 0);
    #undef PK
  }
}
template <int KP, bool SWA, int THRL>
__device__ __forceinline__ void attn_unit(const bf16_t* Qu, const bf16_t* __restrict__ Kh, const bf16_t* __restrict__ Vh, bf16_t* Ou, const int NT, const float* biasg, const int refidx, const float sink0, const float sinkstep, char* shm) {
  int tid_ = threadIdx.x; asm volatile("" : "+v"(tid_));
  const int tid = tid_, lane = tid & 63, r32 = lane & 31, hi = lane >> 5; const int wid = __builtin_amdgcn_readfirstlane(tid >> 6);
  const bf16_t* Qw = Qu + (size_t)(wid * QBLK) * QP;
  const unsigned lds0 = (unsigned)(uintptr_t)shm;
  float* wsf = (float*)(shm + LDS_WS) + wid * 64;
  const bf16_t* ksrc = Kh + (long)lane * KP + wid * 8;
  const bf16_t* vsrc = Vh + (long)(16 * (wid & 3) + (lane >> 2)) * KP + (wid >> 2) * 32 + (lane & 3) * 8;
  const unsigned kdst = lds0 + LDS_K + wid * 1024, vdst = lds0 + LDS_V + wid * 1024;
  #define DMA_K(t, slot) glds16(ksrc + (long)(t) * KVBLK * KP, (unsigned)__builtin_amdgcn_readfirstlane(kdst + (slot)))
  #define DMA_V(t, slot) glds16(vsrc + (long)(t) * KVBLK * KP, (unsigned)__builtin_amdgcn_readfirstlane(vdst + (slot)))
  const int vb0 = (int)(lds0 + LDS_V) + ((lane >> 4) & 1) * 32 + (lane & 3) * 8 + (4 * hi + ((lane & 15) >> 2)) * 64;
  bf16x8 kf[8];
  const lds_cptr shm3 = (lds_cptr)shm; const lds_cptr kp0 = shm3 + LDS_K + hi * 1024 + r32 * 16; const lds_cptr vp0 = shm3 + LDS_V + ((lane >> 4) & 1) * 32 + (lane & 3) * 8 + (4 * hi + ((lane & 15) >> 2)) * 64;
  const lds_cptr bp0 = shm3 + LDS_BIAS + hi * 16;
  const int nb4 = NT * 16; f32x4 bv[3];
  #pragma unroll
  for (int k = 0; k < 3; ++k) { const int idx = tid + 512 * k; bv[k] = (idx < nb4) ? *((const GAS f32x4*)biasg + idx) : (f32x4){0.f, 0.f, 0.f, 0.f}; }
  DMA_K(0, 0); DMA_V(0, 0); DMA_K(1, SLOTB);
  bf16x8 qr[4];
  #pragma unroll
  for (int d0 = 0; d0 < 4; ++d0) qr[d0] = *reinterpret_cast<const bf16x8*>(&Qw[(long)r32 * QP + d0 * 16 + hi * 8]);
  float mhat = 0.f, nmh = 0.f, bref = 0.f, l_reg = 0.f; f32x16 o[2]; o[0] = f32x16{}; o[1] = f32x16{};
  const int qrel = wid * QBLK + r32;
  #define CMASK(P0, P1, t) do { int jb_ = (t) - (NT - 4); if (jb_ >= 0) cmask(P0, P1, jb_, qrel, hi); } while (0)
  #define WMASK(P0, P1, t) do { if constexpr (SWA) { if ((t) < 4) wmask(P0, P1, (t), qrel, hi); } } while (0)
  #define BIASC(C0, C1, t) do { const LAS f32x4* bp_ = (const LAS f32x4*)(bp0 + (t) * 256); \
    _Pragma("unroll") for (int g_ = 0; g_ < 4; ++g_) { const f32x4 x0_ = bp_[2 * g_], x1_ = bp_[8 + 2 * g_]; \
      _Pragma("unroll") for (int c_ = 0; c_ < 4; ++c_) { C0[4 * g_ + c_] = nmh - x0_[c_]; C1[4 * g_ + c_] = nmh - x1_[c_]; } } } while (0)
  bool resc = false;
  #define START(P0, P1) do { const float rm = rowmax(P0, P1); resc = false; \
    { const float dl = (rm > -1e29f) ? rm : 0.f; mhat = fadd_s(mhat, dl); \
      _Pragma("unroll") for (int r = 0; r < 16; ++r) { P0[r] = fsub_s(P0[r], dl); P1[r] = fsub_s(P1[r], dl); } \
      nmh = bref - mhat; } \
    _Pragma("unroll") for (int r = 0; r < 16; ++r) P0[r] = __builtin_amdgcn_exp2f(P0[r]); } while (0)
  #define RESC() do { if (resc) { asm volatile("s_waitcnt lgkmcnt(0)" ::: "memory"); \
      _Pragma("unroll") for (int d_ = 0; d_ < 2; ++d_) _Pragma("unroll") for (int r = 0; r < 16; ++r) o[d_][r] *= wsf[crow(r, hi)]; } } while (0)
  f32x16 pA0, pA1, pB0, pB1;
  int sl_prev = 0, sl_cur = 0, sl_next = SLOTB;
  #define ROT() do { sl_prev = sl_cur; sl_cur = sl_next; sl_next = (sl_next == (NSLOT - 1) * SLOTB) ? 0 : sl_next + SLOTB; } while (0)
  DMA_K(2, 2 * SLOTB);
  #pragma unroll
  for (int k = 0; k < 3; ++k) { const int idx = tid + 512 * k; if (idx < nb4) *((LAS f32x4*)(shm3 + LDS_BIAS) + idx) = bv[k]; }
  WAIT_BAR(3);
  bref = *(const LAS float*)(shm3 + LDS_BIAS + refidx * 4); nmh = bref;
  BIASC(pA0, pA1, 0);
  qkt(pA0, pA1, shm3 + LDS_K, qr, r32, hi); asm volatile("s_nop 15\n\ts_nop 7" : "+v"(pA0), "+v"(pA1)); CMASK(pA0, pA1, 0); WMASK(pA0, pA1, 0);
  START(pA0, pA1);
  _Pragma("unroll") for (int r = 0; r < 16; ++r) pA1[r] = __builtin_amdgcn_exp2f(pA1[r]);
  WAIT_BAR(0);
  DMA_K(3, 0); DMA_V(1, SLOTB);
  ROT();
  kload8(kf, kp0 + sl_cur);
  WAIT_BAR(2);
  s16x4 vlo[8], vhi[8]; u32x4 pw0, pw1, pw2, pw3;
  #define PKW(P, B) cvtpk_s(P[B], P[B + 1])
  #define PAF(k) __builtin_bit_cast(bf16x8, pw##k)
  #define VFR(i) (bf16x8){vlo[i][0], vlo[i][1], vlo[i][2], vlo[i][3], vhi[i][0], vhi[i][1], vhi[i][2], vhi[i][3]}
  #define PIN(x) asm volatile("" : "+v"(x))
  #define MX3(a, b, c) __builtin_fmaxf(__builtin_fmaxf((a), (b)), (c))
  #define GAPA(MF, A0, A1, A2, A3, W0, W1, PW) do { MF; sacc += A0; sacc += A1; sacc += A2; sacc += A3; PIN(sacc); W0; W1; PIN(PW); SBAR(); } while (0)
  #define EX(v) __builtin_amdgcn_exp2f(v)
  #define GAPB(MF, X, B) do { MF; X[B] = EX(X[B]); X[B + 1] = EX(X[B + 1]); X[B + 2] = EX(X[B + 2]); X[B + 3] = EX(X[B + 3]); PIN(X); SBAR(); } while (0)
  #define VRD(i) do { vlo[i] = vtr(vp_ + (((i) >> 2) * 4096 + ((i) & 3) * 1024)); vhi[i] = vtr(vp_ + (((i) >> 2) * 4096 + ((i) & 3) * 1024 + 512)); } while (0)
  #define KRD(G, j) do { if (G) { kload2(kf, kp0 + sl_next, j); SBAR(); } } while (0)
  #define MF32(a, b, c) __builtin_amdgcn_mfma_f32_32x32x16_bf16(a, b, c, 0, 0, 0)
  #define STEP(C0, C1, P0, P1, t, GK, GV, GL) do { SBAR(); \
    BIASC(C0, C1, t); SBAR(); \
    const lds_cptr vp_ = vp0 + sl_prev; \
    VRD(0); SBAR(); float sacc = (P0[0] + P0[1]); \
    GAPA(C0 = MF32(kf[0], qr[0], C0), P0[2], P0[3], P0[4], P0[5],     pw0[0] = PKW(P0, 0), pw0[1] = PKW(P0, 2), pw0); \
    VRD(4); SBAR(); GAPA(C1 = MF32(kf[1], qr[0], C1), P0[6], P0[7], P0[8], P0[9],     pw0[2] = PKW(P0, 4), pw0[3] = PKW(P0, 6), pw0); \
    VRD(1); SBAR(); GAPA(C0 = MF32(kf[2], qr[1], C0), P0[10], P0[11], P0[12], P0[13], pw1[0] = PKW(P0, 8), pw1[1] = PKW(P0, 10), pw1); \
    VRD(5); SBAR(); GAPA(C1 = MF32(kf[3], qr[1], C1), P0[14], P0[15], P1[0], P1[1],   pw1[2] = PKW(P0, 12), pw1[3] = PKW(P0, 14), pw1); \
    VRD(2); SBAR(); GAPA(C0 = MF32(kf[4], qr[2], C0), P1[2], P1[3], P1[4], P1[5],     pw2[0] = PKW(P1, 0), pw2[1] = PKW(P1, 2), pw2); \
    VRD(6); SBAR(); GAPA(C1 = MF32(kf[5], qr[2], C1), P1[6], P1[7], P1[8], P1[9],     pw2[2] = PKW(P1, 4), pw2[3] = PKW(P1, 6), pw2); \
    VRD(3); SBAR(); GAPA(C0 = MF32(kf[6], qr[3], C0), P1[10], P1[11], P1[12], P1[13], pw3[0] = PKW(P1, 8), pw3[1] = PKW(P1, 10), pw3); \
    VRD(7); SBAR(); GAPA(C1 = MF32(kf[7], qr[3], C1), P1[14], P1[15], 0.f, 0.f,       pw3[2] = PKW(P1, 12), pw3[3] = PKW(P1, 14), pw3); \
    l_reg += sacc; \
    if (GK) { DMA_K((t) + 3, sl_cur); } if (GV) { DMA_V((t) + 1, sl_next); } \
    CMASK(C0, C1, t); WMASK(C0, C1, t); \
    { float a = MX3(C0[0], C0[1], C1[0]), b = MX3(C0[2], C0[3], C1[1]); a = MX3(a, C1[2], C1[3]); \
      _Pragma("unroll") for (int r = 4; r < 16; r += 4) { a = MX3(a, C0[r], C0[r + 1]); b = MX3(b, C0[r + 2], C0[r + 3]); a = MX3(a, C1[r], C1[r + 1]); b = MX3(b, C1[r + 2], C1[r + 3]); } \
      float rm = __builtin_fmaxf(a, b); { auto rr = __builtin_amdgcn_permlane32_swap(__float_as_uint(rm), __float_as_uint(rm), false, false); rm = __builtin_fmaxf(__uint_as_float(rr[0]), __uint_as_float(rr[1])); } \
      resc = false; \
      if (__builtin_expect(__any(rm > (float)THRL), 0)) { const float dl = __builtin_fmaxf(rm, 0.f); mhat += dl; \
        _Pragma("unroll") for (int r = 0; r < 16; ++r) { C0[r] -= dl; C1[r] -= dl; } \
        nmh = bref - mhat; \
        const float f = __builtin_amdgcn_exp2f(-dl); l_reg *= f; if (hi == 0) wsf[r32] = f; resc = true; } } \
    SBAR(); \
    GAPB(o[0] = MF32(PAF(0), VFR(0), o[0]), C0, 0); \
    GAPB(o[1] = MF32(PAF(0), VFR(4), o[1]), C0, 4); \
    KRD(GL, 0); GAPB(o[0] = MF32(PAF(1), VFR(1), o[0]), C0, 8); \
    KRD(GL, 1); GAPB(o[1] = MF32(PAF(1), VFR(5), o[1]), C0, 12); \
    KRD(GL, 2); GAPB(o[0] = MF32(PAF(2), VFR(2), o[0]), C1, 0); \
    KRD(GL, 3); GAPB(o[1] = MF32(PAF(2), VFR(6), o[1]), C1, 4); \
    GAPB(o[0] = MF32(PAF(3), VFR(3), o[0]), C1, 8); \
    GAPB(o[1] = MF32(PAF(3), VFR(7), o[1]), C1, 12); \
    } while (0)
  int t = 1;
  #undef CMASK
  #define CMASK(P0, P1, t) do {} while (0)
  for (; t + 5 < NT; t += 2) {
    STEP(pB0, pB1, pA0, pA1, t, true, true, true);     WAIT_BAR(2); RESC(); ROT();
    STEP(pA0, pA1, pB0, pB1, t + 1, true, true, true); WAIT_BAR(2); RESC(); ROT();
  }
  #undef CMASK
  #define CMASK(P0, P1, t) do { int jb_ = (t) - (NT - 4); if (jb_ >= 0) cmask(P0, P1, jb_, qrel, hi); } while (0)
  #define ENDW(tt) do { if ((tt) + 3 < NT) { WAIT_BAR(2); } else if ((tt) + 2 < NT) { WAIT_BAR(1); } else { WAIT_BAR(0); } } while (0)
  for (; t + 1 < NT; t += 2) {
    STEP(pB0, pB1, pA0, pA1, t, (t + 3 < NT), (t + 1 < NT), (t + 1 < NT));         ENDW(t);     RESC(); ROT();
    STEP(pA0, pA1, pB0, pB1, t + 1, (t + 4 < NT), (t + 2 < NT), (t + 2 < NT));     ENDW(t + 1); RESC(); ROT();
  }
  STEP(pB0, pB1, pA0, pA1, NT - 1, false, false, false); RESC();
  { float sacc = pB0[0] + pB0[1]; _Pragma("unroll") for (int r = 2; r < 16; ++r) sacc += pB0[r]; _Pragma("unroll") for (int r = 0; r < 16; ++r) sacc += pB1[r]; l_reg += sacc;
    pw0 = (u32x4){PKW(pB0, 0), PKW(pB0, 2), PKW(pB0, 4), PKW(pB0, 6)}; pw1 = (u32x4){PKW(pB0, 8), PKW(pB0, 10), PKW(pB0, 12), PKW(pB0, 14)}; pw2 = (u32x4){PKW(pB1, 0), PKW(pB1, 2), PKW(pB1, 4), PKW(pB1, 6)}; pw3 = (u32x4){PKW(pB1, 8), PKW(pB1, 10), PKW(pB1, 12), PKW(pB1, 14)};
    SBAR(); pv(o, vb0 + sl_cur, PAF(0), PAF(1), PAF(2), PAF(3)); }
  #undef PKW
  #undef PAF
  #undef VFR
  #undef PIN
  #undef MX3
  #undef GAPA
  #undef GAPB
  #undef EX
  #undef VRD
  #undef KRD
  #undef STEP
  #undef ENDW
  #undef MF32
  { auto rr = __builtin_amdgcn_permlane32_swap(__float_as_uint(l_reg), __float_as_uint(l_reg), false, false); l_reg = __uint_as_float(rr[0]) + __uint_as_float(rr[1]); }
  if constexpr (SWA) l_reg += __builtin_amdgcn_exp2f(sink0 + sinkstep * (float)qrel - mhat);
  if (hi == 0) wsf[32 + r32] = l_reg; asm volatile("s_waitcnt lgkmcnt(0)" ::: "memory");
  float rli[16];
  #pragma unroll
  for (int r = 0; r < 16; ++r) rli[r] = __builtin_amdgcn_rcpf(wsf[32 + crow(r, hi)]);
  bf16_t* Ow = Ou + (size_t)(wid * QBLK) * QP;
  { bf16_t* stg = (bf16_t*)(shm + LDS_OST) + wid * 2048;
    #pragma unroll
    for (int r = 0; r < 16; ++r) { const int orow = crow(r, hi);
      #pragma unroll
      for (int d0 = 0; d0 < 2; ++d0) stg[orow * 64 + d0 * 32 + r32] = (bf16_t)f2bf(o[d0][r] * rli[r]); }
    asm volatile("s_waitcnt lgkmcnt(0)" ::: "memory");
    #pragma unroll
    for (int i = 0; i < 4; ++i) { const int row = i * 8 + (lane >> 3), ch = lane & 7; const u32x4 v = *(const u32x4*)(stg + row * 64 + ch * 8); *(u32x4*)(Ow + (long)row * QP + ch * 8) = v; } }
  asm volatile("s_waitcnt lgkmcnt(0)\n\ts_barrier" ::: "memory");
  #undef DMA_K
  #undef DMA_V
  #undef CMASK
  #undef WMASK
  #undef BIASC
  #undef START
  #undef RESC
  #undef ROT
}
#undef SBAR
#undef WAIT_BAR
}

#define XB_TMO      128
#define XB_XCNT(j)  (256  + 64 * (j))
#define XB_XSUB(j)  (1280 + 64 * (j))
#define XB_XGEN(j)  (2304 + 64 * (j))
#define XB_TOP      3328
#define XB_TOPGEN   3392
#define XCD_BAR_WORDS 3456
#define XB_SPIN_CAP (1u << 18)
__device__ __forceinline__ unsigned xb_ld(unsigned* p)              { return __hip_atomic_load(p, __ATOMIC_RELAXED, __HIP_MEMORY_SCOPE_AGENT); }
__device__ __forceinline__ unsigned xb_add(unsigned* p, unsigned v) { return __hip_atomic_fetch_add(p, v, __ATOMIC_RELAXED, __HIP_MEMORY_SCOPE_AGENT); }
__device__ __forceinline__ unsigned xb_xcc_id() { return (unsigned)__builtin_amdgcn_s_getreg((3 << 11) | 20) & 0xFu; }
#define XB_SPIN(cond, bar) do { unsigned _sp = 0; while (cond) { __builtin_amdgcn_s_sleep(1); \
    if ((++_sp & 255u) == 0u) { if (xb_ld(&(bar)[XB_TMO])) break; if (_sp > XB_SPIN_CAP) { atomicAdd(&(bar)[XB_TMO], 1u); break; } } } } while (0)
struct XcdBarrier { unsigned* bar; unsigned x; volatile LAS unsigned* st; };
__device__ __forceinline__ XcdBarrier xcd_barrier_post(unsigned* bar, volatile LAS unsigned* st) {
    XcdBarrier b; b.bar = bar; b.x = xb_xcc_id(); b.st = st;
    if (threadIdx.x == 0) (void)xb_add(&bar[XB_XCNT(b.x)], 1u);
    return b;
}
__device__ __forceinline__ void xcd_barrier_complete(unsigned* bar, unsigned x, unsigned& nloc, unsigned& nx) {
    const unsigned G = gridDim.x * gridDim.y * gridDim.z;
    unsigned sum, cnt, mine, sp = 0u;
    for (;;) {
        sum = 0u; cnt = 0u; mine = 0u;
#pragma unroll
        for (unsigned j = 0; j < 16; ++j) { const unsigned c = xb_ld(&bar[XB_XCNT(j)]); sum += c; cnt += (c > 0u) ? 1u : 0u; mine = (j == x) ? c : mine; }
        if (sum == G) break;
        __builtin_amdgcn_s_sleep(1);
        if ((++sp & 255u) == 0u) { if (xb_ld(&bar[XB_TMO])) break; if (sp > XB_SPIN_CAP) { atomicAdd(&bar[XB_TMO], 1u); break; } }
    }
    nloc = mine > 0u ? mine : 1u; nx = cnt > 0u ? cnt : 1u;
}
__device__ __forceinline__ void xcd_barrier(const XcdBarrier& b) {
    asm volatile("s_waitcnt vmcnt(0)" ::: "memory");
    __syncthreads();
    if (threadIdx.x == 0) {
        unsigned* bar = b.bar;
        __builtin_amdgcn_s_waitcnt(0);
        unsigned nloc = b.st[0], nx = b.st[1];
        if (nloc == 0u) { xcd_barrier_complete(bar, b.x, nloc, nx); b.st[0] = nloc; b.st[1] = nx; }
        const unsigned old = xb_add(&bar[XB_XSUB(b.x)], 1u);
        const unsigned gen = old / nloc;
        if (old + 1u == (gen + 1u) * nloc) {
            __builtin_amdgcn_fence(__ATOMIC_RELEASE, "agent");
            asm volatile("s_waitcnt vmcnt(0)" ::: "memory");
            const unsigned og = xb_add(&bar[XB_TOP], 1u);
            const unsigned tg = og / nx;
            if (og + 1u == (tg + 1u) * nx) xb_add(&bar[XB_TOPGEN], 1u);
            else XB_SPIN(xb_ld(&bar[XB_TOPGEN]) == tg, bar);
            __builtin_amdgcn_fence(__ATOMIC_ACQUIRE, "agent");
            xb_add(&bar[XB_XGEN(b.x)], 1u);
            asm volatile("s_waitcnt vmcnt(0)" ::: "memory");
        } else {
            XB_SPIN(xb_ld(&bar[XB_XGEN(b.x)]) == gen, bar);
            __builtin_amdgcn_fence(__ATOMIC_ACQUIRE, "agent");
            asm volatile("s_waitcnt vmcnt(0)" ::: "memory");
        }
    }
    __syncthreads();
}

struct Args { const float* in[20]; float* out; unsigned char* ws; };

struct Frame {
    LAS unsigned char* lds; volatile LAS unsigned* MISC; gu32* ctl;
    int tid, lane, wave, G, gw, NGW;
    unsigned char* ws;
};

struct TrItem { const float* W; int ldw, col0, k0; bf16_t* WT; int ldt, row0; };
__device__ __forceinline__ void tr_load(const TrItem& t, f32x4 (&v)[8], int lane) {
    const float* p = t.W + (size_t)(t.k0 + (lane >> 3)) * t.ldw + t.col0 + 4 * (lane & 7);
#pragma unroll
    for (int i = 0; i < 8; ++i) v[i] = __builtin_nontemporal_load((const GAS f32x4*)(p + (size_t)(8 * i) * t.ldw));
}
__device__ __forceinline__ void tr_store(const TrItem& t, const f32x4 (&v)[8], LAS float* scr, int lane) {
    LAS float* w = scr + (lane >> 3) * 33 + 4 * (lane & 7);
#pragma unroll
    for (int i = 0; i < 8; ++i) { w[(8 * i) * 33 + 0] = v[i].x; w[(8 * i) * 33 + 1] = v[i].y; w[(8 * i) * 33 + 2] = v[i].z; w[(8 * i) * 33 + 3] = v[i].w; }
    LDS_WAIT(); asm volatile("" ::: "memory");
    const int c = lane & 7;
#pragma unroll
    for (int j = 0; j < 4; ++j) { const int n = (lane >> 3) + 8 * j; const LAS float* s = scr + (8 * c) * 33 + n;
        u32x4 o; o.x = pk2(s[0 * 33], s[1 * 33]); o.y = pk2(s[2 * 33], s[3 * 33]); o.z = pk2(s[4 * 33], s[5 * 33]); o.w = pk2(s[6 * 33], s[7 * 33]);
        *(GAS u32x4*)(t.WT + (size_t)(t.row0 + n) * t.ldt + t.k0 + 8 * c) = o; }
    LDS_WAIT(); asm volatile("" ::: "memory");
}
__device__ __forceinline__ void tr8_item(const float* W, int ldw, int col0, int k0, unsigned char* WT, int ldt, int row0, LAS float* scr, int lane) {
    const float* p = W + (size_t)(k0 + (lane >> 3)) * ldw + col0 + 4 * (lane & 7);
    f32x4 v[16];
#pragma unroll
    for (int i = 0; i < 16; ++i) v[i] = __builtin_nontemporal_load((const GAS f32x4*)(p + (size_t)(8 * i) * ldw));
    LAS float* w = scr + (lane >> 3) * 33 + 4 * (lane & 7);
#pragma unroll
    for (int i = 0; i < 16; ++i) { w[(8 * i) * 33 + 0] = v[i].x; w[(8 * i) * 33 + 1] = v[i].y; w[(8 * i) * 33 + 2] = v[i].z; w[(8 * i) * 33 + 3] = v[i].w; }
    LDS_WAIT(); asm volatile("" ::: "memory");
    const int c = lane & 7;
#pragma unroll
    for (int j = 0; j < 4; ++j) { const int n = (lane >> 3) + 8 * j; const LAS float* s = scr + (16 * c) * 33 + n;
        u32x4 o; o.x = pk4_fp8(s[0 * 33] * SC_W, s[1 * 33] * SC_W, s[2 * 33] * SC_W, s[3 * 33] * SC_W); o.y = pk4_fp8(s[4 * 33] * SC_W, s[5 * 33] * SC_W, s[6 * 33] * SC_W, s[7 * 33] * SC_W);
        o.z = pk4_fp8(s[8 * 33] * SC_W, s[9 * 33] * SC_W, s[10 * 33] * SC_W, s[11 * 33] * SC_W); o.w = pk4_fp8(s[12 * 33] * SC_W, s[13 * 33] * SC_W, s[14 * 33] * SC_W, s[15 * 33] * SC_W);
        __builtin_nontemporal_store(o, (GAS u32x4*)(WT + (size_t)(row0 + n) * ldt + k0 + 16 * c)); }
    LDS_WAIT(); asm volatile("" ::: "memory");
}
constexpr int NCB_P1 = 64, NCB_P6 = 160, NCB_P2 = 1024 - NCB_P1 - NCB_P6;
__device__ __forceinline__ void conv_batch(int bat, const float* w_up_, const float* w_down_, unsigned char* wup8, unsigned char* wdn8, LAS unsigned char* ring) {
    constexpr int I_UP = NE * 8 * 64; const int t2 = fresh_tid(), lane = t2 & 63, wv = __builtin_amdgcn_readfirstlane(t2 >> 6);
    LAS float* scr = (LAS float*)(ring + wv * 17664);
#pragma unroll 1
    for (int k3 = 0; k3 < 3; ++k3) { const int it = bat * 24 + 8 * k3 + wv;
        if (it < I_UP) { const int e = it / (8 * 64), q = it % (8 * 64), kb = q / 64, nb = q % 64;
            const int lcol = ((nb >> 2) & 1) * 1024 + (nb >> 3) * 128 + (nb & 3) * 32;
            tr8_item(w_up_ + (size_t)e * DM * 2048, 2048, lcol, kb * 128, wup8 + (size_t)e * 2048 * DM, DM, nb * 32, scr, lane); }
        else { const int r = it - I_UP, e = r / (8 * 32), q = r % (8 * 32), kb = q / 32, nb = q % 32;
            tr8_item(w_down_ + (size_t)e * DM * DM, DM, nb * 32, kb * 128, wdn8 + (size_t)e * DM * DM, DM, nb * 32, scr, lane); } }
}
__device__ __forceinline__ int win_logical_col(int p) {
    const int tile = p >> 8, q = p & 255, bj = q >> 7, hh = (q >> 5) & 3;
    if (tile >= 9) { return (tile < 13 ? 2312 + (tile - 9) * 256 : 3336 + (tile - 13) * 256) + q; }
    const int hoff = hh * 64 + bj * 32;
    if (tile < 6) return tile * 256 + hoff;
    if (tile < 8) return 1544 + (tile - 6) * 256 + hoff;
    return 2056 + hoff;
}

struct SchedIn {
    int G, c, lo, hi; const char* A; const char* B;
    __device__ __forceinline__ bool next(int i, pg8::Unit& u) const {
        const int n = lo + i * G + c; int pm, pn;
        if (n >= hi) return false;
        if (n < 5) { pm = 64; pn = (n < 4) ? 2 + n : 8; }
        else { int wgid = n - 5; { const int q = 1088 / 8, xcd = wgid % 8, off = wgid / 8; wgid = xcd * q + off; }
            const int nig = 8 * 17, gid = wgid / nig, fm = gid * 8; pm = fm + ((wgid % nig) % 8); pn = (wgid % nig) / 8; }
        u.A = A + (size_t)pm * 256 * DM * 2; u.B = B + (size_t)pn * 256 * DM * 2; u.rows_lds = 0; u.i0 = pm; u.i1 = pn; u.i2 = 0; u.i3 = 0; return true;
    }
};
constexpr int IN_ALL = 1093, IN_P1 = 992;
struct SchedMix {
    int G, c; const char *OA, *OB, *WF, *WS;
    __device__ __forceinline__ bool next(int i, pg8::Unit& u) const {
        if (i >= 2 || c >= 256) return false;
        int wgid = c; { const int q = 256 / 8, xcd = wgid % 8, off = wgid / 8; wgid = xcd * q + off; }
        const int nig = 8 * 4, gid = wgid / nig, fm = gid * 8, pm = fm + ((wgid % nig) % 8), pn = (wgid % nig) / 8;
        u.A = (i == 0 ? OA : OB) + (size_t)pm * 256 * 512 * 2; u.B = (i == 0 ? WF : WS) + (size_t)pn * 256 * 512 * 2; u.rows_lds = 0; u.i0 = pm; u.i1 = pn; u.i2 = i; u.i3 = 0; return true;
    }
};
struct SchedOut {
    int G, c; const char *A, *B;
    __device__ __forceinline__ bool next(int i, pg8::Unit& u) const {
        if (i >= 1 || c >= 256) return false;
        int wgid = c; { const int q = 256 / 8, xcd = wgid % 8, off = wgid / 8; wgid = xcd * q + off; }
        const int nig = 8 * 4, gid = wgid / nig, fm = gid * 8, pm = fm + ((wgid % nig) % 8), pn = (wgid % nig) / 8;
        u.A = A + (size_t)pm * 256 * DM * 2; u.B = B + (size_t)pn * 256 * DM * 2; u.rows_lds = 0; u.i0 = pm; u.i1 = pn; u.i2 = 0; u.i3 = 0; return true;
    }
};
struct SchedMoe {
    int G, c, NPN; const LAS int* utab; const char* A; const char* B; int gather, pb;
    __device__ __forceinline__ bool next(int i, pg8::Unit& u) const {
        if (i >= 10) return false;
        const i32x4 t = *(const LAS i32x4*)(utab + 4 * i);
        if (__builtin_amdgcn_readfirstlane(t.w) == 0) return false;
        const int tau = __builtin_amdgcn_readfirstlane(t.x), e = __builtin_amdgcn_readfirstlane(t.y), pw = __builtin_amdgcn_readfirstlane(t.w) - 1, pn = pw & 255;
        u.i0 = tau; u.i1 = pw; u.i2 = e;
        u.i3 = __builtin_amdgcn_readfirstlane(t.z);
        u.rows_lds = ROWS_OFF + i * 1024;
        u.A = gather ? A : A + (size_t)tau * 256 * pb;
        u.B = B + ((size_t)e * (NPN * 256) + (size_t)pn * 256) * pb;
        return true;
    }
};
__device__ __forceinline__ void moe_units(LAS int* utab, const LAS int* tab, int T, int NPN, int G, int c, int tid, bool split) {
    if (tid < 10) { const int x = c & 7, k = c >> 3, nx = (G - x + 7) >> 3, t0 = (T * x) >> 3, t1 = (T * (x + 1)) >> 3;
        const int U = (t1 - t0) * NPN, nfull = U / nx, rem = U - nfull * nx; int sp = 1; if (split && rem > 0) sp = (4 * rem <= nx) ? 4 : (2 * rem <= nx) ? 2 : 1;
        int L = -1, qm = 0;
        if (tid < nfull) L = tid * nx + k;
        else if (tid == nfull && k < sp * rem) { L = nfull * nx + k / sp; if (sp == 4) qm = 1 << (k & 3); else if (sp == 2) qm = 3 << (2 * (k & 1)); }
        i32x4 t = {0, 0, 0, 0};
        if (L >= 0) { L += t0 * NPN; const int tau = L / NPN; int e = 0;
            for (int j = 1; j < NE; ++j) e += (tab[32 + j] <= tau) ? 1 : 0;
            t = (i32x4){tau, e, tab[e] - (tau - tab[32 + e]) * 256, 1 + (L % NPN) + (qm << 8)}; }
        *(LAS i32x4*)(utab + 4 * tid) = t; }
    __syncthreads();
}

struct EpiIn {
    __device__ __forceinline__ bool keep_acc(const pg8::Unit&) const { return false; }
    static constexpr int NS = 16;
    __device__ __forceinline__ bool relax_ok(const pg8::Unit& u) const { return u.i0 < 64; }
    bf16_t *FQ, *FK, *FV, *SQ, *SK, *SV, *GA, *GB; const float *gfq, *gfk, *gsq, *gsk;
    __device__ __forceinline__ void operator()(const f32x4 (&acc)[2][2][4][2], const pg8::Unit& u, int wr, int wc, int fr, int fq) const {
        const int pm = u.i0, pn = u.i1;
        if (pn >= 9) {
            bf16_t* G = (pn < 13) ? GA : GB; const int colt = (pn < 13 ? pn - 9 : pn - 13) * 256 + wc * 32 + 8 * fq;
#pragma unroll
            for (int ai = 0; ai < 2; ++ai)
#pragma unroll
                for (int m = 0; m < 4; ++m) { const int row = pm * 256 + ai * 128 + wr * 64 + m * 16 + fr; bf16_t* rowp = G + (size_t)row * DM + colt;
#pragma unroll
                    for (int bj = 0; bj < 2; ++bj) { const f32x4 v0 = acc[ai][bj][m][0], v1 = acc[ai][bj][m][1]; u32x4 w;
                        w.x = pk2(sigmoidf_fast(v0[0]), sigmoidf_fast(v0[1])); w.y = pk2(sigmoidf_fast(v0[2]), sigmoidf_fast(v0[3]));
                        w.z = pk2(sigmoidf_fast(v1[0]), sigmoidf_fast(v1[1])); w.w = pk2(sigmoidf_fast(v1[2]), sigmoidf_fast(v1[3]));
                        *(GAS u32x4*)(rowp + bj * 128) = w; } }
            return;
        }
        bf16_t* dst; int pitch, hcol, metaslot; bool kv, donorm; const float* gain; float scale = 1.f;
        if (pn < 2)      { dst = FQ; pitch = 512; hcol = (4 * pn + wc) * 64;       kv = false; donorm = true;  gain = gfq; scale = C2; metaslot = 0; }
        else if (pn < 4) { dst = FK; pitch = 512; hcol = (4 * (pn - 2) + wc) * 64; kv = true;  donorm = true;  gain = gfk; metaslot = 48; }
        else if (pn < 6) { dst = FV; pitch = 512; hcol = (4 * (pn - 4) + wc) * 64; kv = true;  donorm = false; gain = gfk; metaslot = 48; }
        else if (pn < 8) { dst = SQ; pitch = 512; hcol = (4 * (pn - 6) + wc) * 64; kv = false; donorm = true;  gain = gsq; scale = C2; metaslot = 0; }
        else if (wc < 2) { dst = SK; pitch = 128; hcol = wc * 64;                  kv = true;  donorm = true;  gain = gsk; metaslot = 112; }
        else             { dst = SV; pitch = 128; hcol = (wc - 2) * 64;            kv = true;  donorm = false; gain = gsk; metaslot = 112; }
        f32x4 gv[2][2];
#pragma unroll
        for (int bj = 0; bj < 2; ++bj)
#pragma unroll
            for (int n = 0; n < 2; ++n) { const f32x4 gl = *(const GAS f32x4*)(gain + 32 * bj + 8 * fq + 4 * n); gv[bj][n] = gl * (donorm ? scale : 0.f) + (donorm ? 0.f : 1.f); }
#pragma unroll
        for (int ai = 0; ai < 2; ++ai)
#pragma unroll
            for (int m = 0; m < 4; ++m) {
                float ss = 0.f;
#pragma unroll
                for (int bj = 0; bj < 2; ++bj)
#pragma unroll
                    for (int n = 0; n < 2; ++n) { const f32x4 x = acc[ai][bj][m][n]; ss += (x[0] * x[0] + x[1] * x[1]) + (x[2] * x[2] + x[3] * x[3]); }
                ss += __shfl_xor(ss, 16); ss += __shfl_xor(ss, 32);
                const float r = donorm ? __builtin_amdgcn_rsqf(ss * (1.f / 64.f) + RMS_EPS) : 1.f;
                u32x4 w[2];
#pragma unroll
                for (int bj = 0; bj < 2; ++bj) { const f32x4 v0 = acc[ai][bj][m][0] * gv[bj][0] * r, v1 = acc[ai][bj][m][1] * gv[bj][1] * r;
                    w[bj].x = pk2(v0[0], v0[1]); w[bj].y = pk2(v0[2], v0[3]); w[bj].z = pk2(v1[0], v1[1]); w[bj].w = pk2(v1[2], v1[3]); }
                const int lrow = ai * 128 + wr * 64 + m * 16 + fr;
                if (pm < 64) { const int tok = pm * 256 + lrow; const int drow = kv ? (tok >> 12) * LP + 128 + (tok & 4095) : tok;
                    bf16_t* rowp = dst + (size_t)drow * pitch + hcol + 8 * fq;
                    *(GAS u32x4*)(rowp) = w[0]; *(GAS u32x4*)(rowp + 32) = w[1]; }
                else if (lrow < NMETA && kv) {
#pragma unroll
                    for (int b = 0; b < NB; ++b) { bf16_t* rowp = dst + (size_t)(b * LP + metaslot + lrow) * pitch + hcol + 8 * fq;
                        *(GAS u32x4*)(rowp) = w[0]; *(GAS u32x4*)(rowp + 32) = w[1]; } }
            }
    }
};
struct EpiMix {
    static constexpr int NS = 32;
    __device__ __forceinline__ bool relax_ok(const pg8::Unit& u) const { return true; }
    bf16_t* MIX; const bf16_t *GA, *GB;
    __device__ __forceinline__ bool keep_acc(const pg8::Unit& u) const { return u.i2 == 0; }
    __device__ __forceinline__ void operator()(f32x4 (&acc)[2][2][4][2], const pg8::Unit& u, int wr, int wc, int fr, int fq) const {
        const int pm = u.i0, pn = u.i1, part = u.i2;
#pragma unroll
        for (int ai = 0; ai < 2; ++ai) {
            u32x4 ga[4][2], gb[4][2];
#pragma unroll
            for (int m = 0; m < 4; ++m) { const size_t off = (size_t)(pm * 256 + ai * 128 + wr * 64 + m * 16 + fr) * DM + pn * 256 + wc * 32 + 8 * fq;
#pragma unroll
                for (int bj = 0; bj < 2; ++bj) { gb[m][bj] = *(const GAS u32x4*)(GB + off + bj * 128); ga[m][bj] = part ? gb[m][bj] : *(const GAS u32x4*)(GA + off + bj * 128); } }
#pragma unroll
            for (int m = 0; m < 4; ++m) { const size_t off = (size_t)(pm * 256 + ai * 128 + wr * 64 + m * 16 + fr) * DM + pn * 256 + wc * 32 + 8 * fq;
#pragma unroll
                for (int bj = 0; bj < 2; ++bj) { const u32x4 a_ = ga[m][bj], b_ = gb[m][bj]; f32x4& v0 = acc[ai][bj][m][0]; f32x4& v1 = acc[ai][bj][m][1];
                    if (part == 0) {
                        v0[0] *= bflo(a_.x) * __builtin_amdgcn_rcpf(bflo(b_.x)); v0[1] *= bfhi(a_.x) * __builtin_amdgcn_rcpf(bfhi(b_.x)); v0[2] *= bflo(a_.y) * __builtin_amdgcn_rcpf(bflo(b_.y)); v0[3] *= bfhi(a_.y) * __builtin_amdgcn_rcpf(bfhi(b_.y));
                        v1[0] *= bflo(a_.z) * __builtin_amdgcn_rcpf(bflo(b_.z)); v1[1] *= bfhi(a_.z) * __builtin_amdgcn_rcpf(bfhi(b_.z)); v1[2] *= bflo(a_.w) * __builtin_amdgcn_rcpf(bflo(b_.w)); v1[3] *= bfhi(a_.w) * __builtin_amdgcn_rcpf(bfhi(b_.w));
                    } else {
                        u32x4 w; w.x = pk2(v0[0] * bflo(b_.x), v0[1] * bfhi(b_.x)); w.y = pk2(v0[2] * bflo(b_.y), v0[3] * bfhi(b_.y)); w.z = pk2(v1[0] * bflo(b_.z), v1[1] * bfhi(b_.z)); w.w = pk2(v1[2] * bflo(b_.w), v1[3] * bfhi(b_.w));
                        *(GAS u32x4*)(MIX + off + bj * 128) = w; } } }
        }
    }
};
struct EpiOut {
    __device__ __forceinline__ bool keep_acc(const pg8::Unit&) const { return false; }
    static constexpr int NS = 48;
    __device__ __forceinline__ bool relax_ok(const pg8::Unit& u) const { return true; }
    bf16_t* H; const float* X;
    __device__ __forceinline__ void operator()(const f32x4 (&acc)[2][2][4][2], const pg8::Unit& u, int wr, int wc, int fr, int fq) const {
        const int pm = u.i0, pn = u.i1;
#pragma unroll
        for (int ai = 0; ai < 2; ++ai) {
            f32x4 xv[4][2][2];
#pragma unroll
            for (int m = 0; m < 4; ++m) { const size_t off = (size_t)(pm * 256 + ai * 128 + wr * 64 + m * 16 + fr) * DM + pn * 256 + wc * 32 + 8 * fq;
#pragma unroll
                for (int bj = 0; bj < 2; ++bj)
#pragma unroll
                    for (int n = 0; n < 2; ++n) xv[m][bj][n] = __builtin_nontemporal_load((const GAS f32x4*)(X + off + bj * 128 + 4 * n)); }
#pragma unroll
            for (int m = 0; m < 4; ++m) { const size_t off = (size_t)(pm * 256 + ai * 128 + wr * 64 + m * 16 + fr) * DM + pn * 256 + wc * 32 + 8 * fq;
#pragma unroll
                for (int bj = 0; bj < 2; ++bj) { const f32x4 v0 = xv[m][bj][0] + acc[ai][bj][m][0], v1 = xv[m][bj][1] + acc[ai][bj][m][1];
                    u32x4 w; w.x = pk2(v0[0], v0[1]); w.y = pk2(v0[2], v0[3]); w.z = pk2(v1[0], v1[1]); w.w = pk2(v1[2], v1[3]);
                    *(GAS u32x4*)(H + off + bj * 128) = w; } }
        }
    }
};
__device__ __forceinline__ float swiglu_act(float g, float u) {
    g = fminf(g, 7.f); u = fminf(fmaxf(u, -7.f), 7.f);
    return (u + 1.f) * (g * __builtin_amdgcn_rcpf(1.f + __builtin_amdgcn_exp2f(-1.702f * LOG2E * g)));
}
struct EpiUp {
    __device__ __forceinline__ bool keep_acc(const pg8::Unit&) const { return false; }
    static constexpr int NS = 12;
    __device__ __forceinline__ bool relax_ok(const pg8::Unit& u) const { return true; }
    unsigned char* ACT; const float* bup;
    __device__ __forceinline__ void operator()(const f32x4 (&acc)[2][2][4][2], const pg8::Unit& u, int wr, int wc, int fr, int fq) const {
        const int tau = u.i0, pn = u.i1, e = u.i2; const int gcol = pn * 128 + wc * 32 + 8 * fq; constexpr float us = 1.f / (SC_H * SC_W);
        f32x2 bg[4], bu[4];
#pragma unroll
        for (int n = 0; n < 2; ++n) { const f32x4 g4 = *(const GAS f32x4*)(bup + (size_t)e * 2048 + gcol + 4 * n), u4 = *(const GAS f32x4*)(bup + (size_t)e * 2048 + 1024 + gcol + 4 * n);
            bg[2 * n] = (f32x2){g4.x, g4.y}; bg[2 * n + 1] = (f32x2){g4.z, g4.w}; bu[2 * n] = (f32x2){u4.x, u4.y} * SC_A + SC_A; bu[2 * n + 1] = (f32x2){u4.z, u4.w} * SC_A + SC_A; }
#pragma unroll
        for (int ai = 0; ai < 2; ++ai)
#pragma unroll
            for (int m = 0; m < 4; ++m) { const size_t off = (size_t)(tau * 256 + ai * 128 + wr * 64 + m * 16 + fr) * DM + gcol;
                f32x2 o[4];
#pragma unroll
                for (int p = 0; p < 4; ++p) { const f32x4 ag = acc[ai][0][m][p >> 1], au = acc[ai][1][m][p >> 1];
                    f32x2 g = ((p & 1) ? (f32x2){ag.z, ag.w} : (f32x2){ag.x, ag.y}) * us + bg[p];
                    f32x2 uu = ((p & 1) ? (f32x2){au.z, au.w} : (f32x2){au.x, au.y}) * (us * SC_A) + bu[p];
                    g.x = fminf(g.x, 7.f); g.y = fminf(g.y, 7.f);
                    uu.x = __builtin_amdgcn_fmed3f(uu.x, -6.f * SC_A, 8.f * SC_A); uu.y = __builtin_amdgcn_fmed3f(uu.y, -6.f * SC_A, 8.f * SC_A);
                    const f32x2 t = g * (-1.702f * LOG2E); f32x2 d; d.x = __builtin_amdgcn_exp2f(t.x); d.y = __builtin_amdgcn_exp2f(t.y); d = d + 1.f;
                    f32x2 r; r.x = __builtin_amdgcn_rcpf(d.x); r.y = __builtin_amdgcn_rcpf(d.y);
                    o[p] = uu * (g * r); }
                u32x2 w; w.x = pk4_fp8(o[0].x, o[0].y, o[1].x, o[1].y); w.y = pk4_fp8(o[2].x, o[2].y, o[3].x, o[3].y);
                *(GAS u32x2*)(ACT + off) = w; }
    }
};
struct EpiDown {
    __device__ __forceinline__ bool keep_acc(const pg8::Unit&) const { return false; }
    static constexpr int NS = 20;
    __device__ __forceinline__ bool relax_ok(const pg8::Unit& u) const { return (u.i1 >> 8) == 0; }
    unsigned char* YS; const float* bdn; const float* roww; const LAS int* tab;
    __device__ __forceinline__ void operator()(const f32x4 (&acc)[2][2][4][2], const pg8::Unit& u, int wr, int wc, int fr, int fq) const {
        const int tau = u.i0, pn = u.i1 & 255, qm = (u.i1 >> 8) ? (u.i1 >> 8) : 15, e = u.i2, nvalid = u.i3; const int col = pn * 256 + wc * 32 + 8 * fq; const int lt0 = (tau - tab[32 + e]) * 256;
        f32x4 bv[2][2];
#pragma unroll
        for (int bj = 0; bj < 2; ++bj)
#pragma unroll
            for (int n = 0; n < 2; ++n) bv[bj][n] = *(const GAS f32x4*)(bdn + (size_t)e * DM + col + bj * 128 + 4 * n);
        float wv[8];
#pragma unroll
        for (int q = 0; q < 8; ++q) { const int lrow = (q >> 2) * 128 + wr * 64 + (q & 3) * 16 + fr; const int lr = lrow < nvalid ? lrow : 0; wv[q] = roww[(size_t)e * ECAP + lt0 + lr]; wv[q] = lrow < nvalid ? wv[q] : 0.f; }
#pragma unroll
        for (int ai = 0; ai < 2; ++ai)
#pragma unroll
            for (int m = 0; m < 4; ++m) { const int lrow = ai * 128 + wr * 64 + m * 16 + fr; const size_t off = (size_t)(tau * 256 + lrow) * DM + col;
                const float w = wv[ai * 4 + m];
#pragma unroll
                for (int bj = 0; bj < 2; ++bj) { if (!((qm >> (ai * 2 + bj)) & 1)) continue;
                    constexpr float us = 1.f / (SC_A * SC_W); const float ws = w * SC_Y; const f32x4 lim = {448.f, 448.f, 448.f, 448.f};
                    const f32x4 v0 = __builtin_elementwise_min(__builtin_elementwise_max((acc[ai][bj][m][0] * us + bv[bj][0]) * ws, -lim), lim), v1 = __builtin_elementwise_min(__builtin_elementwise_max((acc[ai][bj][m][1] * us + bv[bj][1]) * ws, -lim), lim);
                    u32x2 o; o.x = pk4_fp8(v0[0], v0[1], v0[2], v0[3]); o.y = pk4_fp8(v1[0], v1[1], v1[2], v1[3]);
                    *(GAS u32x2*)(YS + off + bj * 128) = o; } }
    }
};
__device__ __forceinline__ void router_finish(float (&p)[32], float brt, int lane, int lt, LAS int* hist, LAS int* sel_e, LAS float* sel_g, LAS int* sel_r) {
#pragma unroll
    for (int e = 0; e < 16; ++e) { const bool up = (lane & 32) != 0; const float send = up ? p[e] : p[e + 16]; const float keep = up ? p[e + 16] : p[e]; p[e] = keep + __shfl_xor(send, 32); }
#pragma unroll
    for (int e = 0; e < 8; ++e) { const bool up = (lane & 16) != 0; const float send = up ? p[e] : p[e + 8]; const float keep = up ? p[e + 8] : p[e]; p[e] = keep + __shfl_xor(send, 16); }
#pragma unroll
    for (int e = 0; e < 4; ++e) { const bool up = (lane & 8) != 0; const float send = up ? p[e] : p[e + 4]; const float keep = up ? p[e + 4] : p[e]; p[e] = keep + __shfl_xor(send, 8); }
#pragma unroll
    for (int e = 0; e < 2; ++e) { const bool up = (lane & 4) != 0; const float send = up ? p[e] : p[e + 2]; const float keep = up ? p[e + 2] : p[e]; p[e] = keep + __shfl_xor(send, 4); }
    { const bool up = (lane & 2) != 0; const float send = up ? p[0] : p[1]; const float keep = up ? p[1] : p[0]; p[0] = keep + __shfl_xor(send, 2); }
    const float logit = p[0] + __shfl_xor(p[0], 1) + brt;
    const int my_e = lane >> 1;
    float cur = (lane & 1) ? -INFINITY : logit; int rank = 4; float vmax = 0.f;
#pragma unroll
    for (int r = 0; r < 4; ++r) { const float mx = wave_max(cur); const unsigned long long bal = __ballot(cur == mx); const int win = __ffsll((long long)bal) - 1;
        if (r == 0) vmax = mx;
        if (lane == win) { rank = r; cur = -INFINITY; } }
    const bool selected = rank < 4;
    const float ex = selected ? expf(logit - vmax) : 0.f;
    const float den = wave_sum(ex);
    if (selected) { const int lr = __hip_atomic_fetch_add(hist + my_e, 1, __ATOMIC_RELAXED, __HIP_MEMORY_SCOPE_WORKGROUP); sel_e[lt * 4 + rank] = my_e; sel_g[lt * 4 + rank] = ex / den; sel_r[lt * 4 + rank] = lr; }
}
__device__ __forceinline__ void naive_attn_row(const bf16_t* q, const bf16_t* Kb, const bf16_t* Vb, int pitch, const float* bias, int k0, int k1, bool has_sink, float sinkv, bf16_t* out, int lane) {
    u32x4 qw[8];
#pragma unroll
    for (int j = 0; j < 8; ++j) qw[j] = *(const GAS u32x4*)(q + 8 * j);
    float m = -1e20f, l = 0.f, o = 0.f;
    for (int kb = k0; kb <= k1; kb += 64) {
        const int k = kb + lane; const bool valid = k <= k1; const int kc = valid ? k : k1;
        const bf16_t* kr = Kb + (size_t)kc * pitch;
        float s = 0.f;
#pragma unroll
        for (int j = 0; j < 8; ++j) { const u32x4 kw = *(const GAS u32x4*)(kr + 8 * j);
            s += bflo(qw[j].x) * bflo(kw.x) + bfhi(qw[j].x) * bfhi(kw.x) + bflo(qw[j].y) * bflo(kw.y) + bfhi(qw[j].y) * bfhi(kw.y)
               + bflo(qw[j].z) * bflo(kw.z) + bfhi(qw[j].z) * bfhi(kw.z) + bflo(qw[j].w) * bflo(kw.w) + bfhi(qw[j].w) * bfhi(kw.w); }
        s = valid ? s - bias[kc] : -BIGB;
        const float mn = fmaxf(m, wave_max(s));
        const float alpha = __builtin_amdgcn_exp2f(m - mn);
        const float p = __builtin_amdgcn_exp2f(s - mn);
        l = l * alpha + wave_sum(p); o *= alpha; m = mn;
        const int nk = (k1 - kb + 1 < 64) ? (k1 - kb + 1) : 64;
        for (int j = 0; j < nk; ++j) { const float pj = __shfl(p, j); o += pj * bf2f(Vb[(size_t)(kb + j) * pitch + lane]); }
    }
    if (has_sink) l += __builtin_amdgcn_exp2f(sinkv - m);
    out[lane] = (bf16_t)f2bf(o / l);
}

#define in_x     (args.in[0])
#define meta     (args.in[1])
#define g1       (args.in[2])
#define w_in     (args.in[3])
#define b_forget (args.in[4])
#define gfq      (args.in[5])
#define gfk      (args.in[6])
#define gsq      (args.in[7])
#define gsk      (args.in[8])
#define sinks    (args.in[9])
#define w_fo     (args.in[10])
#define w_so     (args.in[11])
#define w_out    (args.in[12])
#define g2       (args.in[13])
#define w_router (args.in[14])
#define b_router (args.in[15])
#define w_up     (args.in[16])
#define b_up     (args.in[17])
#define w_down   (args.in[18])
#define b_down   (args.in[19])
#define WIN  ((bf16_t*)(ws + WS_WIN))
#define WFO  ((bf16_t*)(ws + WS_WFO))
#define WSO  ((bf16_t*)(ws + WS_WSO))
#define WOUT ((bf16_t*)(ws + WS_WOUT))
#define WUP  ((unsigned char*)(ws + WS_WUP))
#define WDN  ((unsigned char*)(ws + WS_WDN))
#define XN   ((bf16_t*)(ws + WS_XN))
#define LOGF ((float*)(ws + WS_LOGF))
#define FB   ((float*)(ws + WS_FB))
#define SBIAS ((float*)(ws + WS_SBIAS))
#define FQ   ((bf16_t*)(ws + WS_FQ))
#define FK   ((bf16_t*)(ws + WS_FK))
#define FV   ((bf16_t*)(ws + WS_FV))
#define SQ   ((bf16_t*)(ws + WS_SQ))
#define SK   ((bf16_t*)(ws + WS_SK))
#define SV   ((bf16_t*)(ws + WS_SV))
#define GA   ((bf16_t*)(ws + WS_GA))
#define GB   ((bf16_t*)(ws + WS_GB))
#define OA   ((bf16_t*)(ws + WS_OA))
#define OB   ((bf16_t*)(ws + WS_OB))
#define MIX  ((bf16_t*)(ws + WS_MIX))
#define HRES ((bf16_t*)(ws + WS_HRES))
#define H2   ((unsigned char*)(ws + WS_H2))
#define TOKDEST ((int*)(ws + WS_TOKDEST))
#define ROWTOK ((int*)(ws + WS_ROWTOK))
#define ROWW ((float*)(ws + WS_ROWW))
#define ACT  ((unsigned char*)(ws + WS_ACT))
#define YS   ((unsigned char*)(ws + WS_YS))
__global__ void __launch_bounds__(NWAVES * 64, 2) hybrid_fwd(Args args) {
    extern __shared__ __attribute__((aligned(16))) unsigned char lds_raw[];
    Frame F;
    F.lds = (LAS unsigned char*)lds_raw;
    F.MISC = (volatile LAS unsigned*)(F.lds + MISC_OFF);
    F.tid = threadIdx.x; F.lane = F.tid & 63; F.wave = __builtin_amdgcn_readfirstlane(F.tid >> 6);
    F.G = gridDim.x; F.gw = blockIdx.x * NWAVES + F.wave; F.NGW = F.G * NWAVES;
    F.ws = args.ws; F.ctl = (gu32*)(F.ws + WS_CTL);
    unsigned char* ws = args.ws;
    const int tid = F.tid, lane = F.lane, wave = F.wave, gw = F.gw, NGW = F.NGW, c = blockIdx.x, G = F.G;
    for (int u = tid; u < (LDS_BYTES - LDSCTL_OFF) / 4; u += NWAVES * 64) ((LAS unsigned*)(F.lds + LDSCTL_OFF))[u] = 0u;
    __syncthreads();
    XcdBarrier bar = xcd_barrier_post((unsigned*)(F.ctl + CW_BAR), F.MISC + 8);

    LAS int* tab = (LAS int*)(F.lds + TAB_OFF);

#ifndef NO_P0
    {
        LAS float* scr = (LAS float*)(F.lds + RING_OFF + wave * 17664);
        for (int i = gw; i < NB * 112; i += NGW) { const int b = i / 112, r = i % 112, slot = (r < 48) ? r : r + 16;
            GAS u32x4* pk = (GAS u32x4*)(FK + (size_t)(b * LP + slot) * 512) + lane; GAS u32x4* pv = (GAS u32x4*)(FV + (size_t)(b * LP + slot) * 512) + lane;
            *pk = (u32x4){0u, 0u, 0u, 0u}; *pv = (u32x4){0u, 0u, 0u, 0u};
            if (lane < 16) { *((GAS u32x4*)(SK + (size_t)(b * LP + r) * 128) + lane) = (u32x4){0u, 0u, 0u, 0u}; *((GAS u32x4*)(SV + (size_t)(b * LP + r) * 128) + lane) = (u32x4){0u, 0u, 0u, 0u}; } }
        for (int i = gw * 64 + lane; i < 8 * LP; i += NGW * 64) { const int h = i / LP, slot = i % LP; const float slope = exp2f(-(float)(h + 1));
            SBIAS[i] = (slot < 112) ? BIGB : -slope * (float)slot * LOG2E; }
        for (int m = NTOK + NMETA + gw; m < MROWS; m += NGW) { GAS u32x2* o8 = (GAS u32x2*)(XN + (size_t)m * DM) + lane;
#pragma unroll
            for (int j = 0; j < 4; ++j) o8[64 * j] = (u32x2){0u, 0u}; }
        if (wave < 4) {
            f32x4 wf[16][2];
#pragma unroll
            for (int q = 0; q < 16; ++q) { const float* wp = w_in + (size_t)(4 * lane + 256 * (q >> 2) + (q & 3)) * INW + 1536; wf[q][0] = *(const GAS f32x4*)wp; wf[q][1] = *(const GAS f32x4*)(wp + 4); }
            const int NRW = G * 4;
            for (int m0 = c * 4 + wave; m0 < NTOK + NMETA; m0 += 2 * NRW) {
                const int m1 = m0 + NRW; const bool has1 = m1 < NTOK + NMETA; const int mm[2] = {m0, has1 ? m1 : m0};
                f32x4 v[2][4]; float s2[2] = {0.f, 0.f};
#pragma unroll
                for (int r = 0; r < 2; ++r) { const float* xrow = (mm[r] < NTOK) ? in_x + (size_t)mm[r] * DM : meta + (size_t)(mm[r] - NTOK) * DM; const GAS f32x4* xr = (const GAS f32x4*)xrow + lane;
#pragma unroll
                    for (int j = 0; j < 4; ++j) v[r][j] = __builtin_nontemporal_load(xr + 64 * j); }
#pragma unroll
                for (int r = 0; r < 2; ++r)
#pragma unroll
                    for (int j = 0; j < 4; ++j) s2[r] += (v[r][j].x * v[r][j].x + v[r][j].y * v[r][j].y) + (v[r][j].z * v[r][j].z + v[r][j].w * v[r][j].w);
                s2[0] = wave_sum(s2[0]); s2[1] = wave_sum(s2[1]);
                float fl[2][8];
#pragma unroll
                for (int r = 0; r < 2; ++r) { const float rstd = 1.f / sqrtf(s2[r] * (1.f / DM) + RMS_EPS);
#pragma unroll
                    for (int h = 0; h < 8; ++h) fl[r][h] = 0.f;
                    GAS u32x2* o8 = (GAS u32x2*)(XN + (size_t)mm[r] * DM) + lane;
#pragma unroll
                    for (int j = 0; j < 4; ++j) { const f32x4 gg = *((const GAS f32x4*)g1 + lane + 64 * j); v[r][j] = v[r][j] * rstd * gg;
                        if (r == 0 || has1) o8[64 * j] = (u32x2){pk2(v[r][j].x, v[r][j].y), pk2(v[r][j].z, v[r][j].w)};
#pragma unroll
                        for (int cc = 0; cc < 4; ++cc) { const float hv = v[r][j][cc]; const f32x4 w0 = wf[4 * j + cc][0], w1 = wf[4 * j + cc][1];
                            fl[r][0] += hv * w0.x; fl[r][1] += hv * w0.y; fl[r][2] += hv * w0.z; fl[r][3] += hv * w0.w; fl[r][4] += hv * w1.x; fl[r][5] += hv * w1.y; fl[r][6] += hv * w1.z; fl[r][7] += hv * w1.w; } } }
#pragma unroll
                for (int r = 0; r < 2; ++r)
#pragma unroll
                    for (int h = 0; h < 8; ++h) fl[r][h] = wave_sum(fl[r][h]);
#pragma unroll
                for (int r = 0; r < 2; ++r)
                    if (lane < 8 && (r == 0 || has1)) { float z = 0.f;
#pragma unroll
                        for (int h = 0; h < 8; ++h) z = (lane == h) ? fl[r][h] : z;
                        z += b_forget[lane];
                        LOGF[(size_t)mm[r] * 8 + lane] = fminf(z, 0.f) - log1pf(expf(-fabsf(z))); }
            }
        }
        constexpr int I_IN = 16 * (NPHYS / 32), I_FO = 8 * 32, I_SO = 8 * 32, I_OUT = 16 * 32, NITEMS = I_IN + I_FO + I_SO + I_OUT;
        constexpr int I_UP = NE * 8 * 64, I_DN = NE * 8 * 32;
        const int fp8_per_wg = 0, ntask = (NITEMS / 2 + G - 1) / G;
        (void)I_UP; (void)I_DN;
        LAS int* qctr = (LAS int*)(F.lds + MISC_OFF + 132);
        for (;;) {
            int t = 0; if (lane == 0) t = __hip_atomic_fetch_add(qctr, 1, __ATOMIC_RELAXED, __HIP_MEMORY_SCOPE_WORKGROUP);
            t = __builtin_amdgcn_readfirstlane(t);
            if (t >= ntask) break;
            if (t < fp8_per_wg) { const int it = c * fp8_per_wg + t;
                if (it < I_UP) { const int e = it / (8 * 64), q = it % (8 * 64), kb = q / 64, nb = q % 64;
                    const int lcol = ((nb >> 2) & 1) * 1024 + (nb >> 3) * 128 + (nb & 3) * 32;
                    tr8_item(w_up + (size_t)e * DM * 2048, 2048, lcol, kb * 128, WUP + (size_t)e * 2048 * DM, DM, nb * 32, scr, lane); }
                else { const int r = it - I_UP, e = r / (8 * 32), q = r % (8 * 32), kb = q / 32, nb = q % 32;
                    tr8_item(w_down + (size_t)e * DM * DM, DM, nb * 32, kb * 128, WDN + (size_t)e * DM * DM, DM, nb * 32, scr, lane); }
            } else { const int it = 2 * (c + (t - fp8_per_wg) * G); if (it >= NITEMS) continue;
                TrItem ti[2];
#pragma unroll
                for (int q2 = 0; q2 < 2; ++q2) { int r = it + q2; TrItem tt;
                    if (r < I_IN) { const int kb = r / (NPHYS / 32), nb = r % (NPHYS / 32); tt = TrItem{w_in, INW, win_logical_col(nb * 32), kb * 64, WIN, DM, nb * 32}; }
                    else if ((r -= I_IN) < I_FO) { const int kb = r / 32, nb = r % 32; tt = TrItem{w_fo, DM, nb * 32, kb * 64, WFO, 512, nb * 32}; }
                    else if ((r -= I_FO) < I_SO) { const int kb = r / 32, nb = r % 32; tt = TrItem{w_so, DM, nb * 32, kb * 64, WSO, 512, nb * 32}; }
                    else { r -= I_SO; const int kb = r / 32, nb = r % 32; tt = TrItem{w_out, DM, nb * 32, kb * 64, WOUT, DM, nb * 32}; }
                    ti[q2] = tt; }
                f32x4 va[8], vb[8];
                tr_load(ti[0], va, lane); tr_load(ti[1], vb, lane);
                tr_store(ti[0], va, scr, lane); tr_store(ti[1], vb, scr, lane);
            }
        }
    }
#endif
    xcd_barrier(bar);

#ifndef NO_P1
    if (c >= G - 32) {
        const int tid = fresh_tid(), lane = tid & 63;
        const int bh_ = c - (G - 32), b = bh_ >> 3, h = bh_ & 7; LAS float* sc = (LAS float*)(F.lds + RING_OFF);
        float v[9]; float run = 0.f;
#pragma unroll
        for (int j = 0; j < 9; ++j) { const int t = 9 * tid + j; float lf = 0.f;
            if (t < NMETA + SEQ) lf = (t < NMETA) ? LOGF[(size_t)(NTOK + t) * 8 + h] : LOGF[(size_t)(b * SEQ + t - NMETA) * 8 + h];
            run += lf; v[j] = run; }
        sc[tid] = run; __syncthreads();
        if (wave == 0) { float carry = 0.f;
            for (int k = 0; k < 8; ++k) { float xv = sc[k * 64 + lane]; float inc = xv;
#pragma unroll
                for (int o = 1; o < 64; o <<= 1) { const float y = __shfl_up(inc, o); if (lane >= o) inc += y; }
                sc[k * 64 + lane] = carry + inc - xv; carry += __shfl(inc, 63); } }
        __syncthreads();
        const float base = sc[tid]; float* fb = FB + (size_t)(b * 8 + h) * LP;
#pragma unroll
        for (int j = 0; j < 9; ++j) { const int t = 9 * tid + j; if (t < NMETA + SEQ) { const int slot = (t < NMETA) ? 48 + t : 128 + (t - NMETA); fb[slot] = (base + v[j]) * LOG2E; } }
        if (tid < 112) fb[(tid < 48) ? tid : tid + 16] = BIGB;
        __syncthreads();
    }
    {
        SchedIn S{G, c, 0, IN_P1, (const char*)XN, (const char*)WIN};
        EpiIn E{FQ, FK, FV, SQ, SK, SV, GA, GB, gfq, gfk, gsq, gsk};
        pg8::gemm_phase<2 * DM, false, false, EpiIn, SchedIn>(F.lds + RING_OFF, S, E);
    }
    if (c >= G - 32) {
        conv_batch(2 * (c - (G - 32)), w_up, w_down, WUP, WDN, F.lds + RING_OFF);
        conv_batch(2 * (c - (G - 32)) + 1, w_up, w_down, WUP, WDN, F.lds + RING_OFF);
    }
#endif
    xcd_barrier(bar);

#ifndef NO_P2
#ifdef NAIVE_ATTN
    for (int T = gw; T < 2 * NTOK * 8; T += NGW) {
        const int which = T / (NTOK * 8), r = T % (NTOK * 8), h = r & 7, tokp = r >> 3;
        const int tok = tokp; const int b = tok >> 12, s = tok & 4095;
        if (which == 0) naive_attn_row(FQ + (size_t)tok * 512 + h * 64, FK + (size_t)b * LP * 512 + h * 64, FV + (size_t)b * LP * 512 + h * 64, 512, FB + (size_t)(b * 8 + h) * LP, 0, 128 + s, false, 0.f, OA + (size_t)tok * 512 + h * 64, lane);
        else { const int p = 128 + s; const float slope = exp2f(-(float)(h + 1));
            naive_attn_row(SQ + (size_t)tok * 512 + h * 64, SK + (size_t)b * LP * 128 + (h >> 2) * 64, SV + (size_t)b * LP * 128 + (h >> 2) * 64, 128, SBIAS + (size_t)h * LP, p - 127, p, true, (sinks[h] + slope * (float)p) * LOG2E, OB + (size_t)tok * 512 + h * 64, lane); }
    }
#else
    {
        {
            SchedIn S{G, c, IN_P1, IN_ALL, (const char*)XN, (const char*)WIN};
            EpiIn E{FQ, FK, FV, SQ, SK, SV, GA, GB, gfq, gfk, gsq, gsk};
            pg8::gemm_phase<2 * DM, false, false, EpiIn, SchedIn>(F.lds + RING_OFF, S, E);
        }
        char* shm = (char*)lds_raw + RING_OFF;
        const int tid = fresh_tid(), lane = tid & 63;
        float gq = fabsf(gfq[lane]), gk = fabsf(gfk[lane]); gq = wave_max(gq); gk = wave_max(gk);
        const float prune_thr = 2.f * (64.f * gq * gk * C2) + 40.f;
        volatile LAS int* qslot = (volatile LAS int*)(F.lds + MISC_OFF + 128);
        int unext = 0;
        if (tid == 0) unext = (int)__hip_atomic_fetch_add((unsigned*)(F.ctl + CW_QUEUE), 1u, __ATOMIC_RELAXED, __HIP_MEMORY_SCOPE_AGENT);
        for (;;) {
            if (tid == 0) *qslot = unext;
            __syncthreads();
            const int uq = __builtin_amdgcn_readfirstlane(*qslot);
            if (uq >= 1024 + NCB_P2) break;
            if (tid == 0) unext = (int)__hip_atomic_fetch_add((unsigned*)(F.ctl + CW_QUEUE), 1u, __ATOMIC_RELAXED, __HIP_MEMORY_SCOPE_AGENT);
            if (uq < 2 * NCB_P2 && (uq & 1)) { conv_batch(NCB_P1 + (uq >> 1), w_up, w_down, WUP, WDN, F.lds + RING_OFF); continue; }
            const int u = (uq < 2 * NCB_P2) ? (uq >> 1) : uq - NCB_P2;
            if (u < 512) {
                const int j = 15 - (u >> 5), b = (u >> 3) & 3, h = u & 7; int NT = 4 * j + 6;
                const float* fb = FB + (size_t)(b * 8 + h) * LP; const int refidx = 128 + 256 * j;
                int ts = 0;
                { const float bref = fb[refidx]; bool c0 = false, c1 = false; const int t0 = lane, t1 = lane + 64;
                  if (t0 >= 2 && t0 <= NT - 7) c0 = (fb[64 * t0 + 63] - bref) >= prune_thr;
                  if (t1 <= NT - 7) c1 = (fb[64 * t1 + 63] - bref) >= prune_thr;
                  const unsigned long long m0 = __ballot(c0), m1 = __ballot(c1);
                  if (m1) ts = 64 + (63 - __builtin_clzll(m1)) + 1; else if (m0) ts = (63 - __builtin_clzll(m0)) + 1;
                  ts &= ~1; ts = __builtin_amdgcn_readfirstlane(ts); }
                NT -= ts;
                attn::attn_unit<512, false, 8>(FQ + (size_t)(b * SEQ + 256 * j) * 512 + h * 64, FK + ((size_t)b * LP + 64 * ts) * 512 + h * 64, FV + ((size_t)b * LP + 64 * ts) * 512 + h * 64,
                                               OA + (size_t)(b * SEQ + 256 * j) * 512 + h * 64, NT, fb + 64 * ts, refidx - 64 * ts, 0.f, 0.f, shm);
            } else {
                const int w = u - 512, b = w >> 7, h = (w >> 4) & 7, j = w & 15, g = h >> 2; const float slope = exp2f(-(float)(h + 1));
                attn::attn_unit<128, true, 8>(SQ + (size_t)(b * SEQ + 256 * j) * 512 + h * 64, SK + ((size_t)b * LP + 256 * j) * 128 + g * 64, SV + ((size_t)b * LP + 256 * j) * 128 + g * 64,
                                              OB + (size_t)(b * SEQ + 256 * j) * 512 + h * 64, 6, SBIAS + (size_t)h * LP + 256 * j, 128, sinks[h] * LOG2E, slope * LOG2E, shm);
            }
        }
    }
#endif
#endif
    xcd_barrier(bar);

#ifndef NO_P3
    {
        SchedMix S{G, c, (const char*)OA, (const char*)OB, (const char*)WFO, (const char*)WSO};
        EpiMix E{MIX, GA, GB};
        pg8::gemm_phase<2 * 512, false, false, EpiMix, SchedMix>(F.lds + RING_OFF, S, E);
    }
#endif
    xcd_barrier(bar);

#ifndef NO_P4
    {
        SchedOut S{G, c, (const char*)MIX, (const char*)WOUT};
        EpiOut E{HRES, in_x};
        pg8::gemm_phase<2 * DM, false, false, EpiOut, SchedOut>(F.lds + RING_OFF, S, E);
    }
#endif
    xcd_barrier(bar);

#if defined(STOP_AFTER) && STOP_AFTER == 4
    for (int tok = gw; tok < NTOK; tok += NGW) {
#pragma unroll
        for (int j = 0; j < 4; ++j) *((GAS f32x4*)(args.out + (size_t)tok * DM) + lane + 64 * j) = *((const GAS f32x4*)(HRES + (size_t)tok * DM) + lane + 64 * j); }
    return;
#endif
#ifndef NO_P5
    {
        const int tid = fresh_tid(), lane = tid & 63;
        LAS float* WRT = (LAS float*)(F.lds + RING_OFF);
        { f32x4 wv_[16];
#pragma unroll
          for (int k = 0; k < 16; ++k) wv_[k] = *((const GAS f32x4*)w_router + tid + 512 * k);
#pragma unroll
          for (int k = 0; k < 16; ++k) { const int i4 = (tid + 512 * k) * 4, d = i4 >> 5, e0 = i4 & 31; WRT[(e0 + 0) * DM + d] = wv_[k].x; WRT[(e0 + 1) * DM + d] = wv_[k].y; WRT[(e0 + 2) * DM + d] = wv_[k].z; WRT[(e0 + 3) * DM + d] = wv_[k].w; } }
        LAS int* hist = tab + 96; LAS int* basee = tab + 128;
        LAS int* sel_e = (LAS int*)(F.lds + ROWS_OFF); LAS float* sel_g = (LAS float*)(F.lds + ROWS_OFF + 1024); LAS int* sel_r = (LAS int*)(F.lds + ROWS_OFF + 2048);
        if (tid < 32) hist[tid] = 0;
        __syncthreads();
        const int ntb = NTOK / G;
        constexpr int NTK = 4;
        for (int lt0 = wave * NTK; lt0 < ntb; lt0 += NWAVES * NTK) {
            f32x4 v[NTK][4]; float s2[NTK];
#pragma unroll
            for (int q = 0; q < NTK; ++q) { const GAS u32x2* hr = (const GAS u32x2*)(HRES + (size_t)(c * ntb + lt0 + q) * DM) + lane;
#pragma unroll
                for (int j = 0; j < 4; ++j) { const u32x2 w = hr[64 * j]; v[q][j] = (f32x4){bflo(w.x), bfhi(w.x), bflo(w.y), bfhi(w.y)}; } }
#pragma unroll
            for (int q = 0; q < NTK; ++q) { float a = 0.f;
#pragma unroll
                for (int j = 0; j < 4; ++j) a += (v[q][j].x * v[q][j].x + v[q][j].y * v[q][j].y) + (v[q][j].z * v[q][j].z + v[q][j].w * v[q][j].w);
                s2[q] = a; }
#pragma unroll
            for (int q = 0; q < NTK; ++q) s2[q] = wave_sum(s2[q]);
#pragma unroll
            for (int q = 0; q < NTK; ++q) { const float rstd = 1.f / sqrtf(s2[q] * (1.f / DM) + RMS_EPS);
                GAS unsigned* o8 = (GAS unsigned*)(H2 + (size_t)(c * ntb + lt0 + q) * DM) + lane;
#pragma unroll
                for (int j = 0; j < 4; ++j) { const f32x4 gg = *((const GAS f32x4*)g2 + lane + 64 * j); v[q][j] = v[q][j] * rstd * gg; const f32x4 qq = __builtin_elementwise_min(__builtin_elementwise_max(v[q][j] * SC_H, (f32x4){-448.f, -448.f, -448.f, -448.f}), (f32x4){448.f, 448.f, 448.f, 448.f}); o8[64 * j] = pk4_fp8(qq.x, qq.y, qq.z, qq.w); } }
            float pe[NTK][32];
            unsigned wb0 = (unsigned)(RING_OFF + 16 * lane), wb1 = wb0 + 65536u; asm volatile("" : "+v"(wb0), "+v"(wb1));
#pragma unroll
            for (int e = 0; e < 32; ++e) { float a[NTK]; _Pragma("unroll") for (int q = 0; q < NTK; ++q) a[q] = 0.f; const unsigned wb = (e < 16) ? wb0 : wb1;
#pragma unroll
                for (int j = 0; j < 4; ++j) { const f32x4 w = *(const LAS f32x4*)(F.lds + wb + ((e & 15) * 4096 + j * 1024));
#pragma unroll
                    for (int q = 0; q < NTK; ++q) a[q] += (v[q][j].x * w.x + v[q][j].y * w.y) + (v[q][j].z * w.z + v[q][j].w * w.w); }
#pragma unroll
                for (int q = 0; q < NTK; ++q) { asm volatile("" : "+v"(a[q])); pe[q][e] = a[q]; } }
            const int my_e = lane >> 1;
            const float brt = b_router[my_e];
            router_finish(pe[0], brt, lane, lt0 + 0, hist, sel_e, sel_g, sel_r);
            if constexpr (NTK > 1) router_finish(pe[1 % NTK], brt, lane, lt0 + 1, hist, sel_e, sel_g, sel_r);
            if constexpr (NTK > 2) { router_finish(pe[2 % NTK], brt, lane, lt0 + 2, hist, sel_e, sel_g, sel_r); router_finish(pe[3 % NTK], brt, lane, lt0 + 3, hist, sel_e, sel_g, sel_r); }
        }
        __syncthreads();
        if (tid < 32) basee[tid] = (int)atomicAdd((unsigned*)(F.ctl + CW_CNT + 64 * tid), (unsigned)hist[tid]);
        __syncthreads();
        for (int i = tid; i < ntb * 4; i += NWAVES * 64) { const int tok = c * ntb + (i >> 2); const int e = sel_e[i]; const int pos = basee[e] + sel_r[i];
            ROWTOK[(size_t)e * ECAP + pos] = tok; ROWW[(size_t)e * ECAP + pos] = sel_g[i]; TOKDEST[(size_t)tok * 4 + (i & 3)] = e * ECAP + pos; }
    }
#endif
    xcd_barrier(bar);

    int T_tiles;
    {
        const int tid = fresh_tid();
        if (tid < 32) tab[tid] = (int)__hip_atomic_load(F.ctl + CW_CNT + 64 * tid, RLX_AGENT);
        __syncthreads();
        if (tid < 64) { const int nt_ = (tid < NE) ? ((tab[tid] + 255) >> 8) : 0; int inc = nt_;
#pragma unroll
            for (int o = 1; o < 32; o <<= 1) { const int y = __shfl_up(inc, o); if ((tid & 63) >= o) inc += y; }
            if (tid < NE) tab[32 + tid] = inc - nt_; if (tid == NE - 1) tab[32 + NE] = inc; }
        __syncthreads();
        T_tiles = tab[32 + NE];
    }
#ifndef NO_P6
    {
        const int tid = fresh_tid();
        LAS int* utab = (LAS int*)(F.lds + UTAB_OFF); moe_units(utab, tab, T_tiles, 8, G, c, tid, false);
        SchedMoe S{G, c, 8, utab, (const char*)H2, (const char*)WUP, 1, DM};
        for (int i = 0; i < 10; ++i) { pg8::Unit u; if (!S.next(i, u)) break;
            if (tid < 256) { const int e = u.i2, lt0 = (u.i0 - tab[32 + e]) * 256; ((LAS int*)(F.lds + ROWS_OFF + i * 1024))[tid] = (tid < u.i3) ? ROWTOK[(size_t)e * ECAP + lt0 + tid] : 0; } }
        __syncthreads();
        EpiUp E{ACT, b_up};
        pg8::gemm_phase<DM, true, true, EpiUp, SchedMoe>(F.lds + RING_OFF, S, E);
        volatile LAS int* qslot = (volatile LAS int*)(F.lds + MISC_OFF + 128);
        for (;;) {
            if (fresh_tid() == 0) *qslot = (int)__hip_atomic_fetch_add((unsigned*)(F.ctl + CW_QUEUE + 64), 1u, __ATOMIC_RELAXED, __HIP_MEMORY_SCOPE_AGENT);
            __syncthreads();
            const int b6 = __builtin_amdgcn_readfirstlane(*qslot);
            __syncthreads();
            if (b6 >= NCB_P6) break;
            conv_batch(1024 - NCB_P6 + b6, w_up, w_down, WUP, WDN, F.lds + RING_OFF);
        }
    }
#endif
    xcd_barrier(bar);

#ifndef NO_P7
    {
        LAS int* utab = (LAS int*)(F.lds + UTAB_OFF); moe_units(utab, tab, T_tiles, 4, G, c, fresh_tid(), true);
        SchedMoe S{G, c, 4, utab, (const char*)ACT, (const char*)WDN, 0, DM};
        EpiDown E{YS, b_down, ROWW, tab};
        pg8::gemm_phase<DM, true, false, EpiDown, SchedMoe, true>(F.lds + RING_OFF, S, E);
    }
#endif
    xcd_barrier(bar);

#ifndef NO_P8
    {
        const int lane = fresh_tid() & 63;
        const bool poison = (__hip_atomic_load(F.ctl + CW_BAR + XB_TMO, RLX_AGENT) != 0u) || (T_tiles > MAXTILES);
        for (int tok0 = gw; tok0 < NTOK; tok0 += 2 * NGW) {
            const int tk[2] = {tok0, tok0 + NGW};
            u32x4 y[2][4]; u32x4 hb[2][2];
#pragma unroll
            for (int q = 0; q < 2; ++q) {
#pragma unroll
                for (int k = 0; k < 4; ++k) { const int d = TOKDEST[(size_t)tk[q] * 4 + k]; const int e = d / ECAP, pos = d % ECAP; const int row = tab[32 + e] * 256 + pos;
                    y[q][k] = __builtin_nontemporal_load((const GAS u32x4*)(YS + (size_t)row * DM) + lane); }
#pragma unroll
                for (int j = 0; j < 2; ++j) hb[q][j] = *((const GAS u32x4*)(HRES + (size_t)tk[q] * DM) + 2 * lane + j); }
#pragma unroll
            for (int q = 0; q < 2; ++q)
#pragma unroll
                for (int j = 0; j < 4; ++j) { f32x2 lo = {0.f, 0.f}, hi = {0.f, 0.f};
#pragma unroll
                    for (int k = 0; k < 4; ++k) { const unsigned w = y[q][k][j]; lo += __builtin_amdgcn_cvt_pk_f32_fp8((int)w, false); hi += __builtin_amdgcn_cvt_pk_f32_fp8((int)w, true); }
                    const unsigned h0 = hb[q][j >> 1][2 * (j & 1)], h1 = hb[q][j >> 1][2 * (j & 1) + 1]; f32x4 a = {bflo(h0), bfhi(h0), bflo(h1), bfhi(h1)}; a.x += lo.x * (1.f / SC_Y); a.y += lo.y * (1.f / SC_Y); a.z += hi.x * (1.f / SC_Y); a.w += hi.y * (1.f / SC_Y);
                    if (poison) a = (f32x4){__builtin_nanf(""), __builtin_nanf(""), __builtin_nanf(""), __builtin_nanf("")};
                    __builtin_nontemporal_store(a, (GAS f32x4*)(args.out + (size_t)tk[q] * DM) + 4 * lane + j); }
        }
    }
#endif
}

extern "C" void kernel_launch(void* const* d_in, const int* in_sizes, int n_in, void* d_out, int out_size, void* d_ws, size_t ws_size, hipStream_t stream) {
    static int grid = 0;
    if (grid == 0) {
        if (n_in != 20 || in_sizes[0] != NTOK * DM || out_size != NTOK * DM || ws_size < WS_END) { fprintf(stderr, "kernel_launch: unexpected shapes / workspace (%d inputs, ws %zu)\n", n_in, ws_size); grid = -1; return; }
        int dev = 0, cus = 0, per_cu = 0;
        if (hipGetDevice(&dev) != hipSuccess || hipDeviceGetAttribute(&cus, hipDeviceAttributeMultiprocessorCount, dev) != hipSuccess) { grid = -1; return; }
        if (hipFuncSetAttribute((const void*)hybrid_fwd, hipFuncAttributeMaxDynamicSharedMemorySize, LDS_BYTES) != hipSuccess) { grid = -1; return; }
        if (hipOccupancyMaxActiveBlocksPerMultiprocessor(&per_cu, (const void*)hybrid_fwd, NWAVES * 64, LDS_BYTES) != hipSuccess || per_cu < 1) { fprintf(stderr, "kernel_launch: occupancy query says %d\n", per_cu); }
        (void)hipGetLastError();
        grid = cus;
        if (grid > 256) grid = 256;
    }
    if (grid < 0) return;
    if (hipMemsetAsync((char*)d_ws + WS_CTL, 0, CTL_ZERO_BYTES, stream) != hipSuccess) return;
    Args a{};
    for (int i = 0; i < 20; ++i) a.in[i] = (const float*)d_in[i];
    a.out = (float*)d_out; a.ws = (unsigned char*)d_ws;
    hipLaunchKernelGGL(hybrid_fwd, dim3(grid), dim3(NWAVES * 64), LDS_BYTES, stream, a);
}
```

```cpp
#include <hip/hip_runtime.h>
#include <cstdio>
#include <cstdint>

#define GAS __attribute__((address_space(1)))
#define LAS __attribute__((address_space(3)))
typedef unsigned short bf16_t;
typedef short bf16x8 __attribute__((ext_vector_type(8)));
typedef float f32x4 __attribute__((ext_vector_type(4)));
typedef float f32x2 __attribute__((ext_vector_type(2)));
typedef unsigned u32x4 __attribute__((ext_vector_type(4)));
typedef unsigned u32x2 __attribute__((ext_vector_type(2)));
typedef GAS unsigned gu32;
typedef int i32x4 __attribute__((ext_vector_type(4)));
typedef int i32x8 __attribute__((ext_vector_type(8)));
#define RLX_AGENT __ATOMIC_RELAXED, __HIP_MEMORY_SCOPE_AGENT
#define LDS_WAIT() asm volatile("s_waitcnt lgkmcnt(0)" ::: "memory")
#define VM_WAIT() asm volatile("s_waitcnt vmcnt(0)" ::: "memory")

constexpr int NB = 4, SEQ = 4096, DM = 1024, NTOK = NB * SEQ, NMETA = 16, MROWS = 16640, LP = 4224;
constexpr int HD = 64, NE = 32, INW = 4360, NPHYS = 4352;
constexpr int MAXTILES = 288, MAXROWS = MAXTILES * 256, ECAP = 16384;
constexpr float RMS_EPS = 1e-6f, LOG2E = 1.4426950408889634f, C2 = 0.125f * LOG2E, BIGB = 1e30f;
constexpr int NWAVES = 8;
constexpr float SC_W = 256.f, SC_H = 16.f, SC_A = 4.f, SC_Y = 64.f;

constexpr size_t MiB = 1u << 20;
constexpr size_t WS_CTL = 0, CTL_ZERO_BYTES = 1 * MiB;
constexpr size_t WS_WIN = 2 * MiB, WS_WFO = 11 * MiB, WS_WSO = 12 * MiB, WS_WOUT = 13 * MiB, WS_WUP = 16 * MiB, WS_WDN = 144 * MiB;
constexpr size_t WS_XN = 208 * MiB, WS_LOGF = 241 * MiB, WS_FB = 242 * MiB, WS_SBIAS = 243 * MiB;
constexpr size_t WS_FQ = 244 * MiB, WS_FK = 260 * MiB, WS_FV = 277 * MiB, WS_SQ = 294 * MiB, WS_SK = 310 * MiB, WS_SV = 315 * MiB;
constexpr size_t WS_GA = 320 * MiB, WS_GB = 352 * MiB, WS_OA = 384 * MiB, WS_OB = 400 * MiB, WS_MIX = 416 * MiB, WS_HRES = 448 * MiB, WS_H2 = 512 * MiB;
constexpr size_t WS_TOKDEST = 544 * MiB, WS_ROWTOK = 545 * MiB, WS_ROWW = 547 * MiB, WS_ACT = 550 * MiB, WS_YS = 694 * MiB, WS_END = 838 * MiB;
constexpr int CW_TMO = 0, CW_CODE = 1, CW_BAR = 4096, CW_CNT = 8192, CW_QUEUE = 12288;

constexpr int RING_OFF = 0, RING_BYTES = 131072;
constexpr int ROWS_OFF = RING_BYTES;
constexpr int ROWS_BYTES = 10 * 1024;
constexpr int LDSCTL_OFF = ROWS_OFF + ROWS_BYTES;
constexpr int MISC_OFF = LDSCTL_OFF;
constexpr int TAB_OFF = MISC_OFF + 256;
constexpr int UTAB_OFF = TAB_OFF + 1024;
constexpr int LDS_BYTES = 147456;
static_assert(UTAB_OFF + 256 <= LDS_BYTES, "LDS map");

__device__ __forceinline__ unsigned f2bf(float f) { unsigned u = __builtin_bit_cast(unsigned, f); return (u + 0x7fffu + ((u >> 16) & 1u)) >> 16; }
__device__ __forceinline__ unsigned pk2(float lo, float hi) { return f2bf(lo) | (f2bf(hi) << 16); }
__device__ __forceinline__ float bf2f(unsigned short b) { return __builtin_bit_cast(float, (unsigned)b << 16); }
__device__ __forceinline__ float bflo(unsigned w) { return __builtin_bit_cast(float, w << 16); }
__device__ __forceinline__ float bfhi(unsigned w) { return __builtin_bit_cast(float, w & 0xffff0000u); }
__device__ __forceinline__ float wave_sum(float v) {
#pragma unroll
    for (int o = 1; o < 64; o <<= 1) v += __shfl_xor(v, o);
    return v;
}
__device__ __forceinline__ float wave_max(float v) {
#pragma unroll
    for (int o = 1; o < 64; o <<= 1) v = fmaxf(v, __shfl_xor(v, o));
    return v;
}
__device__ __forceinline__ int fresh_tid() { int t = threadIdx.x; asm volatile("" : "+v"(t)); return t; }
__device__ __forceinline__ unsigned pk4_fp8(float a, float b, float c, float d) { int w = __builtin_amdgcn_cvt_pk_fp8_f32(a, b, 0, false); w = __builtin_amdgcn_cvt_pk_fp8_f32(c, d, w, true); return (unsigned)w; }
__device__ __forceinline__ float sigmoidf_fast(float x) { return __builtin_amdgcn_rcpf(1.f + __builtin_amdgcn_exp2f(-x * LOG2E)); }

namespace pg8 {
constexpr int BM = 256, BK = 64, HALF = 128, HTB = HALF * BK * 2, STAGE_BYTES = 8 * HTB;
__host__ __device__ __forceinline__ int lds_byte(int r, int c) { const int st = (r >> 4) * 2 + (c >> 5), rr = r & 15, cc = c & 31, ob = rr * 64 + cc * 2; return st * 1024 + (ob ^ (((ob >> 9) & 1) << 5)); }
__host__ __device__ __forceinline__ void stage_rc(int b, int& R, int& C) { const int st = b / 1024, sb = b % 1024, swz = sb ^ (((sb >> 9) & 1) << 5); R = (st >> 1) * 16 + swz / 64; C = (st & 1) * 32 + (swz % 64) / 2; }
__host__ __device__ __forceinline__ int perm32(int rho) { const int n = rho >> 4, i = rho & 15; return 8 * (i >> 2) + 4 * n + (i & 3); }

struct Unit { const char* A; const char* B; int rows_lds; int i0, i1, i2, i3; };

template <int PB, bool FP8, bool GATHER, class Epi, class Sched>
__device__ __forceinline__ void gemm_phase(LAS unsigned char* lds, const Sched& S, const Epi& E) {
    int tid_ = threadIdx.x; asm volatile("" : "+v"(tid_));
    const int tid = tid_, wid = __builtin_amdgcn_readfirstlane(tid >> 6), lane = tid & 63, wr = wid >> 2, wc = wid & 3, fr = lane & 15, fq = lane >> 4;
    constexpr int nt = PB / 128;
    int Rs[2], Cs[2]; unsigned voffB[2];
#pragma unroll
    for (int i = 0; i < 2; ++i) { int R, C; stage_rc(tid * 16 + i * 8192, R, C); Rs[i] = R; Cs[i] = C; const int Rb = (R & ~31) + perm32(R & 31); voffB[i] = (unsigned)(Rb * PB + C * 2); }
    constexpr size_t kstep = (size_t)(BK * 2);
    constexpr size_t hstep = (size_t)HALF * PB;
    const unsigned ldsw = (unsigned)wid * 1024u;
    const int aoff = lds_byte(wr * 64 + fr, fq * 8), boff = lds_byte(wc * 32 + fr, fq * 8);
#define PG8_SA(b, h) (((b) * 2 + (h)) * HTB)
#define PG8_SB(b, h) ((4 + (b) * 2 + (h)) * HTB)
#define PG8_STAGE(bufoff, gbase, v0, v1) do { \
        __builtin_amdgcn_global_load_lds((const unsigned*)((const char*)(gbase) + (v0)), (LAS unsigned*)(lds + (bufoff) + ldsw), 16, 0, 0); \
        __builtin_amdgcn_global_load_lds((const unsigned*)((const char*)(gbase) + (v1)), (LAS unsigned*)(lds + (bufoff) + ldsw + 8192), 16, 0, 0); } while (0)
#define PG8_STB(bufoff, gbase) PG8_STAGE(bufoff, gbase, voffB[0], voffB[1])
#define PG8_LDA(dst, b, h) do { _Pragma("unroll") for (int m = 0; m < 4; ++m) _Pragma("unroll") for (int k = 0; k < 2; ++k) dst[m][k] = *(const LAS bf16x8*)(lds + PG8_SA(b, h) + aoff + m * 2048 + k * 1024); } while (0)
#define PG8_LDB(dst, b, h) do { _Pragma("unroll") for (int n = 0; n < 2; ++n) _Pragma("unroll") for (int k = 0; k < 2; ++k) dst[n][k] = *(const LAS bf16x8*)(lds + PG8_SB(b, h) + boff + n * 2048 + k * 1024); } while (0)
#define PG8_CAT(x0, x1) __builtin_shufflevector(__builtin_bit_cast(i32x4, x0), __builtin_bit_cast(i32x4, x1), 0, 1, 2, 3, 4, 5, 6, 7)
#define PG8_MMA(ai, bj, At, Bt) do { __builtin_amdgcn_s_setprio(1); _Pragma("unroll") for (int m = 0; m < 4; ++m) _Pragma("unroll") for (int n = 0; n < 2; ++n) { \
        if constexpr (FP8) { asm volatile("v_mfma_scale_f32_16x16x128_f8f6f4 %0, %1, %2, %0, %3, %3 op_sel_hi:[0,0,0]" : "+v"(acc[ai][bj][m][n]) : "v"(PG8_CAT(Bt[n][0], Bt[n][1])), "v"(PG8_CAT(At[m][0], At[m][1])), "v"(scl)); }   \
        else { _Pragma("unroll") for (int k = 0; k < 2; ++k) acc[ai][bj][m][n] = __builtin_amdgcn_mfma_f32_16x16x32_bf16(Bt[n][k], At[m][k], acc[ai][bj][m][n], 0, 0, 0); } } \
        __builtin_amdgcn_s_setprio(0); } while (0)
#define PG8_WAIT_V(n) asm volatile("s_waitcnt vmcnt(" #n ")" ::: "memory")
#define PG8_WAIT_L(n) asm volatile("s_waitcnt lgkmcnt(" #n ")" ::: "memory")
#define PG8_BAR __builtin_amdgcn_s_barrier()
#define PG8_SCHED __builtin_amdgcn_sched_barrier(0)
#define PG8_SETA(v, u) do { _Pragma("unroll") for (int h = 0; h < 2; ++h) _Pragma("unroll") for (int i = 0; i < 2; ++i) { \
        if constexpr (GATHER) { const int tk = *(const LAS int*)(lds + (u).rows_lds + 4 * (h * HALF + Rs[i])); v[h][i] = (unsigned)(tk * PB + Cs[i] * 2); } \
        else v[h][i] = (unsigned)((h * HALF + Rs[i]) * PB + Cs[i] * 2); } } while (0)
    Unit cur, nxt; int ui = 0; bool relax_prev = false;
    if (!S.next(0, cur)) return;
    int scl = 0x7F7F7F7F; asm volatile("" : "+v"(scl));
    f32x4 acc[2][2][4][2];
#pragma unroll
    for (int a = 0; a < 2; ++a)
#pragma unroll
        for (int b = 0; b < 2; ++b)
#pragma unroll
            for (int m = 0; m < 4; ++m)
#pragma unroll
                for (int n = 0; n < 2; ++n) acc[a][b][m][n] = (f32x4){0.f, 0.f, 0.f, 0.f};
    bf16x8 At[4][2], B0[2][2], B1[2][2];
    unsigned vAc[2][2], vAn[2][2];
    PG8_SETA(vAc, cur);
    if constexpr (GATHER) { PG8_WAIT_L(0); }
    const char* cA = cur.A; const char* cB = cur.B;
    PG8_STB(PG8_SB(0, 0), cB); PG8_STB(PG8_SB(0, 1), cB + hstep); PG8_STAGE(PG8_SA(0, 0), cA, vAc[0][0], vAc[0][1]); PG8_STAGE(PG8_SA(0, 1), cA, vAc[1][0], vAc[1][1]);
    if (wr == 1) PG8_BAR;
    PG8_WAIT_V(2); PG8_BAR;
    PG8_STB(PG8_SB(1, 0), cB + kstep); PG8_STAGE(PG8_SA(1, 0), cA + kstep, vAc[0][0], vAc[0][1]); PG8_STB(PG8_SB(1, 1), cB + hstep + kstep);
    PG8_WAIT_V(6); PG8_BAR;
    for (;;) {
        const bool has_next = S.next(ui + 1, nxt);
        const char* nA = has_next ? nxt.A : cA; const char* nB = has_next ? nxt.B : cB;
        if constexpr (GATHER) { if (has_next) { PG8_SETA(vAn, nxt); } else {
#pragma unroll
            for (int h = 0; h < 2; ++h)
#pragma unroll
                for (int i = 0; i < 2; ++i) vAn[h][i] = vAc[h][i]; } }
#pragma unroll 1
        for (int t = 0; t < nt; t += 2) {
            const bool last = (t == nt - 2);
            const bool first = (t == 0) && (ui > 0), relax = first && relax_prev;
            const char* a1 = cA + (size_t)(t + 1) * kstep;
            const char* a2 = last ? nA : cA + (size_t)(t + 2) * kstep; const char* b2 = last ? nB : cB + (size_t)(t + 2) * kstep;
            const char* a3 = a2 + kstep; const char* b3 = b2 + kstep;
            unsigned w00, w01, w10, w11;
            if constexpr (GATHER) { w00 = last ? vAn[0][0] : vAc[0][0]; w01 = last ? vAn[0][1] : vAc[0][1]; w10 = last ? vAn[1][0] : vAc[1][0]; w11 = last ? vAn[1][1] : vAc[1][1]; }
            else { w00 = vAc[0][0]; w01 = vAc[0][1]; w10 = vAc[1][0]; w11 = vAc[1][1]; }
#define PG8_WAIT_VR() do { if (relax) asm volatile("s_waitcnt vmcnt(%0)" :: "n"(8 + Epi::NS) : "memory"); else PG8_WAIT_V(8); } while (0)
            PG8_LDB(B0, 0, 0); PG8_LDB(B1, 0, 1); PG8_SCHED; PG8_LDA(At, 0, 0); if (!first) PG8_STAGE(PG8_SA(1, 1), a1, vAc[1][0], vAc[1][1]);
            PG8_WAIT_VR(); PG8_WAIT_L(0); PG8_BAR; PG8_MMA(0, 0, At, B0); PG8_MMA(0, 1, At, B1); PG8_BAR; PG8_SCHED;
            PG8_LDA(At, 0, 1); PG8_STB(PG8_SB(0, 0), b2); PG8_STB(PG8_SB(0, 1), b2 + hstep); PG8_STAGE(PG8_SA(0, 0), a2, w00, w01);
            PG8_WAIT_VR(); PG8_WAIT_L(0); PG8_BAR; PG8_MMA(1, 0, At, B0); PG8_MMA(1, 1, At, B1); PG8_BAR; PG8_SCHED;
            PG8_LDB(B0, 1, 0); PG8_LDB(B1, 1, 1); PG8_SCHED; PG8_LDA(At, 1, 0); PG8_STAGE(PG8_SA(0, 1), a2, w10, w11);
            PG8_WAIT_VR(); PG8_WAIT_L(0); PG8_BAR; PG8_MMA(0, 0, At, B0); PG8_MMA(0, 1, At, B1); PG8_BAR; PG8_SCHED;
            PG8_LDA(At, 1, 1); PG8_STB(PG8_SB(1, 0), b3); PG8_STB(PG8_SB(1, 1), b3 + hstep); PG8_STAGE(PG8_SA(1, 0), a3, w00, w01);
            PG8_WAIT_V(8); PG8_WAIT_L(0); PG8_BAR; PG8_MMA(1, 0, At, B0); PG8_MMA(1, 1, At, B1); PG8_BAR; PG8_SCHED;
#undef PG8_WAIT_VR
        }
        if (has_next) { if constexpr (GATHER) PG8_STAGE(PG8_SA(1, 1), nA + kstep, vAn[1][0], vAn[1][1]); else PG8_STAGE(PG8_SA(1, 1), nA + kstep, vAc[1][0], vAc[1][1]); }
        asm volatile("" ::: "memory");
        relax_prev = E.relax_ok(cur);
        if (wr == 0) PG8_BAR;
        if constexpr (FP8) asm volatile("s_nop 15\n\ts_nop 7" ::: "memory");
        E(acc, cur, wr, wc, fr, fq);
        if (!has_next) break;
        if (!E.keep_acc(cur)) {
#pragma unroll
        for (int a = 0; a < 2; ++a)
#pragma unroll
            for (int b = 0; b < 2; ++b)
#pragma unroll
                for (int m = 0; m < 4; ++m)
#pragma unroll
                    for (int n = 0; n < 2; ++n) acc[a][b][m][n] = (f32x4){0.f, 0.f, 0.f, 0.f};
        }
        cur = nxt; cA = nA; cB = nB; ++ui;
        if constexpr (GATHER) {
#pragma unroll
            for (int h = 0; h < 2; ++h)
#pragma unroll
                for (int i = 0; i < 2; ++i) vAc[h][i] = vAn[h][i]; }
        if (wr == 1) PG8_BAR;
    }
    PG8_WAIT_V(0);
    PG8_BAR;
#undef PG8_SA
#undef PG8_SB
#undef PG8_STAGE
#undef PG8_STB
#undef PG8_LDA
#undef PG8_LDB
#undef PG8_MMA
#undef PG8_CAT
#undef PG8_WAIT_V
#undef PG8_WAIT_L
#undef PG8_BAR
#undef PG8_SCHED
#undef PG8_SETA
}
}

namespace attn {
using s16x4 = __attribute__((ext_vector_type(4))) short;
using f32x16 = __attribute__((ext_vector_type(16))) float;
constexpr int NW = 8, QBLK = 32, QB = QBLK * NW, KVBLK = 64, QP = 512;
__device__ __forceinline__ int crow(int r, int hi) { return (r & 3) + 8 * (r >> 2) + 4 * hi; }
#define SBAR() __builtin_amdgcn_sched_barrier(0)
__device__ __forceinline__ void cmask(f32x16& p0, f32x16& p1, int jb, int qrel, int hi) {
  const float NEG = -INFINITY; int kb = 64 * jb + 4 * hi;
  #pragma unroll
  for (int r = 0; r < 16; ++r) { int kv = kb + (r & 3) + 8 * (r >> 2); if (kv > qrel) p0[r] = NEG; if (kv + 32 > qrel) p1[r] = NEG; }
}
__device__ __forceinline__ void wmask(f32x16& p0, f32x16& p1, int t, int qrel, int hi) {
  const float NEG = -INFINITY; int kb = 64 * t + 4 * hi;
  #pragma unroll
  for (int r = 0; r < 16; ++r) { int kv = kb + (r & 3) + 8 * (r >> 2); if (kv <= qrel) p0[r] = NEG; if (kv + 32 <= qrel) p1[r] = NEG; }
}
constexpr int NSLOT = 3, SLOTB = 8192;
constexpr int LDS_K = 0, LDS_V = NSLOT * SLOTB, LDS_WS = 2 * NSLOT * SLOTB, LDS_OST = LDS_WS + NW * 64 * 4, LDS_BIAS = LDS_OST + NW * 4096, LDS_BYTES = LDS_BIAS + LP * 4;
__device__ __forceinline__ void glds16(const void* gsrc, unsigned lds_dst) { unsigned keep;
  asm volatile("s_mov_b32 %0, m0\n\ts_mov_b32 m0, %2\n\ts_nop 0\n\tglobal_load_lds_dwordx4 %1, off\n\ts_mov_b32 m0, %0" : "=&s"(keep) : "v"(gsrc), "s"(lds_dst) : "memory"); }
__device__ __forceinline__ float max3f(float a, float b, float c) { float r; asm("v_max3_f32 %0, %1, %2, %3" : "=v"(r) : "v"(a), "v"(b), "v"(c)); return r; }
__device__ __forceinline__ float max2f(float a, float b) { float r; asm("v_max_f32_e32 %0, %1, %2" : "=v"(r) : "v"(a), "v"(b)); return r; }
__device__ __forceinline__ float fadd_s(float a, float b) { float r; asm("v_add_f32_e32 %0, %1, %2" : "=v"(r) : "v"(a), "v"(b)); return r; }
__device__ __forceinline__ float fsub_s(float a, float b) { float r; asm("v_sub_f32_e32 %0, %1, %2" : "=v"(r) : "v"(a), "v"(b)); return r; }
typedef float f32x2_t __attribute__((ext_vector_type(2))); typedef __bf16 bf16x2_t __attribute__((ext_vector_type(2)));
__device__ __forceinline__ unsigned cvtpk_s(float lo, float hi) { f32x2_t v = {lo, hi}; bf16x2_t b = __builtin_convertvector(v, bf16x2_t); return __builtin_bit_cast(unsigned, b); }
#define WAIT_BAR(N) asm volatile("s_waitcnt vmcnt(" #N ") lgkmcnt(0)\n\ts_barrier" ::: "memory")
typedef __attribute__((address_space(3))) const char* lds_cptr;
typedef short v4i16_t __attribute__((ext_vector_type(4)));
__device__ __forceinline__ void qkt(f32x16& p0, f32x16& p1, lds_cptr Kslot, const bf16x8* qr, int r32, int hi) {
  lds_cptr kb = Kslot + hi * 1024 + r32 * 16;
  #pragma unroll
  for (int d0 = 0; d0 < 4; ++d0) {
    const bf16x8 b0 = *(const LAS bf16x8*)(kb + d0 * 2048);
    const bf16x8 b1 = *(const LAS bf16x8*)(kb + d0 * 2048 + 512);
    p0 = __builtin_amdgcn_mfma_f32_32x32x16_bf16(b0, qr[d0], p0, 0, 0, 0); p1 = __builtin_amdgcn_mfma_f32_32x32x16_bf16(b1, qr[d0], p1, 0, 0, 0); }
}
__device__ __forceinline__ void kload8(bf16x8* kf, lds_cptr kp) {
  kf[0] = *(const LAS bf16x8*)(kp);        kf[1] = *(const LAS bf16x8*)(kp + 512);
  kf[2] = *(const LAS bf16x8*)(kp + 2048); kf[3] = *(const LAS bf16x8*)(kp + 2560);
  kf[4] = *(const LAS bf16x8*)(kp + 4096); kf[5] = *(const LAS bf16x8*)(kp + 4608);
  kf[6] = *(const LAS bf16x8*)(kp + 6144); kf[7] = *(const LAS bf16x8*)(kp + 6656);
}
__device__ __forceinline__ void kload2(bf16x8* kf, lds_cptr kp, int j) { kf[2 * j] = *(const LAS bf16x8*)(kp + j * 2048); kf[2 * j + 1] = *(const LAS bf16x8*)(kp + j * 2048 + 512); }
__device__ __forceinline__ s16x4 vtr(lds_cptr p) { return __builtin_bit_cast(s16x4, __builtin_amdgcn_ds_read_tr16_b64_v4i16((LAS v4i16_t*)p)); }
__device__ __forceinline__ float rowmax(const f32x16& p0, const f32x16& p1) {
  float a = max3f(p0[0], p0[1], p1[0]), b = max3f(p0[2], p0[3], p1[1]); a = max3f(a, p1[2], p1[3]);
  #pragma unroll
  for (int r = 4; r < 16; r += 4) { a = max3f(a, p0[r], p0[r + 1]); b = max3f(b, p0[r + 2], p0[r + 3]); a = max3f(a, p1[r], p1[r + 1]); b = max3f(b, p1[r + 2], p1[r + 3]); }
  const float m = max2f(a, b);
  auto rr = __builtin_amdgcn_permlane32_swap(__float_as_uint(m), __float_as_uint(m), false, false);
  return max2f(__uint_as_float(rr[0]), __uint_as_float(rr[1]));
}
__device__ __forceinline__ void pv(f32x16* o, int vb, bf16x8 pa0, bf16x8 pa1, bf16x8 pa2, bf16x8 pa3) {
  #pragma unroll
  for (int d0 = 0; d0 < 2; ++d0) { s16x4 lo[4], hi[4];
    #pragma unroll
    for (int ks = 0; ks < 4; ++ks) {
      asm volatile("ds_read_b64_tr_b16 %0,%1 offset:%c2" : "=&v"(lo[ks]) : "v"(vb), "i"(d0 * 4096 + ks * 1024) : "memory");
      asm volatile("ds_read_b64_tr_b16 %0,%1 offset:%c2" : "=&v"(hi[ks]) : "v"(vb), "i"(d0 * 4096 + ks * 1024 + 512) : "memory"); }
    asm volatile("s_waitcnt lgkmcnt(0)" ::: "memory"); SBAR();
    #define PK(k) (bf16x8){lo[k][0], lo[k][1], lo[k][2], lo[k][3], hi[k][0], hi[k][1], hi[k][2], hi[k][3]}
    o[d0] = __builtin_amdgcn_mfma_f32_32x32x16_bf16(pa0, PK(0), o[d0], 0, 0, 0);
    o[d0] = __builtin_amdgcn_mfma_f32_32x32x16_bf16(pa1, PK(1), o[d0], 0, 0, 0);
    o[d0] = __builtin_amdgcn_mfma_f32_32x32x16_bf16(pa2, PK(2), o[d0], 0, 0, 0);
    o[d0] = __builtin_amdgcn_mfma_f32_32x32x16_bf16(pa3, PK(3), o[d0], 0, 0, 0);
    #undef PK
  }
}
template <int KP, bool SWA, int THRL>
__device__ __forceinline__ void attn_unit(const bf16_t* Qu, const bf16_t* __restrict__ Kh, const bf16_t* __restrict__ Vh, bf16_t* Ou, const int NT, const float* biasg, const int refidx, const float sink0, const float sinkstep, char* shm) {
  int tid_ = threadIdx.x; asm volatile("" : "+v"(tid_));
  const int tid = tid_, lane = tid & 63, r32 = lane & 31, hi = lane >> 5; const int wid = __builtin_amdgcn_readfirstlane(tid >> 6);
  const bf16_t* Qw = Qu + (size_t)(wid * QBLK) * QP;
  const unsigned lds0 = (unsigned)(uintptr_t)shm;
  float* wsf = (float*)(shm + LDS_WS) + wid * 64;
  const bf16_t* ksrc = Kh + (long)lane * KP + wid * 8;
  const bf16_t* vsrc = Vh + (long)(16 * (wid & 3) + (lane >> 2)) * KP + (wid >> 2) * 32 + (lane & 3) * 8;
  const unsigned kdst = lds0 + LDS_K + wid * 1024, vdst = lds0 + LDS_V + wid * 1024;
  #define DMA_K(t, slot) glds16(ksrc + (long)(t) * KVBLK * KP, (unsigned)__builtin_amdgcn_readfirstlane(kdst + (slot)))
  #define DMA_V(t, slot) glds16(vsrc + (long)(t) * KVBLK * KP, (unsigned)__builtin_amdgcn_readfirstlane(vdst + (slot)))
  const int vb0 = (int)(lds0 + LDS_V) + ((lane >> 4) & 1) * 32 + (lane & 3) * 8 + (4 * hi + ((lane & 15) >> 2)) * 64;
  bf16x8 kf[8];
  const lds_cptr shm3 = (lds_cptr)shm; const lds_cptr kp0 = shm3 + LDS_K + hi * 1024 + r32 * 16; const lds_cptr vp0 = shm3 + LDS_V + ((lane >> 4) & 1) * 32 + (lane & 3) * 8 + (4 * hi + ((lane & 15) >> 2)) * 64;
  const lds_cptr bp0 = shm3 + LDS_BIAS + hi * 16;
  const int nb4 = NT * 16; f32x4 bv[3];
  #pragma unroll
  for (int k = 0; k < 3; ++k) { const int idx = tid + 512 * k; bv[k] = (idx < nb4) ? *((const GAS f32x4*)biasg + idx) : (f32x4){0.f, 0.f, 0.f, 0.f}; }
  DMA_K(0, 0); DMA_V(0, 0); DMA_K(1, SLOTB);
  bf16x8 qr[4];
  #pragma unroll
  for (int d0 = 0; d0 < 4; ++d0) qr[d0] = *reinterpret_cast<const bf16x8*>(&Qw[(long)r32 * QP + d0 * 16 + hi * 8]);
  float mhat = 0.f, nmh = 0.f, bref = 0.f, l_reg = 0.f; f32x16 o[2]; o[0] = f32x16{}; o[1] = f32x16{};
  const int qrel = wid * QBLK + r32;
  #define CMASK(P0, P1, t) do { int jb_ = (t) - (NT - 4); if (jb_ >= 0) cmask(P0, P1, jb_, qrel, hi); } while (0)
  #define WMASK(P0, P1, t) do { if constexpr (SWA) { if ((t) < 4) wmask(P0, P1, (t), qrel, hi); } } while (0)
  #define BIASC(C0, C1, t) do { const LAS f32x4* bp_ = (const LAS f32x4*)(bp0 + (t) * 256); \
    _Pragma("unroll") for (int g_ = 0; g_ < 4; ++g_) { const f32x4 x0_ = bp_[2 * g_], x1_ = bp_[8 + 2 * g_]; \
      _Pragma("unroll") for (int c_ = 0; c_ < 4; ++c_) { C0[4 * g_ + c_] = nmh - x0_[c_]; C1[4 * g_ + c_] = nmh - x1_[c_]; } } } while (0)
  bool resc = false;
  #define START(P0, P1) do { const float rm = rowmax(P0, P1); resc = false; \
    { const float dl = (rm > -1e29f) ? rm : 0.f; mhat = fadd_s(mhat, dl); \
      _Pragma("unroll") for (int r = 0; r < 16; ++r) { P0[r] = fsub_s(P0[r], dl); P1[r] = fsub_s(P1[r], dl); } \
      nmh = bref - mhat; } \
    _Pragma("unroll") for (int r = 0; r < 16; ++r) P0[r] = __builtin_amdgcn_exp2f(P0[r]); } while (0)
  #define RESC() do { if (resc) { asm volatile("s_waitcnt lgkmcnt(0)" ::: "memory"); \
      _Pragma("unroll") for (int d_ = 0; d_ < 2; ++d_) _Pragma("unroll") for (int r = 0; r < 16; ++r) o[d_][r] *= wsf[crow(r, hi)]; } } while (0)
  f32x16 pA0, pA1, pB0, pB1;
  int sl_prev = 0, sl_cur = 0, sl_next = SLOTB;
  #define ROT() do { sl_prev = sl_cur; sl_cur = sl_next; sl_next = (sl_next == (NSLOT - 1) * SLOTB) ? 0 : sl_next + SLOTB; } while (0)
  DMA_K(2, 2 * SLOTB);
  #pragma unroll
  for (int k = 0; k < 3; ++k) { const int idx = tid + 512 * k; if (idx < nb4) *((LAS f32x4*)(shm3 + LDS_BIAS) + idx) = bv[k]; }
  WAIT_BAR(3);
  bref = *(const LAS float*)(shm3 + LDS_BIAS + refidx * 4); nmh = bref;
  BIASC(pA0, pA1, 0);
  qkt(pA0, pA1, shm3 + LDS_K, qr, r32, hi); asm volatile("s_nop 15\n\ts_nop 7" : "+v"(pA0), "+v"(pA1)); CMASK(pA0, pA1, 0); WMASK(pA0, pA1, 0);
  START(pA0, pA1);
  _Pragma("unroll") for (int r = 0; r < 16; ++r) pA1[r] = __builtin_amdgcn_exp2f(pA1[r]);
  WAIT_BAR(0);
  DMA_K(3, 0); DMA_V(1, SLOTB);
  ROT();
  kload8(kf, kp0 + sl_cur);
  WAIT_BAR(2);
  s16x4 vlo[8], vhi[8]; u32x4 pw0, pw1, pw2, pw3;
  #define PKW(P, B) cvtpk_s(P[B], P[B + 1])
  #define PAF(k) __builtin_bit_cast(bf16x8, pw##k)
  #define VFR(i) (bf16x8){vlo[i][0], vlo[i][1], vlo[i][2], vlo[i][3], vhi[i][0], vhi[i][1], vhi[i][2], vhi[i][3]}
  #define PIN(x) asm volatile("" : "+v"(x))
  #define MX3(a, b, c) __builtin_fmaxf(__builtin_fmaxf((a), (b)), (c))
  #define GAPA(MF, A0, A1, A2, A3, W0, W1, PW) do { MF; sacc += A0; sacc += A1; sacc += A2; sacc += A3; PIN(sacc); W0; W1; PIN(PW); SBAR(); } while (0)
  #define EX(v) __builtin_amdgcn_exp2f(v)
  #define GAPB(MF, X, B) do { MF; X[B] = EX(X[B]); X[B + 1] = EX(X[B + 1]); X[B + 2] = EX(X[B + 2]); X[B + 3] = EX(X[B + 3]); PIN(X); SBAR(); } while (0)
  #define VRD(i) do { vlo[i] = vtr(vp_ + (((i) >> 2) * 4096 + ((i) & 3) * 1024)); vhi[i] = vtr(vp_ + (((i) >> 2) * 4096 + ((i) & 3) * 1024 + 512)); } while (0)
  #define KRD(G, j) do { if (G) { kload2(kf, kp0 + sl_next, j); SBAR(); } } while (0)
  #define MF32(a, b, c) __builtin_amdgcn_mfma_f32_32x32x16_bf16(a, b, c, 0, 0, 0)
  #define STEP(C0, C1, P0, P1, t, GK, GV, GL) do { SBAR(); \
    BIASC(C0, C1, t); SBAR(); \
    const lds_cptr vp_ = vp0 + sl_prev; \
    VRD(0); SBAR(); float sacc = (P0[0] + P0[1]); \
    GAPA(C0 = MF32(kf[0], qr[0], C0), P0[2], P0[3], P0[4], P0[5],     pw0[0] = PKW(P0, 0), pw0[1] = PKW(P0, 2), pw0); \
    VRD(4); SBAR(); GAPA(C1 = MF32(kf[1], qr[0], C1), P0[6], P0[7], P0[8], P0[9],     pw0[2] = PKW(P0, 4), pw0[3] = PKW(P0, 6), pw0); \
    VRD(1); SBAR(); GAPA(C0 = MF32(kf[2], qr[1], C0), P0[10], P0[11], P0[12], P0[13], pw1[0] = PKW(P0, 8), pw1[1] = PKW(P0, 10), pw1); \
    VRD(5); SBAR(); GAPA(C1 = MF32(kf[3], qr[1], C1), P0[14], P0[15], P1[0], P1[1],   pw1[2] = PKW(P0, 12), pw1[3] = PKW(P0, 14), pw1); \
    VRD(2); SBAR(); GAPA(C0 = MF32(kf[4], qr[2], C0), P1[2], P1[3], P1[4], P1[5],     pw2[0] = PKW(P1, 0), pw2[1] = PKW(P1, 2), pw2); \
    VRD(6); SBAR(); GAPA(C1 = MF32(kf[5], qr[2], C1), P1[6], P1[7], P1[8], P1[9],     pw2[2] = PKW(P1, 4), pw2[3] = PKW(P1, 6), pw2); \
    VRD(3); SBAR(); GAPA(C0 = MF32(kf[6], qr[3], C0), P1[10], P1[11], P1[12], P1[13], pw3[0] = PKW(P1, 8), pw3[1] = PKW(P1, 10), pw3); \
    VRD(7); SBAR(); GAPA(C1 = MF32(kf[7], qr[3], C1), P1[14], P1[15], 0.f, 0.f,       pw3[2] = PKW(P1, 12), pw3[3] = PKW(P1, 14), pw3); \
    l_reg += sacc; \
    if (GK) { DMA_K((t) + 3, sl_cur); } if (GV) { DMA_V((t) + 1, sl_next); } \
    CMASK(C0, C1, t); WMASK(C0, C1, t); \
    { float a = MX3(C0[0], C0[1], C1[0]), b = MX3(C0[2], C0[3], C1[1]); a = MX3(a, C1[2], C1[3]); \
      _Pragma("unroll") for (int r = 4; r < 16; r += 4) { a = MX3(a, C0[r], C0[r + 1]); b = MX3(b, C0[r + 2], C0[r + 3]); a = MX3(a, C1[r], C1[r + 1]); b = MX3(b, C1[r + 2], C1[r + 3]); } \
      float rm = __builtin_fmaxf(a, b); { auto rr = __builtin_amdgcn_permlane32_swap(__float_as_uint(rm), __float_as_uint(rm), false, false); rm = __builtin_fmaxf(__uint_as_float(rr[0]), __uint_as_float(rr[1])); } \
      resc = false; \
      if (__builtin_expect(__any(rm > (float)THRL), 0)) { const float dl = __builtin_fmaxf(rm, 0.f); mhat += dl; \
        _Pragma("unroll") for (int r = 0; r < 16; ++r) { C0[r] -= dl; C1[r] -= dl; } \
        nmh = bref - mhat; \
        const float f = __builtin_amdgcn_exp2f(-dl); l_reg *= f; if (hi == 0) wsf[r32] = f; resc = true; } } \
    SBAR(); \
    GAPB(o[0] = MF32(PAF(0), VFR(0), o[0]), C0, 0); \
    GAPB(o[1] = MF32(PAF(0), VFR(4), o[1]), C0, 4); \
    KRD(GL, 0); GAPB(o[0] = MF32(PAF(1), VFR(1), o[0]), C0, 8); \
    KRD(GL, 1); GAPB(o[1] = MF32(PAF(1), VFR(5), o[1]), C0, 12); \
    KRD(GL, 2); GAPB(o[0] = MF32(PAF(2), VFR(2), o[0]), C1, 0); \
    KRD(GL, 3); GAPB(o[1] = MF32(PAF(2), VFR(6), o[1]), C1, 4); \
    GAPB(o[0] = MF32(PAF(3), VFR(3), o[0]), C1, 8); \
    GAPB(o[1] = MF32(PAF(3), VFR(7), o[1]), C1, 12); \
    } while (0)
  int t = 1;
  #undef CMASK
  #define CMASK(P0, P1, t) do {} while (0)
  for (; t + 5 < NT; t += 2) {
    STEP(pB0, pB1, pA0, pA1, t, true, true, true);     WAIT_BAR(2); RESC(); ROT();
    STEP(pA0, pA1, pB0, pB1, t + 1, true, true, true); WAIT_BAR(2); RESC(); ROT();
  }
  #undef CMASK
  #define CMASK(P0, P1, t) do { int jb_ = (t) - (NT - 4); if (jb_ >= 0) cmask(P0, P1, jb_, qrel, hi); } while (0)
  #define ENDW(tt) do { if ((tt) + 3 < NT) { WAIT_BAR(2); } else if ((tt) + 2 < NT) { WAIT_BAR(1); } else { WAIT_BAR(0); } } while (0)
  for (; t + 1 < NT; t += 2) {
    STEP(pB0, pB1, pA0, pA1, t, (t + 3 < NT), (t + 1 < NT), (t + 1 < NT));         ENDW(t);     RESC(); ROT();
    STEP(pA0, pA1, pB0, pB1, t + 1, (t + 4 < NT), (t + 2 < NT), (t + 2 < NT));     ENDW(t + 1); RESC(); ROT();
  }
  STEP(pB0, pB1, pA0, pA1, NT - 1, false, false, false); RESC();
  { float sacc = pB0[0] + pB0[1]; _Pragma("unroll") for (int r = 2; r < 16; ++r) sacc += pB0[r]; _Pragma("unroll") for (int r = 0; r < 16; ++r) sacc += pB1[r]; l_reg += sacc;
    pw0 = (u32x4){PKW(pB0, 0), PKW(pB0, 2), PKW(pB0, 4), PKW(pB0, 6)}; pw1 = (u32x4){PKW(pB0, 8), PKW(pB0, 10), PKW(pB0, 12), PKW(pB0, 14)}; pw2 = (u32x4){PKW(pB1, 0), PKW(pB1, 2), PKW(pB1, 4), PKW(pB1, 6)}; pw3 = (u32x4){PKW(pB1, 8), PKW(pB1, 10), PKW(pB1, 12), PKW(pB1, 14)};
    SBAR(); pv(o, vb0 + sl_cur, PAF(0), PAF(1), PAF(2), PAF(3)); }
  #undef PKW
  #undef PAF
  #undef VFR
  #undef PIN
  #undef MX3
  #undef GAPA
  #undef GAPB
  #undef EX
  #undef VRD
  #undef KRD
  #undef STEP
  #undef ENDW
  #undef MF32
  { auto rr = __builtin_amdgcn_permlane32_swap(__float_as_uint(l_reg), __float_as_uint(l_reg), false, false); l_reg = __uint_as_float(rr[0]) + __uint_as_float(rr[1]); }
  if constexpr (SWA) l_reg += __builtin_amdgcn_exp2f(sink0 + sinkstep * (float)qrel - mhat);
  if (hi == 0) wsf[32 + r32] = l_reg; asm volatile("s_waitcnt lgkmcnt(0)" ::: "memory");
  float rli[16];
  #pragma unroll
  for (int r = 0; r < 16; ++r) rli[r] = __builtin_amdgcn_rcpf(wsf[32 + crow(r, hi)]);
  bf16_t* Ow = Ou + (size_t)(wid * QBLK) * QP;
  { bf16_t* stg = (bf16_t*)(shm + LDS_OST) + wid * 2048;
    #pragma unroll
    for (int r = 0; r < 16; ++r) { const int orow = crow(r, hi);
      #pragma unroll
      for (int d0 = 0; d0 < 2; ++d0) stg[orow * 64 + d0 * 32 + r32] = (bf16_t)f2bf(o[d0][r] * rli[r]); }
    asm volatile("s_waitcnt lgkmcnt(0)" ::: "memory");
    #pragma unroll
    for (int i = 0; i < 4; ++i) { const int row = i * 8 + (lane >> 3), ch = lane & 7; const u32x4 v = *(const u32x4*)(stg + row * 64 + ch * 8); *(u32x4*)(Ow + (long)row * QP + ch * 8) = v; } }
  asm volatile("s_waitcnt lgkmcnt(0)\n\ts_barrier" ::: "memory");
  #undef DMA_K
  #undef DMA_V
  #undef CMASK
  #undef WMASK
  #undef BIASC
  #undef START
  #undef RESC
  #undef ROT
}
#undef SBAR
#undef WAIT_BAR
}

#define XB_TMO      128
#define XB_XCNT(j)  (256  + 64 * (j))
#define XB_XSUB(j)  (1280 + 64 * (j))
#define XB_XGEN(j)  (2304 + 64 * (j))
#define XB_TOP      3328
#define XB_TOPGEN   3392
#define XCD_BAR_WORDS 3456
#define XB_SPIN_CAP (1u << 18)
__device__ __forceinline__ unsigned xb_ld(unsigned* p)              { return __hip_atomic_load(p, __ATOMIC_RELAXED, __HIP_MEMORY_SCOPE_AGENT); }
__device__ __forceinline__ unsigned xb_add(unsigned* p, unsigned v) { return __hip_atomic_fetch_add(p, v, __ATOMIC_RELAXED, __HIP_MEMORY_SCOPE_AGENT); }
__device__ __forceinline__ unsigned xb_xcc_id() { return (unsigned)__builtin_amdgcn_s_getreg((3 << 11) | 20) & 0xFu; }
#define XB_SPIN(cond, bar) do { unsigned _sp = 0; while (cond) { __builtin_amdgcn_s_sleep(1); \
    if ((++_sp & 255u) == 0u) { if (xb_ld(&(bar)[XB_TMO])) break; if (_sp > XB_SPIN_CAP) { atomicAdd(&(bar)[XB_TMO], 1u); break; } } } } while (0)
struct XcdBarrier { unsigned* bar; unsigned x; volatile LAS unsigned* st; };
__device__ __forceinline__ XcdBarrier xcd_barrier_post(unsigned* bar, volatile LAS unsigned* st) {
    XcdBarrier b; b.bar = bar; b.x = xb_xcc_id(); b.st = st;
    if (threadIdx.x == 0) (void)xb_add(&bar[XB_XCNT(b.x)], 1u);
    return b;
}
__device__ __forceinline__ void xcd_barrier_complete(unsigned* bar, unsigned x, unsigned& nloc, unsigned& nx) {
    const unsigned G = gridDim.x * gridDim.y * gridDim.z;
    unsigned sum, cnt, mine, sp = 0u;
    for (;;) {
        sum = 0u; cnt = 0u; mine = 0u;
#pragma unroll
        for (unsigned j = 0; j < 16; ++j) { const unsigned c = xb_ld(&bar[XB_XCNT(j)]); sum += c; cnt += (c > 0u) ? 1u : 0u; mine = (j == x) ? c : mine; }
        if (sum == G) break;
        __builtin_amdgcn_s_sleep(1);
        if ((++sp & 255u) == 0u) { if (xb_ld(&bar[XB_TMO])) break; if (sp > XB_SPIN_CAP) { atomicAdd(&bar[XB_TMO], 1u); break; } }
    }
    nloc = mine > 0u ? mine : 1u; nx = cnt > 0u ? cnt : 1u;
}
__device__ __forceinline__ void xcd_barrier(const XcdBarrier& b) {
    asm volatile("s_waitcnt vmcnt(0)" ::: "memory");
    __syncthreads();
    if (threadIdx.x == 0) {
        unsigned* bar = b.bar;
        __builtin_amdgcn_s_waitcnt(0);
        unsigned nloc = b.st[0], nx = b.st[1];
        if (nloc == 0u) { xcd_barrier_complete(bar, b.x, nloc, nx); b.st[0] = nloc; b.st[1] = nx; }
        const unsigned old = xb_add(&bar[XB_XSUB(b.x)], 1u);
        const unsigned gen = old / nloc;
        if (old + 1u == (gen + 1u) * nloc) {
            __builtin_amdgcn_fence(__ATOMIC_RELEASE, "agent");
            asm volatile("s_waitcnt vmcnt(0)" ::: "memory");
            const unsigned og = xb_add(&bar[XB_TOP], 1u);
            const unsigned tg = og / nx;
            if (og + 1u == (tg + 1u) * nx) xb_add(&bar[XB_TOPGEN], 1u);
            else XB_SPIN(xb_ld(&bar[XB_TOPGEN]) == tg, bar);
            __builtin_amdgcn_fence(__ATOMIC_ACQUIRE, "agent");
            xb_add(&bar[XB_XGEN(b.x)], 1u);
            asm volatile("s_waitcnt vmcnt(0)" ::: "memory");
        } else {
            XB_SPIN(xb_ld(&bar[XB_XGEN(b.x)]) == gen, bar);
            __builtin_amdgcn_fence(__ATOMIC_ACQUIRE, "agent");
            asm volatile("s_waitcnt vmcnt(0)" ::: "memory");
        }
    }
    __syncthreads();
}

struct Args { const float* in[20]; float* out; unsigned char* ws; };

struct Frame {
    LAS unsigned char* lds; volatile LAS unsigned* MISC; gu32* ctl;
    int tid, lane, wave, G, gw, NGW;
    unsigned char* ws;
};

struct TrItem { const float* W; int ldw, col0, k0; bf16_t* WT; int ldt, row0; };
__device__ __forceinline__ void tr_load(const TrItem& t, f32x4 (&v)[8], int lane) {
    const float* p = t.W + (size_t)(t.k0 + (lane >> 3)) * t.ldw + t.col0 + 4 * (lane & 7);
#pragma unroll
    for (int i = 0; i < 8; ++i) v[i] = __builtin_nontemporal_load((const GAS f32x4*)(p + (size_t)(8 * i) * t.ldw));
}
__device__ __forceinline__ void tr_store(const TrItem& t, const f32x4 (&v)[8], LAS float* scr, int lane) {
    LAS float* w = scr + (lane >> 3) * 33 + 4 * (lane & 7);
#pragma unroll
    for (int i = 0; i < 8; ++i) { w[(8 * i) * 33 + 0] = v[i].x; w[(8 * i) * 33 + 1] = v[i].y; w[(8 * i) * 33 + 2] = v[i].z; w[(8 * i) * 33 + 3] = v[i].w; }
    LDS_WAIT(); asm volatile("" ::: "memory");
    const int c = lane & 7;
#pragma unroll
    for (int j = 0; j < 4; ++j) { const int n = (lane >> 3) + 8 * j; const LAS float* s = scr + (8 * c) * 33 + n;
        u32x4 o; o.x = pk2(s[0 * 33], s[1 * 33]); o.y = pk2(s[2 * 33], s[3 * 33]); o.z = pk2(s[4 * 33], s[5 * 33]); o.w = pk2(s[6 * 33], s[7 * 33]);
        *(GAS u32x4*)(t.WT + (size_t)(t.row0 + n) * t.ldt + t.k0 + 8 * c) = o; }
    LDS_WAIT(); asm volatile("" ::: "memory");
}
__device__ __forceinline__ void tr8_item(const float* W, int ldw, int col0, int k0, unsigned char* WT, int ldt, int row0, LAS float* scr, int lane) {
    const float* p = W + (size_t)(k0 + (lane >> 3)) * ldw + col0 + 4 * (lane & 7);
    f32x4 v[16];
#pragma unroll
    for (int i = 0; i < 16; ++i) v[i] = __builtin_nontemporal_load((const GAS f32x4*)(p + (size_t)(8 * i) * ldw));
    LAS float* w = scr + (lane >> 3) * 33 + 4 * (lane & 7);
#pragma unroll
    for (int i = 0; i < 16; ++i) { w[(8 * i) * 33 + 0] = v[i].x; w[(8 * i) * 33 + 1] = v[i].y; w[(8 * i) * 33 + 2] = v[i].z; w[(8 * i) * 33 + 3] = v[i].w; }
    LDS_WAIT(); asm volatile("" ::: "memory");
    const int c = lane & 7;
#pragma unroll
    for (int j = 0; j < 4; ++j) { const int n = (lane >> 3) + 8 * j; const LAS float* s = scr + (16 * c) * 33 + n;
        u32x4 o; o.x = pk4_fp8(s[0 * 33] * SC_W, s[1 * 33] * SC_W, s[2 * 33] * SC_W, s[3 * 33] * SC_W); o.y = pk4_fp8(s[4 * 33] * SC_W, s[5 * 33] * SC_W, s[6 * 33] * SC_W, s[7 * 33] * SC_W);
        o.z = pk4_fp8(s[8 * 33] * SC_W, s[9 * 33] * SC_W, s[10 * 33] * SC_W, s[11 * 33] * SC_W); o.w = pk4_fp8(s[12 * 33] * SC_W, s[13 * 33] * SC_W, s[14 * 33] * SC_W, s[15 * 33] * SC_W);
        __builtin_nontemporal_store(o, (GAS u32x4*)(WT + (size_t)(row0 + n) * ldt + k0 + 16 * c)); }
    LDS_WAIT(); asm volatile("" ::: "memory");
}
constexpr int NCB_P1 = 64, NCB_P6 = 128, NCB_P2 = 1024 - NCB_P1 - NCB_P6;
__device__ __forceinline__ void conv_batch(int bat, const float* w_up_, const float* w_down_, unsigned char* wup8, unsigned char* wdn8, LAS unsigned char* ring) {
    constexpr int I_UP = NE * 8 * 64; const int t2 = fresh_tid(), lane = t2 & 63, wv = __builtin_amdgcn_readfirstlane(t2 >> 6);
    LAS float* scr = (LAS float*)(ring + wv * 17664);
#pragma unroll 1
    for (int k3 = 0; k3 < 3; ++k3) { const int it = bat * 24 + 8 * k3 + wv;
        if (it < I_UP) { const int e = it / (8 * 64), q = it % (8 * 64), kb = q / 64, nb = q % 64;
            const int lcol = ((nb >> 2) & 1) * 1024 + (nb >> 3) * 128 + (nb & 3) * 32;
            tr8_item(w_up_ + (size_t)e * DM * 2048, 2048, lcol, kb * 128, wup8 + (size_t)e * 2048 * DM, DM, nb * 32, scr, lane); }
        else { const int r = it - I_UP, e = r / (8 * 32), q = r % (8 * 32), kb = q / 32, nb = q % 32;
            tr8_item(w_down_ + (size_t)e * DM * DM, DM, nb * 32, kb * 128, wdn8 + (size_t)e * DM * DM, DM, nb * 32, scr, lane); } }
}
__device__ __forceinline__ int win_logical_col(int p) {
    const int tile = p >> 8, q = p & 255, bj = q >> 7, hh = (q >> 5) & 3;
    if (tile >= 9) { return (tile < 13 ? 2312 + (tile - 9) * 256 : 3336 + (tile - 13) * 256) + q; }
    const int hoff = hh * 64 + bj * 32;
    if (tile < 6) return tile * 256 + hoff;
    if (tile < 8) return 1544 + (tile - 6) * 256 + hoff;
    return 2056 + hoff;
}

struct SchedIn {
    int G, c, lo, hi; const char* A; const char* B;
    __device__ __forceinline__ bool next(int i, pg8::Unit& u) const {
        const int n = lo + i * G + c; int pm, pn;
        if (n >= hi) return false;
        if (n < 5) { pm = 64; pn = (n < 4) ? 2 + n : 8; }
        else { int wgid = n - 5; { const int q = 1088 / 8, xcd = wgid % 8, off = wgid / 8; wgid = xcd * q + off; }
            const int nig = 8 * 17, gid = wgid / nig, fm = gid * 8; pm = fm + ((wgid % nig) % 8); pn = (wgid % nig) / 8; }
        u.A = A + (size_t)pm * 256 * DM * 2; u.B = B + (size_t)pn * 256 * DM * 2; u.rows_lds = 0; u.i0 = pm; u.i1 = pn; u.i2 = 0; u.i3 = 0; return true;
    }
};
constexpr int IN_ALL = 1093, IN_P1 = 992;
struct SchedMix {
    int G, c; const char *OA, *OB, *WF, *WS;
    __device__ __forceinline__ bool next(int i, pg8::Unit& u) const {
        if (i >= 2 || c >= 256) return false;
        int wgid = c; { const int q = 256 / 8, xcd = wgid % 8, off = wgid / 8; wgid = xcd * q + off; }
        const int nig = 8 * 4, gid = wgid / nig, fm = gid * 8, pm = fm + ((wgid % nig) % 8), pn = (wgid % nig) / 8;
        u.A = (i == 0 ? OA : OB) + (size_t)pm * 256 * 512 * 2; u.B = (i == 0 ? WF : WS) + (size_t)pn * 256 * 512 * 2; u.rows_lds = 0; u.i0 = pm; u.i1 = pn; u.i2 = i; u.i3 = 0; return true;
    }
};
struct SchedOut {
    int G, c; const char *A, *B;
    __device__ __forceinline__ bool next(int i, pg8::Unit& u) const {
        if (i >= 1 || c >= 256) return false;
        int wgid = c; { const int q = 256 / 8, xcd = wgid % 8, off = wgid / 8; wgid = xcd * q + off; }
        const int nig = 8 * 4, gid = wgid / nig, fm = gid * 8, pm = fm + ((wgid % nig) % 8), pn = (wgid % nig) / 8;
        u.A = A + (size_t)pm * 256 * DM * 2; u.B = B + (size_t)pn * 256 * DM * 2; u.rows_lds = 0; u.i0 = pm; u.i1 = pn; u.i2 = 0; u.i3 = 0; return true;
    }
};
struct SchedMoe {
    int G, c, NPN; const LAS int* utab; const char* A; const char* B; int gather, pb;
    __device__ __forceinline__ bool next(int i, pg8::Unit& u) const {
        if (i >= 10) return false;
        const i32x4 t = *(const LAS i32x4*)(utab + 4 * i);
        if (__builtin_amdgcn_readfirstlane(t.w) == 0) return false;
        const int tau = __builtin_amdgcn_readfirstlane(t.x), e = __builtin_amdgcn_readfirstlane(t.y), pn = __builtin_amdgcn_readfirstlane(t.w) - 1;
        u.i0 = tau; u.i1 = pn; u.i2 = e; u.i3 = __builtin_amdgcn_readfirstlane(t.z);
        u.rows_lds = ROWS_OFF + i * 1024;
        u.A = gather ? A : A + (size_t)tau * 256 * pb;
        u.B = B + ((size_t)e * (NPN * 256) + (size_t)pn * 256) * pb;
        return true;
    }
};
__device__ __forceinline__ void moe_units(LAS int* utab, const LAS int* tab, int T, int NPN, int G, int c, int tid) {
    if (tid < 10) { const int x = c & 7, k = c >> 3, nx = (G - x + 7) >> 3, t0 = (T * x) >> 3, t1 = (T * (x + 1)) >> 3;
        const int L = t0 * NPN + tid * nx + k; i32x4 t = {0, 0, 0, 0};
        if (L < t1 * NPN) { const int tau = L / NPN; int e = 0;
            for (int j = 1; j < NE; ++j) e += (tab[32 + j] <= tau) ? 1 : 0;
            t = (i32x4){tau, e, tab[e] - (tau - tab[32 + e]) * 256, 1 + L % NPN}; }
        *(LAS i32x4*)(utab + 4 * tid) = t; }
    __syncthreads();
}

struct EpiIn {
    __device__ __forceinline__ bool keep_acc(const pg8::Unit&) const { return false; }
    static constexpr int NS = 16;
    __device__ __forceinline__ bool relax_ok(const pg8::Unit& u) const { return u.i0 < 64; }
    bf16_t *FQ, *FK, *FV, *SQ, *SK, *SV, *GA, *GB; const float *gfq, *gfk, *gsq, *gsk;
    __device__ __forceinline__ void operator()(const f32x4 (&acc)[2][2][4][2], const pg8::Unit& u, int wr, int wc, int fr, int fq) const {
        const int pm = u.i0, pn = u.i1;
        if (pn >= 9) {
            bf16_t* G = (pn < 13) ? GA : GB; const int colt = (pn < 13 ? pn - 9 : pn - 13) * 256 + wc * 32 + 8 * fq;
#pragma unroll
            for (int ai = 0; ai < 2; ++ai)
#pragma unroll
                for (int m = 0; m < 4; ++m) { const int row = pm * 256 + ai * 128 + wr * 64 + m * 16 + fr; bf16_t* rowp = G + (size_t)row * DM + colt;
#pragma unroll
                    for (int bj = 0; bj < 2; ++bj) { const f32x4 v0 = acc[ai][bj][m][0], v1 = acc[ai][bj][m][1]; u32x4 w;
                        w.x = pk2(sigmoidf_fast(v0[0]), sigmoidf_fast(v0[1])); w.y = pk2(sigmoidf_fast(v0[2]), sigmoidf_fast(v0[3]));
                        w.z = pk2(sigmoidf_fast(v1[0]), sigmoidf_fast(v1[1])); w.w = pk2(sigmoidf_fast(v1[2]), sigmoidf_fast(v1[3]));
                        *(GAS u32x4*)(rowp + bj * 128) = w; } }
            return;
        }
        bf16_t* dst; int pitch, hcol, metaslot; bool kv, donorm; const float* gain; float scale = 1.f;
        if (pn < 2)      { dst = FQ; pitch = 512; hcol = (4 * pn + wc) * 64;       kv = false; donorm = true;  gain = gfq; scale = C2; metaslot = 0; }
        else if (pn < 4) { dst = FK; pitch = 512; hcol = (4 * (pn - 2) + wc) * 64; kv = true;  donorm = true;  gain = gfk; metaslot = 48; }
        else if (pn < 6) { dst = FV; pitch = 512; hcol = (4 * (pn - 4) + wc) * 64; kv = true;  donorm = false; gain = gfk; metaslot = 48; }
        else if (pn < 8) { dst = SQ; pitch = 512; hcol = (4 * (pn - 6) + wc) * 64; kv = false; donorm = true;  gain = gsq; scale = C2; metaslot = 0; }
        else if (wc < 2) { dst = SK; pitch = 128; hcol = wc * 64;                  kv = true;  donorm = true;  gain = gsk; metaslot = 112; }
        else             { dst = SV; pitch = 128; hcol = (wc - 2) * 64;            kv = true;  donorm = false; gain = gsk; metaslot = 112; }
        f32x4 gv[2][2];
#pragma unroll
        for (int bj = 0; bj < 2; ++bj)
#pragma unroll
            for (int n = 0; n < 2; ++n) { const f32x4 gl = *(const GAS f32x4*)(gain + 32 * bj + 8 * fq + 4 * n); gv[bj][n] = gl * (donorm ? scale : 0.f) + (donorm ? 0.f : 1.f); }
#pragma unroll
        for (int ai = 0; ai < 2; ++ai)
#pragma unroll
            for (int m = 0; m < 4; ++m) {
                float ss = 0.f;
#pragma unroll
                for (int bj = 0; bj < 2; ++bj)
#pragma unroll
                    for (int n = 0; n < 2; ++n) { const f32x4 x = acc[ai][bj][m][n]; ss += (x[0] * x[0] + x[1] * x[1]) + (x[2] * x[2] + x[3] * x[3]); }
                ss += __shfl_xor(ss, 16); ss += __shfl_xor(ss, 32);
                const float r = donorm ? __builtin_amdgcn_rsqf(ss * (1.f / 64.f) + RMS_EPS) : 1.f;
                u32x4 w[2];
#pragma unroll
                for (int bj = 0; bj < 2; ++bj) { const f32x4 v0 = acc[ai][bj][m][0] * gv[bj][0] * r, v1 = acc[ai][bj][m][1] * gv[bj][1] * r;
                    w[bj].x = pk2(v0[0], v0[1]); w[bj].y = pk2(v0[2], v0[3]); w[bj].z = pk2(v1[0], v1[1]); w[bj].w = pk2(v1[2], v1[3]); }
                const int lrow = ai * 128 + wr * 64 + m * 16 + fr;
                if (pm < 64) { const int tok = pm * 256 + lrow; const int drow = kv ? (tok >> 12) * LP + 128 + (tok & 4095) : tok;
                    bf16_t* rowp = dst + (size_t)drow * pitch + hcol + 8 * fq;
                    *(GAS u32x4*)(rowp) = w[0]; *(GAS u32x4*)(rowp + 32) = w[1]; }
                else if (lrow < NMETA && kv) {
#pragma unroll
                    for (int b = 0; b < NB; ++b) { bf16_t* rowp = dst + (size_t)(b * LP + metaslot + lrow) * pitch + hcol + 8 * fq;
                        *(GAS u32x4*)(rowp) = w[0]; *(GAS u32x4*)(rowp + 32) = w[1]; } }
            }
    }
};
struct EpiMix {
    static constexpr int NS = 32;
    __device__ __forceinline__ bool relax_ok(const pg8::Unit& u) const { return true; }
    bf16_t* MIX; const bf16_t *GA, *GB;
    __device__ __forceinline__ bool keep_acc(const pg8::Unit& u) const { return u.i2 == 0; }
    __device__ __forceinline__ void operator()(f32x4 (&acc)[2][2][4][2], const pg8::Unit& u, int wr, int wc, int fr, int fq) const {
        const int pm = u.i0, pn = u.i1, part = u.i2;
#pragma unroll
        for (int ai = 0; ai < 2; ++ai) {
            u32x4 ga[4][2], gb[4][2];
#pragma unroll
            for (int m = 0; m < 4; ++m) { const size_t off = (size_t)(pm * 256 + ai * 128 + wr * 64 + m * 16 + fr) * DM + pn * 256 + wc * 32 + 8 * fq;
#pragma unroll
                for (int bj = 0; bj < 2; ++bj) { gb[m][bj] = *(const GAS u32x4*)(GB + off + bj * 128); ga[m][bj] = part ? gb[m][bj] : *(const GAS u32x4*)(GA + off + bj * 128); } }
#pragma unroll
            for (int m = 0; m < 4; ++m) { const size_t off = (size_t)(pm * 256 + ai * 128 + wr * 64 + m * 16 + fr) * DM + pn * 256 + wc * 32 + 8 * fq;
#pragma unroll
                for (int bj = 0; bj < 2; ++bj) { const u32x4 a_ = ga[m][bj], b_ = gb[m][bj]; f32x4& v0 = acc[ai][bj][m][0]; f32x4& v1 = acc[ai][bj][m][1];
                    if (part == 0) {
                        v0[0] *= bflo(a_.x) * __builtin_amdgcn_rcpf(bflo(b_.x)); v0[1] *= bfhi(a_.x) * __builtin_amdgcn_rcpf(bfhi(b_.x)); v0[2] *= bflo(a_.y) * __builtin_amdgcn_rcpf(bflo(b_.y)); v0[3] *= bfhi(a_.y) * __builtin_amdgcn_rcpf(bfhi(b_.y));
                        v1[0] *= bflo(a_.z) * __builtin_amdgcn_rcpf(bflo(b_.z)); v1[1] *= bfhi(a_.z) * __builtin_amdgcn_rcpf(bfhi(b_.z)); v1[2] *= bflo(a_.w) * __builtin_amdgcn_rcpf(bflo(b_.w)); v1[3] *= bfhi(a_.w) * __builtin_amdgcn_rcpf(bfhi(b_.w));
                    } else {
                        u32x4 w; w.x = pk2(v0[0] * bflo(b_.x), v0[1] * bfhi(b_.x)); w.y = pk2(v0[2] * bflo(b_.y), v0[3] * bfhi(b_.y)); w.z = pk2(v1[0] * bflo(b_.z), v1[1] * bfhi(b_.z)); w.w = pk2(v1[2] * bflo(b_.w), v1[3] * bfhi(b_.w));
                        *(GAS u32x4*)(MIX + off + bj * 128) = w; } } }
        }
    }
};
struct EpiOut {
    __device__ __forceinline__ bool keep_acc(const pg8::Unit&) const { return false; }
    static constexpr int NS = 48;
    __device__ __forceinline__ bool relax_ok(const pg8::Unit& u) const { return true; }
    bf16_t* H; const float* X;
    __device__ __forceinline__ void operator()(const f32x4 (&acc)[2][2][4][2], const pg8::Unit& u, int wr, int wc, int fr, int fq) const {
        const int pm = u.i0, pn = u.i1;
#pragma unroll
        for (int ai = 0; ai < 2; ++ai) {
            f32x4 xv[4][2][2];
#pragma unroll
            for (int m = 0; m < 4; ++m) { const size_t off = (size_t)(pm * 256 + ai * 128 + wr * 64 + m * 16 + fr) * DM + pn * 256 + wc * 32 + 8 * fq;
#pragma unroll
                for (int bj = 0; bj < 2; ++bj)
#pragma unroll
                    for (int n = 0; n < 2; ++n) xv[m][bj][n] = __builtin_nontemporal_load((const GAS f32x4*)(X + off + bj * 128 + 4 * n)); }
#pragma unroll
            for (int m = 0; m < 4; ++m) { const size_t off = (size_t)(pm * 256 + ai * 128 + wr * 64 + m * 16 + fr) * DM + pn * 256 + wc * 32 + 8 * fq;
#pragma unroll
                for (int bj = 0; bj < 2; ++bj) { const f32x4 v0 = xv[m][bj][0] + acc[ai][bj][m][0], v1 = xv[m][bj][1] + acc[ai][bj][m][1];
                    u32x4 w; w.x = pk2(v0[0], v0[1]); w.y = pk2(v0[2], v0[3]); w.z = pk2(v1[0], v1[1]); w.w = pk2(v1[2], v1[3]);
                    *(GAS u32x4*)(H + off + bj * 128) = w; } }
        }
    }
};
__device__ __forceinline__ float swiglu_act(float g, float u) {
    g = fminf(g, 7.f); u = fminf(fmaxf(u, -7.f), 7.f);
    return (u + 1.f) * (g * __builtin_amdgcn_rcpf(1.f + __builtin_amdgcn_exp2f(-1.702f * LOG2E * g)));
}
struct EpiUp {
    __device__ __forceinline__ bool keep_acc(const pg8::Unit&) const { return false; }
    static constexpr int NS = 12;
    __device__ __forceinline__ bool relax_ok(const pg8::Unit& u) const { return true; }
    unsigned char* ACT; const float* bup;
    __device__ __forceinline__ void operator()(const f32x4 (&acc)[2][2][4][2], const pg8::Unit& u, int wr, int wc, int fr, int fq) const {
        const int tau = u.i0, pn = u.i1, e = u.i2; const int gcol = pn * 128 + wc * 32 + 8 * fq; constexpr float us = 1.f / (SC_H * SC_W);
        f32x2 bg[4], bu[4];
#pragma unroll
        for (int n = 0; n < 2; ++n) { const f32x4 g4 = *(const GAS f32x4*)(bup + (size_t)e * 2048 + gcol + 4 * n), u4 = *(const GAS f32x4*)(bup + (size_t)e * 2048 + 1024 + gcol + 4 * n);
            bg[2 * n] = (f32x2){g4.x, g4.y}; bg[2 * n + 1] = (f32x2){g4.z, g4.w}; bu[2 * n] = (f32x2){u4.x, u4.y} * SC_A + SC_A; bu[2 * n + 1] = (f32x2){u4.z, u4.w} * SC_A + SC_A; }
#pragma unroll
        for (int ai = 0; ai < 2; ++ai)
#pragma unroll
            for (int m = 0; m < 4; ++m) { const size_t off = (size_t)(tau * 256 + ai * 128 + wr * 64 + m * 16 + fr) * DM + gcol;
                f32x2 o[4];
#pragma unroll
                for (int p = 0; p < 4; ++p) { const f32x4 ag = acc[ai][0][m][p >> 1], au = acc[ai][1][m][p >> 1];
                    f32x2 g = ((p & 1) ? (f32x2){ag.z, ag.w} : (f32x2){ag.x, ag.y}) * us + bg[p];
                    f32x2 uu = ((p & 1) ? (f32x2){au.z, au.w} : (f32x2){au.x, au.y}) * (us * SC_A) + bu[p];
                    g.x = fminf(g.x, 7.f); g.y = fminf(g.y, 7.f);
                    uu.x = __builtin_amdgcn_fmed3f(uu.x, -6.f * SC_A, 8.f * SC_A); uu.y = __builtin_amdgcn_fmed3f(uu.y, -6.f * SC_A, 8.f * SC_A);
                    const f32x2 t = g * (-1.702f * LOG2E); f32x2 d; d.x = __builtin_amdgcn_exp2f(t.x); d.y = __builtin_amdgcn_exp2f(t.y); d = d + 1.f;
                    f32x2 r; r.x = __builtin_amdgcn_rcpf(d.x); r.y = __builtin_amdgcn_rcpf(d.y);
                    o[p] = uu * (g * r); }
                u32x2 w; w.x = pk4_fp8(o[0].x, o[0].y, o[1].x, o[1].y); w.y = pk4_fp8(o[2].x, o[2].y, o[3].x, o[3].y);
                *(GAS u32x2*)(ACT + off) = w; }
    }
};
struct EpiDown {
    __device__ __forceinline__ bool keep_acc(const pg8::Unit&) const { return false; }
    static constexpr int NS = 20;
    __device__ __forceinline__ bool relax_ok(const pg8::Unit& u) const { return true; }
    unsigned char* YS; const float* bdn; const float* roww; const LAS int* tab;
    __device__ __forceinline__ void operator()(const f32x4 (&acc)[2][2][4][2], const pg8::Unit& u, int wr, int wc, int fr, int fq) const {
        const int tau = u.i0, pn = u.i1, e = u.i2, nvalid = u.i3; const int col = pn * 256 + wc * 32 + 8 * fq; const int lt0 = (tau - tab[32 + e]) * 256;
        f32x4 bv[2][2];
#pragma unroll
        for (int bj = 0; bj < 2; ++bj)
#pragma unroll
            for (int n = 0; n < 2; ++n) bv[bj][n] = *(const GAS f32x4*)(bdn + (size_t)e * DM + col + bj * 128 + 4 * n);
        float wv[8];
#pragma unroll
        for (int q = 0; q < 8; ++q) { const int lrow = (q >> 2) * 128 + wr * 64 + (q & 3) * 16 + fr; const int lr = lrow < nvalid ? lrow : 0; wv[q] = roww[(size_t)e * ECAP + lt0 + lr]; wv[q] = lrow < nvalid ? wv[q] : 0.f; }
#pragma unroll
        for (int ai = 0; ai < 2; ++ai)
#pragma unroll
            for (int m = 0; m < 4; ++m) { const int lrow = ai * 128 + wr * 64 + m * 16 + fr; const size_t off = (size_t)(tau * 256 + lrow) * DM + col;
                const float w = wv[ai * 4 + m];
#pragma unroll
                for (int bj = 0; bj < 2; ++bj) { constexpr float us = 1.f / (SC_A * SC_W); const float ws = w * SC_Y; const f32x4 lim = {448.f, 448.f, 448.f, 448.f};
                    const f32x4 v0 = __builtin_elementwise_min(__builtin_elementwise_max((acc[ai][bj][m][0] * us + bv[bj][0]) * ws, -lim), lim), v1 = __builtin_elementwise_min(__builtin_elementwise_max((acc[ai][bj][m][1] * us + bv[bj][1]) * ws, -lim), lim);
                    u32x2 o; o.x = pk4_fp8(v0[0], v0[1], v0[2], v0[3]); o.y = pk4_fp8(v1[0], v1[1], v1[2], v1[3]);
                    *(GAS u32x2*)(YS + off + bj * 128) = o; } }
    }
};
__device__ __forceinline__ void router_finish(float (&p)[32], float brt, int lane, int lt, LAS int* hist, LAS int* sel_e, LAS float* sel_g, LAS int* sel_r) {
#pragma unroll
    for (int e = 0; e < 16; ++e) { const bool up = (lane & 32) != 0; const float send = up ? p[e] : p[e + 16]; const float keep = up ? p[e + 16] : p[e]; p[e] = keep + __shfl_xor(send, 32); }
#pragma unroll
    for (int e = 0; e < 8; ++e) { const bool up = (lane & 16) != 0; const float send = up ? p[e] : p[e + 8]; const float keep = up ? p[e + 8] : p[e]; p[e] = keep + __shfl_xor(send, 16); }
#pragma unroll
    for (int e = 0; e < 4; ++e) { const bool up = (lane & 8) != 0; const float send = up ? p[e] : p[e + 4]; const float keep = up ? p[e + 4] : p[e]; p[e] = keep + __shfl_xor(send, 8); }
#pragma unroll
    for (int e = 0; e < 2; ++e) { const bool up = (lane & 4) != 0; const float send = up ? p[e] : p[e + 2]; const float keep = up ? p[e + 2] : p[e]; p[e] = keep + __shfl_xor(send, 4); }
    { const bool up = (lane & 2) != 0; const float send = up ? p[0] : p[1]; const float keep = up ? p[1] : p[0]; p[0] = keep + __shfl_xor(send, 2); }
    const float logit = p[0] + __shfl_xor(p[0], 1) + brt;
    const int my_e = lane >> 1;
    float cur = (lane & 1) ? -INFINITY : logit; int rank = 4; float vmax = 0.f;
#pragma unroll
    for (int r = 0; r < 4; ++r) { const float mx = wave_max(cur); const unsigned long long bal = __ballot(cur == mx); const int win = __ffsll((long long)bal) - 1;
        if (r == 0) vmax = mx;
        if (lane == win) { rank = r; cur = -INFINITY; } }
    const bool selected = rank < 4;
    const float ex = selected ? expf(logit - vmax) : 0.f;
    const float den = wave_sum(ex);
    if (selected) { const int lr = __hip_atomic_fetch_add(hist + my_e, 1, __ATOMIC_RELAXED, __HIP_MEMORY_SCOPE_WORKGROUP); sel_e[lt * 4 + rank] = my_e; sel_g[lt * 4 + rank] = ex / den; sel_r[lt * 4 + rank] = lr; }
}
__device__ __forceinline__ void naive_attn_row(const bf16_t* q, const bf16_t* Kb, const bf16_t* Vb, int pitch, const float* bias, int k0, int k1, bool has_sink, float sinkv, bf16_t* out, int lane) {
    u32x4 qw[8];
#pragma unroll
    for (int j = 0; j < 8; ++j) qw[j] = *(const GAS u32x4*)(q + 8 * j);
    float m = -1e20f, l = 0.f, o = 0.f;
    for (int kb = k0; kb <= k1; kb += 64) {
        const int k = kb + lane; const bool valid = k <= k1; const int kc = valid ? k : k1;
        const bf16_t* kr = Kb + (size_t)kc * pitch;
        float s = 0.f;
#pragma unroll
        for (int j = 0; j < 8; ++j) { const u32x4 kw = *(const GAS u32x4*)(kr + 8 * j);
            s += bflo(qw[j].x) * bflo(kw.x) + bfhi(qw[j].x) * bfhi(kw.x) + bflo(qw[j].y) * bflo(kw.y) + bfhi(qw[j].y) * bfhi(kw.y)
               + bflo(qw[j].z) * bflo(kw.z) + bfhi(qw[j].z) * bfhi(kw.z) + bflo(qw[j].w) * bflo(kw.w) + bfhi(qw[j].w) * bfhi(kw.w); }
        s = valid ? s - bias[kc] : -BIGB;
        const float mn = fmaxf(m, wave_max(s));
        const float alpha = __builtin_amdgcn_exp2f(m - mn);
        const float p = __builtin_amdgcn_exp2f(s - mn);
        l = l * alpha + wave_sum(p); o *= alpha; m = mn;
        const int nk = (k1 - kb + 1 < 64) ? (k1 - kb + 1) : 64;
        for (int j = 0; j < nk; ++j) { const float pj = __shfl(p, j); o += pj * bf2f(Vb[(size_t)(kb + j) * pitch + lane]); }
    }
    if (has_sink) l += __builtin_amdgcn_exp2f(sinkv - m);
    out[lane] = (bf16_t)f2bf(o / l);
}

#define in_x     (args.in[0])
#define meta     (args.in[1])
#define g1       (args.in[2])
#define w_in     (args.in[3])
#define b_forget (args.in[4])
#define gfq      (args.in[5])
#define gfk      (args.in[6])
#define gsq      (args.in[7])
#define gsk      (args.in[8])
#define sinks    (args.in[9])
#define w_fo     (args.in[10])
#define w_so     (args.in[11])
#define w_out    (args.in[12])
#define g2       (args.in[13])
#define w_router (args.in[14])
#define b_router (args.in[15])
#define w_up     (args.in[16])
#define b_up     (args.in[17])
#define w_down   (args.in[18])
#define b_down   (args.in[19])
#define WIN  ((bf16_t*)(ws + WS_WIN))
#define WFO  ((bf16_t*)(ws + WS_WFO))
#define WSO  ((bf16_t*)(ws + WS_WSO))
#define WOUT ((bf16_t*)(ws + WS_WOUT))
#define WUP  ((unsigned char*)(ws + WS_WUP))
#define WDN  ((unsigned char*)(ws + WS_WDN))
#define XN   ((bf16_t*)(ws + WS_XN))
#define LOGF ((float*)(ws + WS_LOGF))
#define FB   ((float*)(ws + WS_FB))
#define SBIAS ((float*)(ws + WS_SBIAS))
#define FQ   ((bf16_t*)(ws + WS_FQ))
#define FK   ((bf16_t*)(ws + WS_FK))
#define FV   ((bf16_t*)(ws + WS_FV))
#define SQ   ((bf16_t*)(ws + WS_SQ))
#define SK   ((bf16_t*)(ws + WS_SK))
#define SV   ((bf16_t*)(ws + WS_SV))
#define GA   ((bf16_t*)(ws + WS_GA))
#define GB   ((bf16_t*)(ws + WS_GB))
#define OA   ((bf16_t*)(ws + WS_OA))
#define OB   ((bf16_t*)(ws + WS_OB))
#define MIX  ((bf16_t*)(ws + WS_MIX))
#define HRES ((bf16_t*)(ws + WS_HRES))
#define H2   ((unsigned char*)(ws + WS_H2))
#define TOKDEST ((int*)(ws + WS_TOKDEST))
#define ROWTOK ((int*)(ws + WS_ROWTOK))
#define ROWW ((float*)(ws + WS_ROWW))
#define ACT  ((unsigned char*)(ws + WS_ACT))
#define YS   ((unsigned char*)(ws + WS_YS))
__global__ void __launch_bounds__(NWAVES * 64, 2) hybrid_fwd(Args args) {
    extern __shared__ __attribute__((aligned(16))) unsigned char lds_raw[];
    Frame F;
    F.lds = (LAS unsigned char*)lds_raw;
    F.MISC = (volatile LAS unsigned*)(F.lds + MISC_OFF);
    F.tid = threadIdx.x; F.lane = F.tid & 63; F.wave = __builtin_amdgcn_readfirstlane(F.tid >> 6);
    F.G = gridDim.x; F.gw = blockIdx.x * NWAVES + F.wave; F.NGW = F.G * NWAVES;
    F.ws = args.ws; F.ctl = (gu32*)(F.ws + WS_CTL);
    unsigned char* ws = args.ws;
    const int tid = F.tid, lane = F.lane, wave = F.wave, gw = F.gw, NGW = F.NGW, c = blockIdx.x, G = F.G;
    for (int u = tid; u < (LDS_BYTES - LDSCTL_OFF) / 4; u += NWAVES * 64) ((LAS unsigned*)(F.lds + LDSCTL_OFF))[u] = 0u;
    __syncthreads();
    XcdBarrier bar = xcd_barrier_post((unsigned*)(F.ctl + CW_BAR), F.MISC + 8);

    LAS int* tab = (LAS int*)(F.lds + TAB_OFF);

#ifndef NO_P0
    {
        LAS float* scr = (LAS float*)(F.lds + RING_OFF + wave * 17664);
        for (int i = gw; i < NB * 112; i += NGW) { const int b = i / 112, r = i % 112, slot = (r < 48) ? r : r + 16;
            GAS u32x4* pk = (GAS u32x4*)(FK + (size_t)(b * LP + slot) * 512) + lane; GAS u32x4* pv = (GAS u32x4*)(FV + (size_t)(b * LP + slot) * 512) + lane;
            *pk = (u32x4){0u, 0u, 0u, 0u}; *pv = (u32x4){0u, 0u, 0u, 0u};
            if (lane < 16) { *((GAS u32x4*)(SK + (size_t)(b * LP + r) * 128) + lane) = (u32x4){0u, 0u, 0u, 0u}; *((GAS u32x4*)(SV + (size_t)(b * LP + r) * 128) + lane) = (u32x4){0u, 0u, 0u, 0u}; } }
        for (int i = gw * 64 + lane; i < 8 * LP; i += NGW * 64) { const int h = i / LP, slot = i % LP; const float slope = exp2f(-(float)(h + 1));
            SBIAS[i] = (slot < 112) ? BIGB : -slope * (float)slot * LOG2E; }
        for (int m = NTOK + NMETA + gw; m < MROWS; m += NGW) { GAS u32x2* o8 = (GAS u32x2*)(XN + (size_t)m * DM) + lane;
#pragma unroll
            for (int j = 0; j < 4; ++j) o8[64 * j] = (u32x2){0u, 0u}; }
        if (wave < 4) {
            f32x4 wf[16][2];
#pragma unroll
            for (int q = 0; q < 16; ++q) { const float* wp = w_in + (size_t)(4 * lane + 256 * (q >> 2) + (q & 3)) * INW + 1536; wf[q][0] = *(const GAS f32x4*)wp; wf[q][1] = *(const GAS f32x4*)(wp + 4); }
            const int NRW = G * 4;
            for (int m0 = c * 4 + wave; m0 < NTOK + NMETA; m0 += 2 * NRW) {
                const int m1 = m0 + NRW; const bool has1 = m1 < NTOK + NMETA; const int mm[2] = {m0, has1 ? m1 : m0};
                f32x4 v[2][4]; float s2[2] = {0.f, 0.f};
#pragma unroll
                for (int r = 0; r < 2; ++r) { const float* xrow = (mm[r] < NTOK) ? in_x + (size_t)mm[r] * DM : meta + (size_t)(mm[r] - NTOK) * DM; const GAS f32x4* xr = (const GAS f32x4*)xrow + lane;
#pragma unroll
                    for (int j = 0; j < 4; ++j) v[r][j] = __builtin_nontemporal_load(xr + 64 * j); }
#pragma unroll
                for (int r = 0; r < 2; ++r)
#pragma unroll
                    for (int j = 0; j < 4; ++j) s2[r] += (v[r][j].x * v[r][j].x + v[r][j].y * v[r][j].y) + (v[r][j].z * v[r][j].z + v[r][j].w * v[r][j].w);
                s2[0] = wave_sum(s2[0]); s2[1] = wave_sum(s2[1]);
                float fl[2][8];
#pragma unroll
                for (int r = 0; r < 2; ++r) { const float rstd = 1.f / sqrtf(s2[r] * (1.f / DM) + RMS_EPS);
#pragma unroll
                    for (int h = 0; h < 8; ++h) fl[r][h] = 0.f;
                    GAS u32x2* o8 = (GAS u32x2*)(XN + (size_t)mm[r] * DM) + lane;
#pragma unroll
                    for (int j = 0; j < 4; ++j) { const f32x4 gg = *((const GAS f32x4*)g1 + lane + 64 * j); v[r][j] = v[r][j] * rstd * gg;
                        if (r == 0 || has1) o8[64 * j] = (u32x2){pk2(v[r][j].x, v[r][j].y), pk2(v[r][j].z, v[r][j].w)};
#pragma unroll
                        for (int cc = 0; cc < 4; ++cc) { const float hv = v[r][j][cc]; const f32x4 w0 = wf[4 * j + cc][0], w1 = wf[4 * j + cc][1];
                            fl[r][0] += hv * w0.x; fl[r][1] += hv * w0.y; fl[r][2] += hv * w0.z; fl[r][3] += hv * w0.w; fl[r][4] += hv * w1.x; fl[r][5] += hv * w1.y; fl[r][6] += hv * w1.z; fl[r][7] += hv * w1.w; } } }
#pragma unroll
                for (int r = 0; r < 2; ++r)
#pragma unroll
                    for (int h = 0; h < 8; ++h) fl[r][h] = wave_sum(fl[r][h]);
#pragma unroll
                for (int r = 0; r < 2; ++r)
                    if (lane < 8 && (r == 0 || has1)) { float z = 0.f;
#pragma unroll
                        for (int h = 0; h < 8; ++h) z = (lane == h) ? fl[r][h] : z;
                        z += b_forget[lane];
                        LOGF[(size_t)mm[r] * 8 + lane] = fminf(z, 0.f) - log1pf(expf(-fabsf(z))); }
            }
        }
        constexpr int I_IN = 16 * (NPHYS / 32), I_FO = 8 * 32, I_SO = 8 * 32, I_OUT = 16 * 32, NITEMS = I_IN + I_FO + I_SO + I_OUT;
        constexpr int I_UP = NE * 8 * 64, I_DN = NE * 8 * 32;
        const int fp8_per_wg = 0, ntask = (NITEMS / 2 + G - 1) / G;
        (void)I_UP; (void)I_DN;
        LAS int* qctr = (LAS int*)(F.lds + MISC_OFF + 132);
        for (;;) {
            int t = 0; if (lane == 0) t = __hip_atomic_fetch_add(qctr, 1, __ATOMIC_RELAXED, __HIP_MEMORY_SCOPE_WORKGROUP);
            t = __builtin_amdgcn_readfirstlane(t);
            if (t >= ntask) break;
            if (t < fp8_per_wg) { const int it = c * fp8_per_wg + t;
                if (it < I_UP) { const int e = it / (8 * 64), q = it % (8 * 64), kb = q / 64, nb = q % 64;
                    const int lcol = ((nb >> 2) & 1) * 1024 + (nb >> 3) * 128 + (nb & 3) * 32;
                    tr8_item(w_up + (size_t)e * DM * 2048, 2048, lcol, kb * 128, WUP + (size_t)e * 2048 * DM, DM, nb * 32, scr, lane); }
                else { const int r = it - I_UP, e = r / (8 * 32), q = r % (8 * 32), kb = q / 32, nb = q % 32;
                    tr8_item(w_down + (size_t)e * DM * DM, DM, nb * 32, kb * 128, WDN + (size_t)e * DM * DM, DM, nb * 32, scr, lane); }
            } else { const int it = 2 * (c + (t - fp8_per_wg) * G); if (it >= NITEMS) continue;
                TrItem ti[2];
#pragma unroll
                for (int q2 = 0; q2 < 2; ++q2) { int r = it + q2; TrItem tt;
                    if (r < I_IN) { const int kb = r / (NPHYS / 32), nb = r % (NPHYS / 32); tt = TrItem{w_in, INW, win_logical_col(nb * 32), kb * 64, WIN, DM, nb * 32}; }
                    else if ((r -= I_IN) < I_FO) { const int kb = r / 32, nb = r % 32; tt = TrItem{w_fo, DM, nb * 32, kb * 64, WFO, 512, nb * 32}; }
                    else if ((r -= I_FO) < I_SO) { const int kb = r / 32, nb = r % 32; tt = TrItem{w_so, DM, nb * 32, kb * 64, WSO, 512, nb * 32}; }
                    else { r -= I_SO; const int kb = r / 32, nb = r % 32; tt = TrItem{w_out, DM, nb * 32, kb * 64, WOUT, DM, nb * 32}; }
                    ti[q2] = tt; }
                f32x4 va[8], vb[8];
                tr_load(ti[0], va, lane); tr_load(ti[1], vb, lane);
                tr_store(ti[0], va, scr, lane); tr_store(ti[1], vb, scr, lane);
            }
        }
    }
#endif
    xcd_barrier(bar);

#ifndef NO_P1
    if (c >= G - 32) {
        const int tid = fresh_tid(), lane = tid & 63;
        const int bh_ = c - (G - 32), b = bh_ >> 3, h = bh_ & 7; LAS float* sc = (LAS float*)(F.lds + RING_OFF);
        float v[9]; float run = 0.f;
#pragma unroll
        for (int j = 0; j < 9; ++j) { const int t = 9 * tid + j; float lf = 0.f;
            if (t < NMETA + SEQ) lf = (t < NMETA) ? LOGF[(size_t)(NTOK + t) * 8 + h] : LOGF[(size_t)(b * SEQ + t - NMETA) * 8 + h];
            run += lf; v[j] = run; }
        sc[tid] = run; __syncthreads();
        if (wave == 0) { float carry = 0.f;
            for (int k = 0; k < 8; ++k) { float xv = sc[k * 64 + lane]; float inc = xv;
#pragma unroll
                for (int o = 1; o < 64; o <<= 1) { const float y = __shfl_up(inc, o); if (lane >= o) inc += y; }
                sc[k * 64 + lane] = carry + inc - xv; carry += __shfl(inc, 63); } }
        __syncthreads();
        const float base = sc[tid]; float* fb = FB + (size_t)(b * 8 + h) * LP;
#pragma unroll
        for (int j = 0; j < 9; ++j) { const int t = 9 * tid + j; if (t < NMETA + SEQ) { const int slot = (t < NMETA) ? 48 + t : 128 + (t - NMETA); fb[slot] = (base + v[j]) * LOG2E; } }
        if (tid < 112) fb[(tid < 48) ? tid : tid + 16] = BIGB;
        __syncthreads();
    }
    {
        SchedIn S{G, c, 0, IN_P1, (const char*)XN, (const char*)WIN};
        EpiIn E{FQ, FK, FV, SQ, SK, SV, GA, GB, gfq, gfk, gsq, gsk};
        pg8::gemm_phase<2 * DM, false, false, EpiIn, SchedIn>(F.lds + RING_OFF, S, E);
    }
    if (c >= G - 32) {
        conv_batch(2 * (c - (G - 32)), w_up, w_down, WUP, WDN, F.lds + RING_OFF);
        conv_batch(2 * (c - (G - 32)) + 1, w_up, w_down, WUP, WDN, F.lds + RING_OFF);
    }
#endif
    xcd_barrier(bar);

#ifndef NO_P2
#ifdef NAIVE_ATTN
    for (int T = gw; T < 2 * NTOK * 8; T += NGW) {
        const int which = T / (NTOK * 8), r = T % (NTOK * 8), h = r & 7, tokp = r >> 3;
        const int tok = tokp; const int b = tok >> 12, s = tok & 4095;
        if (which == 0) naive_attn_row(FQ + (size_t)tok * 512 + h * 64, FK + (size_t)b * LP * 512 + h * 64, FV + (size_t)b * LP * 512 + h * 64, 512, FB + (size_t)(b * 8 + h) * LP, 0, 128 + s, false, 0.f, OA + (size_t)tok * 512 + h * 64, lane);
        else { const int p = 128 + s; const float slope = exp2f(-(float)(h + 1));
            naive_attn_row(SQ + (size_t)tok * 512 + h * 64, SK + (size_t)b * LP * 128 + (h >> 2) * 64, SV + (size_t)b * LP * 128 + (h >> 2) * 64, 128, SBIAS + (size_t)h * LP, p - 127, p, true, (sinks[h] + slope * (float)p) * LOG2E, OB + (size_t)tok * 512 + h * 64, lane); }
    }
#else
    {
        {
            SchedIn S{G, c, IN_P1, IN_ALL, (const char*)XN, (const char*)WIN};
            EpiIn E{FQ, FK, FV, SQ, SK, SV, GA, GB, gfq, gfk, gsq, gsk};
            pg8::gemm_phase<2 * DM, false, false, EpiIn, SchedIn>(F.lds + RING_OFF, S, E);
        }
        char* shm = (char*)lds_raw + RING_OFF;
        const int tid = fresh_tid(), lane = tid & 63;
        float gq = fabsf(gfq[lane]), gk = fabsf(gfk[lane]); gq = wave_max(gq); gk = wave_max(gk);
        const float prune_thr = 2.f * (64.f * gq * gk * C2) + 40.f;
        volatile LAS int* qslot = (volatile LAS int*)(F.lds + MISC_OFF + 128);
        int unext = 0;
        if (tid == 0) unext = (int)__hip_atomic_fetch_add((unsigned*)(F.ctl + CW_QUEUE), 1u, __ATOMIC_RELAXED, __HIP_MEMORY_SCOPE_AGENT);
        for (;;) {
            if (tid == 0) *qslot = unext;
            __syncthreads();
            const int uq = __builtin_amdgcn_readfirstlane(*qslot);
            if (uq >= 1024 + NCB_P2) break;
            if (tid == 0) unext = (int)__hip_atomic_fetch_add((unsigned*)(F.ctl + CW_QUEUE), 1u, __ATOMIC_RELAXED, __HIP_MEMORY_SCOPE_AGENT);
            if (uq < 2 * NCB_P2 && (uq & 1)) { conv_batch(NCB_P1 + (uq >> 1), w_up, w_down, WUP, WDN, F.lds + RING_OFF); continue; }
            const int u = (uq < 2 * NCB_P2) ? (uq >> 1) : uq - NCB_P2;
            if (u < 512) {
                const int j = 15 - (u >> 5), b = (u >> 3) & 3, h = u & 7; int NT = 4 * j + 6;
                const float* fb = FB + (size_t)(b * 8 + h) * LP; const int refidx = 128 + 256 * j;
                int ts = 0;
                { const float bref = fb[refidx]; bool c0 = false, c1 = false; const int t0 = lane, t1 = lane + 64;
                  if (t0 >= 2 && t0 <= NT - 7) c0 = (fb[64 * t0 + 63] - bref) >= prune_thr;
                  if (t1 <= NT - 7) c1 = (fb[64 * t1 + 63] - bref) >= prune_thr;
                  const unsigned long long m0 = __ballot(c0), m1 = __ballot(c1);
                  if (m1) ts = 64 + (63 - __builtin_clzll(m1)) + 1; else if (m0) ts = (63 - __builtin_clzll(m0)) + 1;
                  ts &= ~1; ts = __builtin_amdgcn_readfirstlane(ts); }
                NT -= ts;
                attn::attn_unit<512, false, 8>(FQ + (size_t)(b * SEQ + 256 * j) * 512 + h * 64, FK + ((size_t)b * LP + 64 * ts) * 512 + h * 64, FV + ((size_t)b * LP + 64 * ts) * 512 + h * 64,
                                               OA + (size_t)(b * SEQ + 256 * j) * 512 + h * 64, NT, fb + 64 * ts, refidx - 64 * ts, 0.f, 0.f, shm);
            } else {
                const int w = u - 512, b = w >> 7, h = (w >> 4) & 7, j = w & 15, g = h >> 2; const float slope = exp2f(-(float)(h + 1));
                attn::attn_unit<128, true, 8>(SQ + (size_t)(b * SEQ + 256 * j) * 512 + h * 64, SK + ((size_t)b * LP + 256 * j) * 128 + g * 64, SV + ((size_t)b * LP + 256 * j) * 128 + g * 64,
                                              OB + (size_t)(b * SEQ + 256 * j) * 512 + h * 64, 6, SBIAS + (size_t)h * LP + 256 * j, 128, sinks[h] * LOG2E, slope * LOG2E, shm);
            }
        }
    }
#endif
#endif
    xcd_barrier(bar);

#ifndef NO_P3
    {
        SchedMix S{G, c, (const char*)OA, (const char*)OB, (const char*)WFO, (const char*)WSO};
        EpiMix E{MIX, GA, GB};
        pg8::gemm_phase<2 * 512, false, false, EpiMix, SchedMix>(F.lds + RING_OFF, S, E);
    }
#endif
    xcd_barrier(bar);

#ifndef NO_P4
    {
        SchedOut S{G, c, (const char*)MIX, (const char*)WOUT};
        EpiOut E{HRES, in_x};
        pg8::gemm_phase<2 * DM, false, false, EpiOut, SchedOut>(F.lds + RING_OFF, S, E);
    }
#endif
    xcd_barrier(bar);

#if defined(STOP_AFTER) && STOP_AFTER == 4
    for (int tok = gw; tok < NTOK; tok += NGW) {
#pragma unroll
        for (int j = 0; j < 4; ++j) *((GAS f32x4*)(args.out + (size_t)tok * DM) + lane + 64 * j) = *((const GAS f32x4*)(HRES + (size_t)tok * DM) + lane + 64 * j); }
    return;
#endif
#ifndef NO_P5
    {
        const int tid = fresh_tid(), lane = tid & 63;
        LAS float* WRT = (LAS float*)(F.lds + RING_OFF);
        { f32x4 wv_[16];
#pragma unroll
          for (int k = 0; k < 16; ++k) wv_[k] = *((const GAS f32x4*)w_router + tid + 512 * k);
#pragma unroll
          for (int k = 0; k < 16; ++k) { const int i4 = (tid + 512 * k) * 4, d = i4 >> 5, e0 = i4 & 31; WRT[(e0 + 0) * DM + d] = wv_[k].x; WRT[(e0 + 1) * DM + d] = wv_[k].y; WRT[(e0 + 2) * DM + d] = wv_[k].z; WRT[(e0 + 3) * DM + d] = wv_[k].w; } }
        LAS int* hist = tab + 96; LAS int* basee = tab + 128;
        LAS int* sel_e = (LAS int*)(F.lds + ROWS_OFF); LAS float* sel_g = (LAS float*)(F.lds + ROWS_OFF + 1024); LAS int* sel_r = (LAS int*)(F.lds + ROWS_OFF + 2048);
        if (tid < 32) hist[tid] = 0;
        __syncthreads();
        const int ntb = NTOK / G;
        constexpr int NTK = 4;
        for (int lt0 = wave * NTK; lt0 < ntb; lt0 += NWAVES * NTK) {
            f32x4 v[NTK][4]; float s2[NTK];
#pragma unroll
            for (int q = 0; q < NTK; ++q) { const GAS u32x2* hr = (const GAS u32x2*)(HRES + (size_t)(c * ntb + lt0 + q) * DM) + lane;
#pragma unroll
                for (int j = 0; j < 4; ++j) { const u32x2 w = hr[64 * j]; v[q][j] = (f32x4){bflo(w.x), bfhi(w.x), bflo(w.y), bfhi(w.y)}; } }
#pragma unroll
            for (int q = 0; q < NTK; ++q) { float a = 0.f;
#pragma unroll
                for (int j = 0; j < 4; ++j) a += (v[q][j].x * v[q][j].x + v[q][j].y * v[q][j].y) + (v[q][j].z * v[q][j].z + v[q][j].w * v[q][j].w);
                s2[q] = a; }
#pragma unroll
            for (int q = 0; q < NTK; ++q) s2[q] = wave_sum(s2[q]);
#pragma unroll
            for (int q = 0; q < NTK; ++q) { const float rstd = 1.f / sqrtf(s2[q] * (1.f / DM) + RMS_EPS);
                GAS unsigned* o8 = (GAS unsigned*)(H2 + (size_t)(c * ntb + lt0 + q) * DM) + lane;
#pragma unroll
                for (int j = 0; j < 4; ++j) { const f32x4 gg = *((const GAS f32x4*)g2 + lane + 64 * j); v[q][j] = v[q][j] * rstd * gg; const f32x4 qq = __builtin_elementwise_min(__builtin_elementwise_max(v[q][j] * SC_H, (f32x4){-448.f, -448.f, -448.f, -448.f}), (f32x4){448.f, 448.f, 448.f, 448.f}); o8[64 * j] = pk4_fp8(qq.x, qq.y, qq.z, qq.w); } }
            float pe[NTK][32];
            unsigned wb0 = (unsigned)(RING_OFF + 16 * lane), wb1 = wb0 + 65536u; asm volatile("" : "+v"(wb0), "+v"(wb1));
#pragma unroll
            for (int e = 0; e < 32; ++e) { float a[NTK]; _Pragma("unroll") for (int q = 0; q < NTK; ++q) a[q] = 0.f; const unsigned wb = (e < 16) ? wb0 : wb1;
#pragma unroll
                for (int j = 0; j < 4; ++j) { const f32x4 w = *(const LAS f32x4*)(F.lds + wb + ((e & 15) * 4096 + j * 1024));
#pragma unroll
                    for (int q = 0; q < NTK; ++q) a[q] += (v[q][j].x * w.x + v[q][j].y * w.y) + (v[q][j].z * w.z + v[q][j].w * w.w); }
#pragma unroll
                for (int q = 0; q < NTK; ++q) { asm volatile("" : "+v"(a[q])); pe[q][e] = a[q]; } }
            const int my_e = lane >> 1;
            const float brt = b_router[my_e];
            router_finish(pe[0], brt, lane, lt0 + 0, hist, sel_e, sel_g, sel_r);
            if constexpr (NTK > 1) router_finish(pe[1 % NTK], brt, lane, lt0 + 1, hist, sel_e, sel_g, sel_r);
            if constexpr (NTK > 2) { router_finish(pe[2 % NTK], brt, lane, lt0 + 2, hist, sel_e, sel_g, sel_r); router_finish(pe[3 % NTK], brt, lane, lt0 + 3, hist, sel_e, sel_g, sel_r); }
        }
        __syncthreads();
        if (tid < 32) basee[tid] = (int)atomicAdd((unsigned*)(F.ctl + CW_CNT + 64 * tid), (unsigned)hist[tid]);
        __syncthreads();
        for (int i = tid; i < ntb * 4; i += NWAVES * 64) { const int tok = c * ntb + (i >> 2); const int e = sel_e[i]; const int pos = basee[e] + sel_r[i];
            ROWTOK[(size_t)e * ECAP + pos] = tok; ROWW[(size_t)e * ECAP + pos] = sel_g[i]; TOKDEST[(size_t)tok * 4 + (i & 3)] = e * ECAP + pos; }
    }
#endif
    xcd_barrier(bar);

    int T_tiles;
    {
        const int tid = fresh_tid();
        if (tid < 32) tab[tid] = (int)__hip_atomic_load(F.ctl + CW_CNT + 64 * tid, RLX_AGENT);
        __syncthreads();
        if (tid < 64) { const int nt_ = (tid < NE) ? ((tab[tid] + 255) >> 8) : 0; int inc = nt_;
#pragma unroll
            for (int o = 1; o < 32; o <<= 1) { const int y = __shfl_up(inc, o); if ((tid & 63) >= o) inc += y; }
            if (tid < NE) tab[32 + tid] = inc - nt_; if (tid == NE - 1) tab[32 + NE] = inc; }
        __syncthreads();
        T_tiles = tab[32 + NE];
    }
#ifndef NO_P6
    {
        const int tid = fresh_tid();
        LAS int* utab = (LAS int*)(F.lds + UTAB_OFF); moe_units(utab, tab, T_tiles, 8, G, c, tid);
        SchedMoe S{G, c, 8, utab, (const char*)H2, (const char*)WUP, 1, DM};
        for (int i = 0; i < 10; ++i) { pg8::Unit u; if (!S.next(i, u)) break;
            if (tid < 256) { const int e = u.i2, lt0 = (u.i0 - tab[32 + e]) * 256; ((LAS int*)(F.lds + ROWS_OFF + i * 1024))[tid] = (tid < u.i3) ? ROWTOK[(size_t)e * ECAP + lt0 + tid] : 0; } }
        __syncthreads();
        EpiUp E{ACT, b_up};
        pg8::gemm_phase<DM, true, true, EpiUp, SchedMoe>(F.lds + RING_OFF, S, E);
        volatile LAS int* qslot = (volatile LAS int*)(F.lds + MISC_OFF + 128);
        for (;;) {
            if (fresh_tid() == 0) *qslot = (int)__hip_atomic_fetch_add((unsigned*)(F.ctl + CW_QUEUE + 64), 1u, __ATOMIC_RELAXED, __HIP_MEMORY_SCOPE_AGENT);
            __syncthreads();
            const int b6 = __builtin_amdgcn_readfirstlane(*qslot);
            __syncthreads();
            if (b6 >= NCB_P6) break;
            conv_batch(1024 - NCB_P6 + b6, w_up, w_down, WUP, WDN, F.lds + RING_OFF);
        }
    }
#endif
    xcd_barrier(bar);

#ifndef NO_P7
    {
        LAS int* utab = (LAS int*)(F.lds + UTAB_OFF); moe_units(utab, tab, T_tiles, 4, G, c, fresh_tid());
        SchedMoe S{G, c, 4, utab, (const char*)ACT, (const char*)WDN, 0, DM};
        EpiDown E{YS, b_down, ROWW, tab};
        pg8::gemm_phase<DM, true, false, EpiDown, SchedMoe>(F.lds + RING_OFF, S, E);
    }
#endif
    xcd_barrier(bar);

#ifndef NO_P8
    {
        const int lane = fresh_tid() & 63;
        const bool poison = (__hip_atomic_load(F.ctl + CW_BAR + XB_TMO, RLX_AGENT) != 0u) || (T_tiles > MAXTILES);
        for (int tok0 = gw; tok0 < NTOK; tok0 += 2 * NGW) {
            const int tk[2] = {tok0, tok0 + NGW};
            u32x4 y[2][4]; u32x4 hb[2][2];
#pragma unroll
            for (int q = 0; q < 2; ++q) {
#pragma unroll
                for (int k = 0; k < 4; ++k) { const int d = TOKDEST[(size_t)tk[q] * 4 + k]; const int e = d / ECAP, pos = d % ECAP; const int row = tab[32 + e] * 256 + pos;
                    y[q][k] = __builtin_nontemporal_load((const GAS u32x4*)(YS + (size_t)row * DM) + lane); }
#pragma unroll
                for (int j = 0; j < 2; ++j) hb[q][j] = *((const GAS u32x4*)(HRES + (size_t)tk[q] * DM) + 2 * lane + j); }
#pragma unroll
            for (int q = 0; q < 2; ++q)
#pragma unroll
                for (int j = 0; j < 4; ++j) { f32x2 lo = {0.f, 0.f}, hi = {0.f, 0.f};
#pragma unroll
                    for (int k = 0; k < 4; ++k) { const unsigned w = y[q][k][j]; lo += __builtin_amdgcn_cvt_pk_f32_fp8((int)w, false); hi += __builtin_amdgcn_cvt_pk_f32_fp8((int)w, true); }
                    const unsigned h0 = hb[q][j >> 1][2 * (j & 1)], h1 = hb[q][j >> 1][2 * (j & 1) + 1]; f32x4 a = {bflo(h0), bfhi(h0), bflo(h1), bfhi(h1)}; a.x += lo.x * (1.f / SC_Y); a.y += lo.y * (1.f / SC_Y); a.z += hi.x * (1.f / SC_Y); a.w += hi.y * (1.f / SC_Y);
                    if (poison) a = (f32x4){__builtin_nanf(""), __builtin_nanf(""), __builtin_nanf(""), __builtin_nanf("")};
                    __builtin_nontemporal_store(a, (GAS f32x4*)(args.out + (size_t)tk[q] * DM) + 4 * lane + j); }
        }
    }
#endif
}

extern "C" void kernel_launch(void* const* d_in, const int* in_sizes, int n_in, void* d_out, int out_size, void* d_ws, size_t ws_size, hipStream_t stream) {
    static int grid = 0;
    if (grid == 0) {
        if (n_in != 20 || in_sizes[0] != NTOK * DM || out_size != NTOK * DM || ws_size < WS_END) { fprintf(stderr, "kernel_launch: unexpected shapes / workspace (%d inputs, ws %zu)\n", n_in, ws_size); grid = -1; return; }
        int dev = 0, cus = 0, per_cu = 0;
        if (hipGetDevice(&dev) != hipSuccess || hipDeviceGetAttribute(&cus, hipDeviceAttributeMultiprocessorCount, dev) != hipSuccess) { grid = -1; return; }
        if (hipFuncSetAttribute((const void*)hybrid_fwd, hipFuncAttributeMaxDynamicSharedMemorySize, LDS_BYTES) != hipSuccess) { grid = -1; return; }
        if (hipOccupancyMaxActiveBlocksPerMultiprocessor(&per_cu, (const void*)hybrid_fwd, NWAVES * 64, LDS_BYTES) != hipSuccess || per_cu < 1) { fprintf(stderr, "kernel_launch: occupancy query says %d\n", per_cu); }
        (void)hipGetLastError();
        grid = cus;
        if (grid > 256) grid = 256;
    }
    if (grid < 0) return;
    if (hipMemsetAsync((char*)d_ws + WS_CTL, 0, CTL_ZERO_BYTES, stream) != hipSuccess) return;
    Args a{};
    for (int i = 0; i < 20; ++i) a.in[i] = (const float*)d_in[i];
    a.out = (float*)d_out; a.ws = (unsigned char*)d_ws;
    hipLaunchKernelGGL(hybrid_fwd, dim3(grid), dim3(NWAVES * 64), LDS_BYTES, stream, a);
}
```

```cpp
#include <hip/hip_runtime.h>
#include <cstdio>
#include <cstdint>

#define GAS __attribute__((address_space(1)))
#define LAS __attribute__((address_space(3)))
typedef unsigned short bf16_t;
typedef short bf16x8 __attribute__((ext_vector_type(8)));
typedef float f32x4 __attribute__((ext_vector_type(4)));
typedef float f32x2 __attribute__((ext_vector_type(2)));
typedef unsigned u32x4 __attribute__((ext_vector_type(4)));
typedef unsigned u32x2 __attribute__((ext_vector_type(2)));
typedef GAS unsigned gu32;
typedef int i32x4 __attribute__((ext_vector_type(4)));
typedef int i32x8 __attribute__((ext_vector_type(8)));
#define RLX_AGENT __ATOMIC_RELAXED, __HIP_MEMORY_SCOPE_AGENT
#define LDS_WAIT() asm volatile("s_waitcnt lgkmcnt(0)" ::: "memory")
#define VM_WAIT() asm volatile("s_waitcnt vmcnt(0)" ::: "memory")

constexpr int NB = 4, SEQ = 4096, DM = 1024, NTOK = NB * SEQ, NMETA = 16, MROWS = 16640, LP = 4224;
constexpr int HD = 64, NE = 32, INW = 4360, NPHYS = 4352;
constexpr int MAXTILES = 288, MAXROWS = MAXTILES * 256, ECAP = 16384;
constexpr float RMS_EPS = 1e-6f, LOG2E = 1.4426950408889634f, C2 = 0.125f * LOG2E, BIGB = 1e30f;
constexpr int NWAVES = 8;
constexpr float SC_W = 256.f, SC_H = 16.f, SC_A = 4.f, SC_Y = 64.f;

constexpr size_t MiB = 1u << 20;
constexpr size_t WS_CTL = 0, CTL_ZERO_BYTES = 1 * MiB;
constexpr size_t WS_WIN = 2 * MiB, WS_WFO = 11 * MiB, WS_WSO = 12 * MiB, WS_WOUT = 13 * MiB, WS_WUP = 16 * MiB, WS_WDN = 144 * MiB;
constexpr size_t WS_XN = 208 * MiB, WS_LOGF = 241 * MiB, WS_FB = 242 * MiB, WS_SBIAS = 243 * MiB;
constexpr size_t WS_FQ = 244 * MiB, WS_FK = 260 * MiB, WS_FV = 277 * MiB, WS_SQ = 294 * MiB, WS_SK = 310 * MiB, WS_SV = 315 * MiB;
constexpr size_t WS_GA = 320 * MiB, WS_GB = 352 * MiB, WS_OA = 384 * MiB, WS_OB = 400 * MiB, WS_MIX = 416 * MiB, WS_HRES = 448 * MiB, WS_H2 = 512 * MiB;
constexpr size_t WS_TOKDEST = 544 * MiB, WS_ROWTOK = 545 * MiB, WS_ROWW = 547 * MiB, WS_ACT = 550 * MiB, WS_YS = 694 * MiB, WS_END = 838 * MiB;
constexpr int CW_TMO = 0, CW_CODE = 1, CW_BAR = 4096, CW_CNT = 8192, CW_QUEUE = 12288;

constexpr int RING_OFF = 0, RING_BYTES = 131072;
constexpr int ROWS_OFF = RING_BYTES;
constexpr int ROWS_BYTES = 10 * 1024;
constexpr int LDSCTL_OFF = ROWS_OFF + ROWS_BYTES;
constexpr int MISC_OFF = LDSCTL_OFF;
constexpr int TAB_OFF = MISC_OFF + 256;
constexpr int UTAB_OFF = TAB_OFF + 1024;
constexpr int LDS_BYTES = 147456;
static_assert(UTAB_OFF + 256 <= LDS_BYTES, "LDS map");

__device__ __forceinline__ unsigned f2bf(float f) { unsigned u = __builtin_bit_cast(unsigned, f); return (u + 0x7fffu + ((u >> 16) & 1u)) >> 16; }
__device__ __forceinline__ unsigned pk2(float lo, float hi) { return f2bf(lo) | (f2bf(hi) << 16); }
__device__ __forceinline__ float bf2f(unsigned short b) { return __builtin_bit_cast(float, (unsigned)b << 16); }
__device__ __forceinline__ float bflo(unsigned w) { return __builtin_bit_cast(float, w << 16); }
__device__ __forceinline__ float bfhi(unsigned w) { return __builtin_bit_cast(float, w & 0xffff0000u); }
__device__ __forceinline__ float wave_sum(float v) {
#pragma unroll
    for (int o = 1; o < 64; o <<= 1) v += __shfl_xor(v, o);
    return v;
}
__device__ __forceinline__ float wave_max(float v) {
#pragma unroll
    for (int o = 1; o < 64; o <<= 1) v = fmaxf(v, __shfl_xor(v, o));
    return v;
}
__device__ __forceinline__ int fresh_tid() { int t = threadIdx.x; asm volatile("" : "+v"(t)); return t; }
__device__ __forceinline__ unsigned pk4_fp8(float a, float b, float c, float d) { int w = __builtin_amdgcn_cvt_pk_fp8_f32(a, b, 0, false); w = __builtin_amdgcn_cvt_pk_fp8_f32(c, d, w, true); return (unsigned)w; }
__device__ __forceinline__ float sigmoidf_fast(float x) { return __builtin_amdgcn_rcpf(1.f + __builtin_amdgcn_exp2f(-x * LOG2E)); }

namespace pg8 {
constexpr int BM = 256, BK = 64, HALF = 128, HTB = HALF * BK * 2, STAGE_BYTES = 8 * HTB;
__host__ __device__ __forceinline__ int lds_byte(int r, int c) { const int st = (r >> 4) * 2 + (c >> 5), rr = r & 15, cc = c & 31, ob = rr * 64 + cc * 2; return st * 1024 + (ob ^ (((ob >> 9) & 1) << 5)); }
__host__ __device__ __forceinline__ void stage_rc(int b, int& R, int& C) { const int st = b / 1024, sb = b % 1024, swz = sb ^ (((sb >> 9) & 1) << 5); R = (st >> 1) * 16 + swz / 64; C = (st & 1) * 32 + (swz % 64) / 2; }
__host__ __device__ __forceinline__ int perm32(int rho) { const int n = rho >> 4, i = rho & 15; return 8 * (i >> 2) + 4 * n + (i & 3); }

struct Unit { const char* A; const char* B; int rows_lds; int i0, i1, i2, i3; };

template <int PB, bool FP8, bool GATHER, class Epi, class Sched>
__device__ __forceinline__ void gemm_phase(LAS unsigned char* lds, const Sched& S, const Epi& E) {
    int tid_ = threadIdx.x; asm volatile("" : "+v"(tid_));
    const int tid = tid_, wid = __builtin_amdgcn_readfirstlane(tid >> 6), lane = tid & 63, wr = wid >> 2, wc = wid & 3, fr = lane & 15, fq = lane >> 4;
    constexpr int nt = PB / 128;
    int Rs[2], Cs[2]; unsigned voffB[2];
#pragma unroll
    for (int i = 0; i < 2; ++i) { int R, C; stage_rc(tid * 16 + i * 8192, R, C); Rs[i] = R; Cs[i] = C; const int Rb = (R & ~31) + perm32(R & 31); voffB[i] = (unsigned)(Rb * PB + C * 2); }
    constexpr size_t kstep = (size_t)(BK * 2);
    constexpr size_t hstep = (size_t)HALF * PB;
    const unsigned ldsw = (unsigned)wid * 1024u;
    const int aoff = lds_byte(wr * 64 + fr, fq * 8), boff = lds_byte(wc * 32 + fr, fq * 8);
#define PG8_SA(b, h) (((b) * 2 + (h)) * HTB)
#define PG8_SB(b, h) ((4 + (b) * 2 + (h)) * HTB)
#define PG8_STAGE(bufoff, gbase, v0, v1) do { \
        __builtin_amdgcn_global_load_lds((const unsigned*)((const char*)(gbase) + (v0)), (LAS unsigned*)(lds + (bufoff) + ldsw), 16, 0, 0); \
        __builtin_amdgcn_global_load_lds((const unsigned*)((const char*)(gbase) + (v1)), (LAS unsigned*)(lds + (bufoff) + ldsw + 8192), 16, 0, 0); } while (0)
#define PG8_STB(bufoff, gbase) PG8_STAGE(bufoff, gbase, voffB[0], voffB[1])
#define PG8_LDA(dst, b, h) do { _Pragma("unroll") for (int m = 0; m < 4; ++m) _Pragma("unroll") for (int k = 0; k < 2; ++k) dst[m][k] = *(const LAS bf16x8*)(lds + PG8_SA(b, h) + aoff + m * 2048 + k * 1024); } while (0)
#define PG8_LDB(dst, b, h) do { _Pragma("unroll") for (int n = 0; n < 2; ++n) _Pragma("unroll") for (int k = 0; k < 2; ++k) dst[n][k] = *(const LAS bf16x8*)(lds + PG8_SB(b, h) + boff + n * 2048 + k * 1024); } while (0)
#define PG8_CAT(x0, x1) __builtin_shufflevector(__builtin_bit_cast(i32x4, x0), __builtin_bit_cast(i32x4, x1), 0, 1, 2, 3, 4, 5, 6, 7)
#define PG8_MMA(ai, bj, At, Bt) do { __builtin_amdgcn_s_setprio(1); _Pragma("unroll") for (int m = 0; m < 4; ++m) _Pragma("unroll") for (int n = 0; n < 2; ++n) { \
        if constexpr (FP8) { asm volatile("v_mfma_scale_f32_16x16x128_f8f6f4 %0, %1, %2, %0, %3, %3 op_sel_hi:[0,0,0]" : "+v"(acc[ai][bj][m][n]) : "v"(PG8_CAT(Bt[n][0], Bt[n][1])), "v"(PG8_CAT(At[m][0], At[m][1])), "v"(scl)); }   \
        else { _Pragma("unroll") for (int k = 0; k < 2; ++k) acc[ai][bj][m][n] = __builtin_amdgcn_mfma_f32_16x16x32_bf16(Bt[n][k], At[m][k], acc[ai][bj][m][n], 0, 0, 0); } } \
        __builtin_amdgcn_s_setprio(0); } while (0)
#define PG8_WAIT_V(n) asm volatile("s_waitcnt vmcnt(" #n ")" ::: "memory")
#define PG8_WAIT_L(n) asm volatile("s_waitcnt lgkmcnt(" #n ")" ::: "memory")
#define PG8_BAR __builtin_amdgcn_s_barrier()
#define PG8_SCHED __builtin_amdgcn_sched_barrier(0)
#define PG8_SETA(v, u) do { _Pragma("unroll") for (int h = 0; h < 2; ++h) _Pragma("unroll") for (int i = 0; i < 2; ++i) { \
        if constexpr (GATHER) { const int tk = *(const LAS int*)(lds + (u).rows_lds + 4 * (h * HALF + Rs[i])); v[h][i] = (unsigned)(tk * PB + Cs[i] * 2); } \
        else v[h][i] = (unsigned)((h * HALF + Rs[i]) * PB + Cs[i] * 2); } } while (0)
    Unit cur, nxt; int ui = 0; bool relax_prev = false;
    if (!S.next(0, cur)) return;
    int scl = 0x7F7F7F7F; asm volatile("" : "+v"(scl));
    f32x4 acc[2][2][4][2];
#pragma unroll
    for (int a = 0; a < 2; ++a)
#pragma unroll
        for (int b = 0; b < 2; ++b)
#pragma unroll
            for (int m = 0; m < 4; ++m)
#pragma unroll
                for (int n = 0; n < 2; ++n) acc[a][b][m][n] = (f32x4){0.f, 0.f, 0.f, 0.f};
    bf16x8 At[4][2], B0[2][2], B1[2][2];
    unsigned vAc[2][2], vAn[2][2];
    PG8_SETA(vAc, cur);
    if constexpr (GATHER) { PG8_WAIT_L(0); }
    const char* cA = cur.A; const char* cB = cur.B;
    PG8_STB(PG8_SB(0, 0), cB); PG8_STB(PG8_SB(0, 1), cB + hstep); PG8_STAGE(PG8_SA(0, 0), cA, vAc[0][0], vAc[0][1]); PG8_STAGE(PG8_SA(0, 1), cA, vAc[1][0], vAc[1][1]);
    if (wr == 1) PG8_BAR;
    PG8_WAIT_V(2); PG8_BAR;
    PG8_STB(PG8_SB(1, 0), cB + kstep); PG8_STAGE(PG8_SA(1, 0), cA + kstep, vAc[0][0], vAc[0][1]); PG8_STB(PG8_SB(1, 1), cB + hstep + kstep);
    PG8_WAIT_V(6); PG8_BAR;
    for (;;) {
        const bool has_next = S.next(ui + 1, nxt);
        const char* nA = has_next ? nxt.A : cA; const char* nB = has_next ? nxt.B : cB;
        if constexpr (GATHER) { if (has_next) { PG8_SETA(vAn, nxt); } else {
#pragma unroll
            for (int h = 0; h < 2; ++h)
#pragma unroll
                for (int i = 0; i < 2; ++i) vAn[h][i] = vAc[h][i]; } }
#pragma unroll 1
        for (int t = 0; t < nt; t += 2) {
            const bool last = (t == nt - 2);
            const bool first = (t == 0) && (ui > 0), relax = first && relax_prev;
            const char* a1 = cA + (size_t)(t + 1) * kstep;
            const char* a2 = last ? nA : cA + (size_t)(t + 2) * kstep; const char* b2 = last ? nB : cB + (size_t)(t + 2) * kstep;
            const char* a3 = a2 + kstep; const char* b3 = b2 + kstep;
            unsigned w00, w01, w10, w11;
            if constexpr (GATHER) { w00 = last ? vAn[0][0] : vAc[0][0]; w01 = last ? vAn[0][1] : vAc[0][1]; w10 = last ? vAn[1][0] : vAc[1][0]; w11 = last ? vAn[1][1] : vAc[1][1]; }
            else { w00 = vAc[0][0]; w01 = vAc[0][1]; w10 = vAc[1][0]; w11 = vAc[1][1]; }
#define PG8_WAIT_VR() do { if (relax) asm volatile("s_waitcnt vmcnt(%0)" :: "n"(8 + Epi::NS) : "memory"); else PG8_WAIT_V(8); } while (0)
            PG8_LDB(B0, 0, 0); PG8_LDB(B1, 0, 1); PG8_SCHED; PG8_LDA(At, 0, 0); if (!first) PG8_STAGE(PG8_SA(1, 1), a1, vAc[1][0], vAc[1][1]);
            PG8_WAIT_VR(); PG8_WAIT_L(0); PG8_BAR; PG8_MMA(0, 0, At, B0); PG8_MMA(0, 1, At, B1); PG8_BAR; PG8_SCHED;
            PG8_LDA(At, 0, 1); PG8_STB(PG8_SB(0, 0), b2); PG8_STB(PG8_SB(0, 1), b2 + hstep); PG8_STAGE(PG8_SA(0, 0), a2, w00, w01);
            PG8_WAIT_VR(); PG8_WAIT_L(0); PG8_BAR; PG8_MMA(1, 0, At, B0); PG8_MMA(1, 1, At, B1); PG8_BAR; PG8_SCHED;
            PG8_LDB(B0, 1, 0); PG8_LDB(B1, 1, 1); PG8_SCHED; PG8_LDA(At, 1, 0); PG8_STAGE(PG8_SA(0, 1), a2, w10, w11);
            PG8_WAIT_VR(); PG8_WAIT_L(0); PG8_BAR; PG8_MMA(0, 0, At, B0); PG8_MMA(0, 1, At, B1); PG8_BAR; PG8_SCHED;
            PG8_LDA(At, 1, 1); PG8_STB(PG8_SB(1, 0), b3); PG8_STB(PG8_SB(1, 1), b3 + hstep); PG8_STAGE(PG8_SA(1, 0), a3, w00, w01);
            PG8_WAIT_V(8); PG8_WAIT_L(0); PG8_BAR; PG8_MMA(1, 0, At, B0); PG8_MMA(1, 1, At, B1); PG8_BAR; PG8_SCHED;
#undef PG8_WAIT_VR
        }
        if (has_next) { if constexpr (GATHER) PG8_STAGE(PG8_SA(1, 1), nA + kstep, vAn[1][0], vAn[1][1]); else PG8_STAGE(PG8_SA(1, 1), nA + kstep, vAc[1][0], vAc[1][1]); }
        asm volatile("" ::: "memory");
        relax_prev = E.relax_ok(cur);
        if (wr == 0) PG8_BAR;
        if constexpr (FP8) asm volatile("s_nop 15\n\ts_nop 7" ::: "memory");
        E(acc, cur, wr, wc, fr, fq);
        if (!has_next) break;
        if (!E.keep_acc(cur)) {
#pragma unroll
        for (int a = 0; a < 2; ++a)
#pragma unroll
            for (int b = 0; b < 2; ++b)
#pragma unroll
                for (int m = 0; m < 4; ++m)
#pragma unroll
                    for (int n = 0; n < 2; ++n) acc[a][b][m][n] = (f32x4){0.f, 0.f, 0.f, 0.f};
        }
        cur = nxt; cA = nA; cB = nB; ++ui;
        if constexpr (GATHER) {
#pragma unroll
            for (int h = 0; h < 2; ++h)
#pragma unroll
                for (int i = 0; i < 2; ++i) vAc[h][i] = vAn[h][i]; }
        if (wr == 1) PG8_BAR;
    }
    PG8_WAIT_V(0);
    PG8_BAR;
#undef PG8_SA
#undef PG8_SB
#undef PG8_STAGE
#undef PG8_STB
#undef PG8_LDA
#undef PG8_LDB
#undef PG8_MMA
#undef PG8_CAT
#undef PG8_WAIT_V
#undef PG8_WAIT_L
#undef PG8_BAR
#undef PG8_SCHED
#undef PG8_SETA
}
}

namespace attn {
using s16x4 = __attribute__((ext_vector_type(4))) short;
using f32x16 = __attribute__((ext_vector_type(16))) float;
constexpr int NW = 8, QBLK = 32, QB = QBLK * NW, KVBLK = 64, QP = 512;
__device__ __forceinline__ int crow(int r, int hi) { return (r & 3) + 8 * (r >> 2) + 4 * hi; }
#define SBAR() __builtin_amdgcn_sched_barrier(0)
__device__ __forceinline__ void cmask(f32x16& p0, f32x16& p1, int jb, int qrel, int hi) {
  const float NEG = -INFINITY; int kb = 64 * jb + 4 * hi;
  #pragma unroll
  for (int r = 0; r < 16; ++r) { int kv = kb + (r & 3) + 8 * (r >> 2); if (kv > qrel) p0[r] = NEG; if (kv + 32 > qrel) p1[r] = NEG; }
}
__device__ __forceinline__ void wmask(f32x16& p0, f32x16& p1, int t, int qrel, int hi) {
  const float NEG = -INFINITY; int kb = 64 * t + 4 * hi;
  #pragma unroll
  for (int r = 0; r < 16; ++r) { int kv = kb + (r & 3) + 8 * (r >> 2); if (kv <= qrel) p0[r] = NEG; if (kv + 32 <= qrel) p1[r] = NEG; }
}
constexpr int NSLOT = 3, SLOTB = 8192;
constexpr int LDS_K = 0, LDS_V = NSLOT * SLOTB, LDS_WS = 2 * NSLOT * SLOTB, LDS_OST = LDS_WS + NW * 64 * 4, LDS_BIAS = LDS_OST + NW * 4096, LDS_BYTES = LDS_BIAS + LP * 4;
__device__ __forceinline__ void glds16(const void* gsrc, unsigned lds_dst) { unsigned keep;
  asm volatile("s_mov_b32 %0, m0\n\ts_mov_b32 m0, %2\n\ts_nop 0\n\tglobal_load_lds_dwordx4 %1, off\n\ts_mov_b32 m0, %0" : "=&s"(keep) : "v"(gsrc), "s"(lds_dst) : "memory"); }
__device__ __forceinline__ float max3f(float a, float b, float c) { float r; asm("v_max3_f32 %0, %1, %2, %3" : "=v"(r) : "v"(a), "v"(b), "v"(c)); return r; }
__device__ __forceinline__ float max2f(float a, float b) { float r; asm("v_max_f32_e32 %0, %1, %2" : "=v"(r) : "v"(a), "v"(b)); return r; }
__device__ __forceinline__ float fadd_s(float a, float b) { float r; asm("v_add_f32_e32 %0, %1, %2" : "=v"(r) : "v"(a), "v"(b)); return r; }
__device__ __forceinline__ float fsub_s(float a, float b) { float r; asm("v_sub_f32_e32 %0, %1, %2" : "=v"(r) : "v"(a), "v"(b)); return r; }
typedef float f32x2_t __attribute__((ext_vector_type(2))); typedef __bf16 bf16x2_t __attribute__((ext_vector_type(2)));
__device__ __forceinline__ unsigned cvtpk_s(float lo, float hi) { f32x2_t v = {lo, hi}; bf16x2_t b = __builtin_convertvector(v, bf16x2_t); return __builtin_bit_cast(unsigned, b); }
#define WAIT_BAR(N) asm volatile("s_waitcnt vmcnt(" #N ") lgkmcnt(0)\n\ts_barrier" ::: "memory")
typedef __attribute__((address_space(3))) const char* lds_cptr;
typedef short v4i16_t __attribute__((ext_vector_type(4)));
__device__ __forceinline__ void qkt(f32x16& p0, f32x16& p1, lds_cptr Kslot, const bf16x8* qr, int r32, int hi) {
  lds_cptr kb = Kslot + hi * 1024 + r32 * 16;
  #pragma unroll
  for (int d0 = 0; d0 < 4; ++d0) {
    const bf16x8 b0 = *(const LAS bf16x8*)(kb + d0 * 2048);
    const bf16x8 b1 = *(const LAS bf16x8*)(kb + d0 * 2048 + 512);
    p0 = __builtin_amdgcn_mfma_f32_32x32x16_bf16(b0, qr[d0], p0, 0, 0, 0); p1 = __builtin_amdgcn_mfma_f32_32x32x16_bf16(b1, qr[d0], p1, 0, 0, 0); }
}
__device__ __forceinline__ void kload8(bf16x8* kf, lds_cptr kp) {
  kf[0] = *(const LAS bf16x8*)(kp);        kf[1] = *(const LAS bf16x8*)(kp + 512);
  kf[2] = *(const LAS bf16x8*)(kp + 2048); kf[3] = *(const LAS bf16x8*)(kp + 2560);
  kf[4] = *(const LAS bf16x8*)(kp + 4096); kf[5] = *(const LAS bf16x8*)(kp + 4608);
  kf[6] = *(const LAS bf16x8*)(kp + 6144); kf[7] = *(const LAS bf16x8*)(kp + 6656);
}
__device__ __forceinline__ void kload2(bf16x8* kf, lds_cptr kp, int j) { kf[2 * j] = *(const LAS bf16x8*)(kp + j * 2048); kf[2 * j + 1] = *(const LAS bf16x8*)(kp + j * 2048 + 512); }
__device__ __forceinline__ s16x4 vtr(lds_cptr p) { return __builtin_bit_cast(s16x4, __builtin_amdgcn_ds_read_tr16_b64_v4i16((LAS v4i16_t*)p)); }
__device__ __forceinline__ float rowmax(const f32x16& p0, const f32x16& p1) {
  float a = max3f(p0[0], p0[1], p1[0]), b = max3f(p0[2], p0[3], p1[1]); a = max3f(a, p1[2], p1[3]);
  #pragma unroll
  for (int r = 4; r < 16; r += 4) { a = max3f(a, p0[r], p0[r + 1]); b = max3f(b, p0[r + 2], p0[r + 3]); a = max3f(a, p1[r], p1[r + 1]); b = max3f(b, p1[r + 2], p1[r + 3]); }
  const float m = max2f(a, b);
  auto rr = __builtin_amdgcn_permlane32_swap(__float_as_uint(m), __float_as_uint(m), false, false);
  return max2f(__uint_as_float(rr[0]), __uint_as_float(rr[1]));
}
__device__ __forceinline__ void pv(f32x16* o, int vb, bf16x8 pa0, bf16x8 pa1, bf16x8 pa2, bf16x8 pa3) {
  #pragma unroll
  for (int d0 = 0; d0 < 2; ++d0) { s16x4 lo[4], hi[4];
    #pragma unroll
    for (int ks = 0; ks < 4; ++ks) {
      asm volatile("ds_read_b64_tr_b16 %0,%1 offset:%c2" : "=&v"(lo[ks]) : "v"(vb), "i"(d0 * 4096 + ks * 1024) : "memory");
      asm volatile("ds_read_b64_tr_b16 %0,%1 offset:%c2" : "=&v"(hi[ks]) : "v"(vb), "i"(d0 * 4096 + ks * 1024 + 512) : "memory"); }
    asm volatile("s_waitcnt lgkmcnt(0)" ::: "memory"); SBAR();
    #define PK(k) (bf16x8){lo[k][0], lo[k][1], lo[k][2], lo[k][3], hi[k][0], hi[k][1], hi[k][2], hi[k][3]}
    o[d0] = __builtin_amdgcn_mfma_f32_32x32x16_bf16(pa0, PK(0), o[d0], 0, 0, 0);
    o[d0] = __builtin_amdgcn_mfma_f32_32x32x16_bf16(pa1, PK(1), o[d0], 0, 0, 0);
    o[d0] = __builtin_amdgcn_mfma_f32_32x32x16_bf16(pa2, PK(2), o[d0], 0, 0, 0);
    o[d0] = __builtin_amdgcn_mfma_f32_32x32x16_bf16(pa3, PK(3), o[d0], 0, 0, 0);
    #undef PK
  }
}
template <int KP, bool SWA, int THRL>
__device__ __forceinline__ void attn_unit(const bf16_t* Qu, const bf16_t* __restrict__ Kh, const bf16_t* __restrict__ Vh, bf16_t* Ou, const int NT, const float* biasg, const int refidx, const float sink0, const float sinkstep, char* shm) {
  int tid_ = threadIdx.x; asm volatile("" : "+v"(tid_));
  const int tid = tid_, lane = tid & 63, r32 = lane & 31, hi = lane >> 5; const int wid = __builtin_amdgcn_readfirstlane(tid >> 6);
  const bf16_t* Qw = Qu + (size_t)(wid * QBLK) * QP;
  const unsigned lds0 = (unsigned)(uintptr_t)shm;
  float* wsf = (float*)(shm + LDS_WS) + wid * 64;
  const bf16_t* ksrc = Kh + (long)lane * KP + wid * 8;
  const bf16_t* vsrc = Vh + (long)(16 * (wid & 3) + (lane >> 2)) * KP + (wid >> 2) * 32 + (lane & 3) * 8;
  const unsigned kdst = lds0 + LDS_K + wid * 1024, vdst = lds0 + LDS_V + wid * 1024;
  #define DMA_K(t, slot) glds16(ksrc + (long)(t) * KVBLK * KP, (unsigned)__builtin_amdgcn_readfirstlane(kdst + (slot)))
  #define DMA_V(t, slot) glds16(vsrc + (long)(t) * KVBLK * KP, (unsigned)__builtin_amdgcn_readfirstlane(vdst + (slot)))
  const int vb0 = (int)(lds0 + LDS_V) + ((lane >> 4) & 1) * 32 + (lane & 3) * 8 + (4 * hi + ((lane & 15) >> 2)) * 64;
  bf16x8 kf[8];
  const lds_cptr shm3 = (lds_cptr)shm; const lds_cptr kp0 = shm3 + LDS_K + hi * 1024 + r32 * 16; const lds_cptr vp0 = shm3 + LDS_V + ((lane >> 4) & 1) * 32 + (lane & 3) * 8 + (4 * hi + ((lane & 15) >> 2)) * 64;
  const lds_cptr bp0 = shm3 + LDS_BIAS + hi * 16;
  const int nb4 = NT * 16; f32x4 bv[3];
  #pragma unroll
  for (int k = 0; k < 3; ++k) { const int idx = tid + 512 * k; bv[k] = (idx < nb4) ? *((const GAS f32x4*)biasg + idx) : (f32x4){0.f, 0.f, 0.f, 0.f}; }
  DMA_K(0, 0); DMA_V(0, 0); DMA_K(1, SLOTB);
  bf16x8 qr[4];
  #pragma unroll
  for (int d0 = 0; d0 < 4; ++d0) qr[d0] = *reinterpret_cast<const bf16x8*>(&Qw[(long)r32 * QP + d0 * 16 + hi * 8]);
  float mhat = 0.f, nmh = 0.f, bref = 0.f, l_reg = 0.f; f32x16 o[2]; o[0] = f32x16{}; o[1] = f32x16{};
  const int qrel = wid * QBLK + r32;
  #define CMASK(P0, P1, t) do { int jb_ = (t) - (NT - 4); if (jb_ >= 0) cmask(P0, P1, jb_, qrel, hi); } while (0)
  #define WMASK(P0, P1, t) do { if constexpr (SWA) { if ((t) < 4) wmask(P0, P1, (t), qrel, hi); } } while (0)
  #define BIASC(C0, C1, t) do { const LAS f32x4* bp_ = (const LAS f32x4*)(bp0 + (t) * 256); \
    _Pragma("unroll") for (int g_ = 0; g_ < 4; ++g_) { const f32x4 x0_ = bp_[2 * g_], x1_ = bp_[8 + 2 * g_]; \
      _Pragma("unroll") for (int c_ = 0; c_ < 4; ++c_) { C0[4 * g_ + c_] = nmh - x0_[c_]; C1[4 * g_ + c_] = nmh - x1_[c_]; } } } while (0)
  bool resc = false;
  #define START(P0, P1) do { const float rm = rowmax(P0, P1); resc = false; \
    { const float dl = (rm > -1e29f) ? rm : 0.f; mhat = fadd_s(mhat, dl); \
      _Pragma("unroll") for (int r = 0; r < 16; ++r) { P0[r] = fsub_s(P0[r], dl); P1[r] = fsub_s(P1[r], dl); } \
      nmh = bref - mhat; } \
    _Pragma("unroll") for (int r = 0; r < 16; ++r) P0[r] = __builtin_amdgcn_exp2f(P0[r]); } while (0)
  #define RESC() do { if (resc) { asm volatile("s_waitcnt lgkmcnt(0)" ::: "memory"); \
      _Pragma("unroll") for (int d_ = 0; d_ < 2; ++d_) _Pragma("unroll") for (int r = 0; r < 16; ++r) o[d_][r] *= wsf[crow(r, hi)]; } } while (0)
  f32x16 pA0, pA1, pB0, pB1;
  int sl_prev = 0, sl_cur = 0, sl_next = SLOTB;
  #define ROT() do { sl_prev = sl_cur; sl_cur = sl_next; sl_next = (sl_next == (NSLOT - 1) * SLOTB) ? 0 : sl_next + SLOTB; } while (0)
  DMA_K(2, 2 * SLOTB);
  #pragma unroll
  for (int k = 0; k < 3; ++k) { const int idx = tid + 512 * k; if (idx < nb4) *((LAS f32x4*)(shm3 + LDS_BIAS) + idx) = bv[k]; }
  WAIT_BAR(3);
  bref = *(const LAS float*)(shm3 + LDS_BIAS + refidx * 4); nmh = bref;
  BIASC(pA0, pA1, 0);
  qkt(pA0, pA1, shm3 + LDS_K, qr, r32, hi); asm volatile("s_nop 15\n\ts_nop 7" : "+v"(pA0), "+v"(pA1)); CMASK(pA0, pA1, 0); WMASK(pA0, pA1, 0);
  START(pA0, pA1);
  _Pragma("unroll") for (int r = 0; r < 16; ++r) pA1[r] = __builtin_amdgcn_exp2f(pA1[r]);
  WAIT_BAR(0);
  DMA_K(3, 0); DMA_V(1, SLOTB);
  ROT();
  kload8(kf, kp0 + sl_cur);
  WAIT_BAR(2);
  s16x4 vlo[8], vhi[8]; u32x4 pw0, pw1, pw2, pw3;
  #define PKW(P, B) cvtpk_s(P[B], P[B + 1])
  #define PAF(k) __builtin_bit_cast(bf16x8, pw##k)
  #define VFR(i) (bf16x8){vlo[i][0], vlo[i][1], vlo[i][2], vlo[i][3], vhi[i][0], vhi[i][1], vhi[i][2], vhi[i][3]}
  #define PIN(x) asm volatile("" : "+v"(x))
  #define MX3(a, b, c) __builtin_fmaxf(__builtin_fmaxf((a), (b)), (c))
  #define GAPA(MF, A0, A1, A2, A3, W0, W1, PW) do { MF; sacc += A0; sacc += A1; sacc += A2; sacc += A3; PIN(sacc); W0; W1; PIN(PW); SBAR(); } while (0)
  #define EX(v) __builtin_amdgcn_exp2f(v)
  #define GAPB(MF, X, B) do { MF; X[B] = EX(X[B]); X[B + 1] = EX(X[B + 1]); X[B + 2] = EX(X[B + 2]); X[B + 3] = EX(X[B + 3]); PIN(X); SBAR(); } while (0)
  #define VRD(i) do { vlo[i] = vtr(vp_ + (((i) >> 2) * 4096 + ((i) & 3) * 1024)); vhi[i] = vtr(vp_ + (((i) >> 2) * 4096 + ((i) & 3) * 1024 + 512)); } while (0)
  #define KRD(G, j) do { if (G) { kload2(kf, kp0 + sl_next, j); SBAR(); } } while (0)
  #define MF32(a, b, c) __builtin_amdgcn_mfma_f32_32x32x16_bf16(a, b, c, 0, 0, 0)
  #define STEP(C0, C1, P0, P1, t, GK, GV, GL) do { SBAR(); \
    BIASC(C0, C1, t); SBAR(); \
    const lds_cptr vp_ = vp0 + sl_prev; \
    VRD(0); SBAR(); float sacc = (P0[0] + P0[1]); \
    GAPA(C0 = MF32(kf[0], qr[0], C0), P0[2], P0[3], P0[4], P0[5],     pw0[0] = PKW(P0, 0), pw0[1] = PKW(P0, 2), pw0); \
    VRD(4); SBAR(); GAPA(C1 = MF32(kf[1], qr[0], C1), P0[6], P0[7], P0[8], P0[9],     pw0[2] = PKW(P0, 4), pw0[3] = PKW(P0, 6), pw0); \
    VRD(1); SBAR(); GAPA(C0 = MF32(kf[2], qr[1], C0), P0[10], P0[11], P0[12], P0[13], pw1[0] = PKW(P0, 8), pw1[1] = PKW(P0, 10), pw1); \
    VRD(5); SBAR(); GAPA(C1 = MF32(kf[3], qr[1], C1), P0[14], P0[15], P1[0], P1[1],   pw1[2] = PKW(P0, 12), pw1[3] = PKW(P0, 14), pw1); \
    VRD(2); SBAR(); GAPA(C0 = MF32(kf[4], qr[2], C0), P1[2], P1[3], P1[4], P1[5],     pw2[0] = PKW(P1, 0), pw2[1] = PKW(P1, 2), pw2); \
    VRD(6); SBAR(); GAPA(C1 = MF32(kf[5], qr[2], C1), P1[6], P1[7], P1[8], P1[9],     pw2[2] = PKW(P1, 4), pw2[3] = PKW(P1, 6), pw2); \
    VRD(3); SBAR(); GAPA(C0 = MF32(kf[6], qr[3], C0), P1[10], P1[11], P1[12], P1[13], pw3[0] = PKW(P1, 8), pw3[1] = PKW(P1, 10), pw3); \
    VRD(7); SBAR(); GAPA(C1 = MF32(kf[7], qr[3], C1), P1[14], P1[15], 0.f, 0.f,       pw3[2] = PKW(P1, 12), pw3[3] = PKW(P1, 14), pw3); \
    l_reg += sacc; \
    if (GK) { DMA_K((t) + 3, sl_cur); } if (GV) { DMA_V((t) + 1, sl_next); } \
    CMASK(C0, C1, t); WMASK(C0, C1, t); \
    { float a = MX3(C0[0], C0[1], C1[0]), b = MX3(C0[2], C0[3], C1[1]); a = MX3(a, C1[2], C1[3]); \
      _Pragma("unroll") for (int r = 4; r < 16; r += 4) { a = MX3(a, C0[r], C0[r + 1]); b = MX3(b, C0[r + 2], C0[r + 3]); a = MX3(a, C1[r], C1[r + 1]); b = MX3(b, C1[r + 2], C1[r + 3]); } \
      float rm = __builtin_fmaxf(a, b); { auto rr = __builtin_amdgcn_permlane32_swap(__float_as_uint(rm), __float_as_uint(rm), false, false); rm = __builtin_fmaxf(__uint_as_float(rr[0]), __uint_as_float(rr[1])); } \
      resc = false; \
      if (__builtin_expect(__any(rm > (float)THRL), 0)) { const float dl = __builtin_fmaxf(rm, 0.f); mhat += dl; \
        _Pragma("unroll") for (int r = 0; r < 16; ++r) { C0[r] -= dl; C1[r] -= dl; } \
        nmh = bref - mhat; \
        const float f = __builtin_amdgcn_exp2f(-dl); l_reg *= f; if (hi == 0) wsf[r32] = f; resc = true; } } \
    SBAR(); \
    GAPB(o[0] = MF32(PAF(0), VFR(0), o[0]), C0, 0); \
    GAPB(o[1] = MF32(PAF(0), VFR(4), o[1]), C0, 4); \
    KRD(GL, 0); GAPB(o[0] = MF32(PAF(1), VFR(1), o[0]), C0, 8); \
    KRD(GL, 1); GAPB(o[1] = MF32(PAF(1), VFR(5), o[1]), C0, 12); \
    KRD(GL, 2); GAPB(o[0] = MF32(PAF(2), VFR(2), o[0]), C1, 0); \
    KRD(GL, 3); GAPB(o[1] = MF32(PAF(2), VFR(6), o[1]), C1, 4); \
    GAPB(o[0] = MF32(PAF(3), VFR(3), o[0]), C1, 8); \
    GAPB(o[1] = MF32(PAF(3), VFR(7), o[1]), C1, 12); \
    } while (0)
  int t = 1;
  #undef CMASK
  #define CMASK(P0, P1, t) do {} while (0)
  for (; t + 5 < NT; t += 2) {
    STEP(pB0, pB1, pA0, pA1, t, true, true, true);     WAIT_BAR(2); RESC(); ROT();
    STEP(pA0, pA1, pB0, pB1, t + 1, true, true, true); WAIT_BAR(2); RESC(); ROT();
  }
  #undef CMASK
  #define CMASK(P0, P1, t) do { int jb_ = (t) - (NT - 4); if (jb_ >= 0) cmask(P0, P1, jb_, qrel, hi); } while (0)
  #define ENDW(tt) do { if ((tt) + 3 < NT) { WAIT_BAR(2); } else if ((tt) + 2 < NT) { WAIT_BAR(1); } else { WAIT_BAR(0); } } while (0)
  for (; t + 1 < NT; t += 2) {
    STEP(pB0, pB1, pA0, pA1, t, (t + 3 < NT), (t + 1 < NT), (t + 1 < NT));         ENDW(t);     RESC(); ROT();
    STEP(pA0, pA1, pB0, pB1, t + 1, (t + 4 < NT), (t + 2 < NT), (t + 2 < NT));     ENDW(t + 1); RESC(); ROT();
  }
  STEP(pB0, pB1, pA0, pA1, NT - 1, false, false, false); RESC();
  { float sacc = pB0[0] + pB0[1]; _Pragma("unroll") for (int r = 2; r < 16; ++r) sacc += pB0[r]; _Pragma("unroll") for (int r = 0; r < 16; ++r) sacc += pB1[r]; l_reg += sacc;
    pw0 = (u32x4){PKW(pB0, 0), PKW(pB0, 2), PKW(pB0, 4), PKW(pB0, 6)}; pw1 = (u32x4){PKW(pB0, 8), PKW(pB0, 10), PKW(pB0, 12), PKW(pB0, 14)}; pw2 = (u32x4){PKW(pB1, 0), PKW(pB1, 2), PKW(pB1, 4), PKW(pB1, 6)}; pw3 = (u32x4){PKW(pB1, 8), PKW(pB1, 10), PKW(pB1, 12), PKW(pB1, 14)};
    SBAR(); pv(o, vb0 + sl_cur, PAF(0), PAF(1), PAF(2), PAF(3)); }
  #undef PKW
  #undef PAF
  #undef VFR
  #undef PIN
  #undef MX3
  #undef GAPA
  #undef GAPB
  #undef EX
  #undef VRD
  #undef KRD
  #undef STEP
  #undef ENDW
  #undef MF32
  { auto rr = __builtin_amdgcn_permlane32_swap(__float_as_uint(l_reg), __float_as_uint(l_reg), false, false); l_reg = __uint_as_float(rr[0]) + __uint_as_float(rr[1]); }
  if constexpr (SWA) l_reg += __builtin_amdgcn_exp2f(sink0 + sinkstep * (float)qrel - mhat);
  if (hi == 0) wsf[32 + r32] = l_reg; asm volatile("s_waitcnt lgkmcnt(0)" ::: "memory");
  float rli[16];
  #pragma unroll
  for (int r = 0; r < 16; ++r) rli[r] = __builtin_amdgcn_rcpf(wsf[32 + crow(r, hi)]);
  bf16_t* Ow = Ou + (size_t)(wid * QBLK) * QP;
  { bf16_t* stg = (bf16_t*)(shm + LDS_OST) + wid * 2048;
    #pragma unroll
    for (int r = 0; r < 16; ++r) { const int orow = crow(r, hi);
      #pragma unroll
      for (int d0 = 0; d0 < 2; ++d0) stg[orow * 64 + d0 * 32 + r32] = (bf16_t)f2bf(o[d0][r] * rli[r]); }
    asm volatile("s_waitcnt lgkmcnt(0)" ::: "memory");
    #pragma unroll
    for (int i = 0; i < 4; ++i) { const int row = i * 8 + (lane >> 3), ch = lane & 7; const u32x4 v = *(const u32x4*)(stg + row * 64 + ch * 8); *(u32x4*)(Ow + (long)row * QP + ch * 8) = v; } }
  asm volatile("s_waitcnt lgkmcnt(0)\n\ts_barrier" ::: "memory");
  #undef DMA_K
  #undef DMA_V
  #undef CMASK
  #undef WMASK
  #undef BIASC
  #undef START
  #undef RESC
  #undef ROT
}
#undef SBAR
#undef WAIT_BAR
}

#define XB_TMO      128
#define XB_XCNT(j)  (256  + 64 * (j))
#define XB_XSUB(j)  (1280 + 64 * (j))
#define XB_XGEN(j)  (2304 + 64 * (j))
#define XB_TOP      3328
#define XB_TOPGEN   3392
#define XCD_BAR_WORDS 3456
#define XB_SPIN_CAP (1u << 18)
__device__ __forceinline__ unsigned xb_ld(unsigned* p)              { return __hip_atomic_load(p, __ATOMIC_RELAXED, __HIP_MEMORY_SCOPE_AGENT); }
__device__ __forceinline__ unsigned xb_add(unsigned* p, unsigned v) { return __hip_atomic_fetch_add(p, v, __ATOMIC_RELAXED, __HIP_MEMORY_SCOPE_AGENT); }
__device__ __forceinline__ unsigned xb_xcc_id() { return (unsigned)__builtin_amdgcn_s_getreg((3 << 11) | 20) & 0xFu; }
#define XB_SPIN(cond, bar) do { unsigned _sp = 0; while (cond) { __builtin_amdgcn_s_sleep(1); \
    if ((++_sp & 255u) == 0u) { if (xb_ld(&(bar)[XB_TMO])) break; if (_sp > XB_SPIN_CAP) { atomicAdd(&(bar)[XB_TMO], 1u); break; } } } } while (0)
struct XcdBarrier { unsigned* bar; unsigned x; volatile LAS unsigned* st; };
__device__ __forceinline__ XcdBarrier xcd_barrier_post(unsigned* bar, volatile LAS unsigned* st) {
    XcdBarrier b; b.bar = bar; b.x = xb_xcc_id(); b.st = st;
    if (threadIdx.x == 0) (void)xb_add(&bar[XB_XCNT(b.x)], 1u);
    return b;
}
__device__ __forceinline__ void xcd_barrier_complete(unsigned* bar, unsigned x, unsigned& nloc, unsigned& nx) {
    const unsigned G = gridDim.x * gridDim.y * gridDim.z;
    unsigned sum, cnt, mine, sp = 0u;
    for (;;) {
        sum = 0u; cnt = 0u; mine = 0u;
#pragma unroll
        for (unsigned j = 0; j < 16; ++j) { const unsigned c = xb_ld(&bar[XB_XCNT(j)]); sum += c; cnt += (c > 0u) ? 1u : 0u; mine = (j == x) ? c : mine; }
        if (sum == G) break;
        __builtin_amdgcn_s_sleep(1);
        if ((++sp & 255u) == 0u) { if (xb_ld(&bar[XB_TMO])) break; if (sp > XB_SPIN_CAP) { atomicAdd(&bar[XB_TMO], 1u); break; } }
    }
    nloc = mine > 0u ? mine : 1u; nx = cnt > 0u ? cnt : 1u;
}
__device__ __forceinline__ void xcd_barrier(const XcdBarrier& b) {
    asm volatile("s_waitcnt vmcnt(0)" ::: "memory");
    __syncthreads();
    if (threadIdx.x == 0) {
        unsigned* bar = b.bar;
        __builtin_amdgcn_s_waitcnt(0);
        unsigned nloc = b.st[0], nx = b.st[1];
        if (nloc == 0u) { xcd_barrier_complete(bar, b.x, nloc, nx); b.st[0] = nloc; b.st[1] = nx; }
        const unsigned old = xb_add(&bar[XB_XSUB(b.x)], 1u);
        const unsigned gen = old / nloc;
        if (old + 1u == (gen + 1u) * nloc) {
            __builtin_amdgcn_fence(__ATOMIC_RELEASE, "agent");
            asm volatile("s_waitcnt vmcnt(0)" ::: "memory");
            const unsigned og = xb_add(&bar[XB_TOP], 1u);
            const unsigned tg = og / nx;
            if (og + 1u == (tg + 1u) * nx) xb_add(&bar[XB_TOPGEN], 1u);
            else XB_SPIN(xb_ld(&bar[XB_TOPGEN]) == tg, bar);
            __builtin_amdgcn_fence(__ATOMIC_ACQUIRE, "agent");
            xb_add(&bar[XB_XGEN(b.x)], 1u);
            asm volatile("s_waitcnt vmcnt(0)" ::: "memory");
        } else {
            XB_SPIN(xb_ld(&bar[XB_XGEN(b.x)]) == gen, bar);
            __builtin_amdgcn_fence(__ATOMIC_ACQUIRE, "agent");
            asm volatile("s_waitcnt vmcnt(0)" ::: "memory");
        }
    }
    __syncthreads();
}

struct Args { const float* in[20]; float* out; unsigned char* ws; };

struct Frame {
    LAS unsigned char* lds; volatile LAS unsigned* MISC; gu32* ctl;
    int tid, lane, wave, G, gw, NGW;
    unsigned char* ws;
};

struct TrItem { const float* W; int ldw, col0, k0; bf16_t* WT; int ldt, row0; };
__device__ __forceinline__ void tr_load(const TrItem& t, f32x4 (&v)[8], int lane) {
    const float* p = t.W + (size_t)(t.k0 + (lane >> 3)) * t.ldw + t.col0 + 4 * (lane & 7);
#pragma unroll
    for (int i = 0; i < 8; ++i) v[i] = __builtin_nontemporal_load((const GAS f32x4*)(p + (size_t)(8 * i) * t.ldw));
}
__device__ __forceinline__ void tr_store(const TrItem& t, const f32x4 (&v)[8], LAS float* scr, int lane) {
    LAS float* w = scr + (lane >> 3) * 33 + 4 * (lane & 7);
#pragma unroll
    for (int i = 0; i < 8; ++i) { w[(8 * i) * 33 + 0] = v[i].x; w[(8 * i) * 33 + 1] = v[i].y; w[(8 * i) * 33 + 2] = v[i].z; w[(8 * i) * 33 + 3] = v[i].w; }
    LDS_WAIT(); asm volatile("" ::: "memory");
    const int c = lane & 7;
#pragma unroll
    for (int j = 0; j < 4; ++j) { const int n = (lane >> 3) + 8 * j; const LAS float* s = scr + (8 * c) * 33 + n;
        u32x4 o; o.x = pk2(s[0 * 33], s[1 * 33]); o.y = pk2(s[2 * 33], s[3 * 33]); o.z = pk2(s[4 * 33], s[5 * 33]); o.w = pk2(s[6 * 33], s[7 * 33]);
        *(GAS u32x4*)(t.WT + (size_t)(t.row0 + n) * t.ldt + t.k0 + 8 * c) = o; }
    LDS_WAIT(); asm volatile("" ::: "memory");
}
__device__ __forceinline__ void tr8_item(const float* W, int ldw, int col0, int k0, unsigned char* WT, int ldt, int row0, LAS float* scr, int lane) {
    const float* p = W + (size_t)(k0 + (lane >> 3)) * ldw + col0 + 4 * (lane & 7);
    f32x4 v[16];
#pragma unroll
    for (int i = 0; i < 16; ++i) v[i] = __builtin_nontemporal_load((const GAS f32x4*)(p + (size_t)(8 * i) * ldw));
    LAS float* w = scr + (lane >> 3) * 33 + 4 * (lane & 7);
#pragma unroll
    for (int i = 0; i < 16; ++i) { w[(8 * i) * 33 + 0] = v[i].x; w[(8 * i) * 33 + 1] = v[i].y; w[(8 * i) * 33 + 2] = v[i].z; w[(8 * i) * 33 + 3] = v[i].w; }
    LDS_WAIT(); asm volatile("" ::: "memory");
    const int c = lane & 7;
#pragma unroll
    for (int j = 0; j < 4; ++j) { const int n = (lane >> 3) + 8 * j; const LAS float* s = scr + (16 * c) * 33 + n;
        u32x4 o; o.x = pk4_fp8(s[0 * 33] * SC_W, s[1 * 33] * SC_W, s[2 * 33] * SC_W, s[3 * 33] * SC_W); o.y = pk4_fp8(s[4 * 33] * SC_W, s[5 * 33] * SC_W, s[6 * 33] * SC_W, s[7 * 33] * SC_W);
        o.z = pk4_fp8(s[8 * 33] * SC_W, s[9 * 33] * SC_W, s[10 * 33] * SC_W, s[11 * 33] * SC_W); o.w = pk4_fp8(s[12 * 33] * SC_W, s[13 * 33] * SC_W, s[14 * 33] * SC_W, s[15 * 33] * SC_W);
        __builtin_nontemporal_store(o, (GAS u32x4*)(WT + (size_t)(row0 + n) * ldt + k0 + 16 * c)); }
    LDS_WAIT(); asm volatile("" ::: "memory");
}
constexpr int NCB_P1 = 64, NCB_P6 = 160, NCB_P2 = 1024 - NCB_P1 - NCB_P6;
__device__ __forceinline__ void conv_batch(int bat, const float* w_up_, const float* w_down_, unsigned char* wup8, unsigned char* wdn8, LAS unsigned char* ring) {
    constexpr int I_UP = NE * 8 * 64; const int t2 = fresh_tid(), lane = t2 & 63, wv = __builtin_amdgcn_readfirstlane(t2 >> 6);
    LAS float* scr = (LAS float*)(ring + wv * 17664);
#pragma unroll 1
    for (int k3 = 0; k3 < 3; ++k3) { const int it = bat * 24 + 8 * k3 + wv;
        if (it < I_UP) { const int e = it / (8 * 64), q = it % (8 * 64), kb = q / 64, nb = q % 64;
            const int lcol = ((nb >> 2) & 1) * 1024 + (nb >> 3) * 128 + (nb & 3) * 32;
            tr8_item(w_up_ + (size_t)e * DM * 2048, 2048, lcol, kb * 128, wup8 + (size_t)e * 2048 * DM, DM, nb * 32, scr, lane); }
        else { const int r = it - I_UP, e = r / (8 * 32), q = r % (8 * 32), kb = q / 32, nb = q % 32;
            tr8_item(w_down_ + (size_t)e * DM * DM, DM, nb * 32, kb * 128, wdn8 + (size_t)e * DM * DM, DM, nb * 32, scr, lane); } }
}
__device__ __forceinline__ int win_logical_col(int p) {
    const int tile = p >> 8, q = p & 255, bj = q >> 7, hh = (q >> 5) & 3;
    if (tile >= 9) { return (tile < 13 ? 2312 + (tile - 9) * 256 : 3336 + (tile - 13) * 256) + q; }
    const int hoff = hh * 64 + bj * 32;
    if (tile < 6) return tile * 256 + hoff;
    if (tile < 8) return 1544 + (tile - 6) * 256 + hoff;
    return 2056 + hoff;
}

struct SchedIn {
    int G, c, lo, hi; const char* A; const char* B;
    __device__ __forceinline__ bool next(int i, pg8::Unit& u) const {
        const int n = lo + i * G + c; int pm, pn;
        if (n >= hi) return false;
        if (n < 5) { pm = 64; pn = (n < 4) ? 2 + n : 8; }
        else { int wgid = n - 5; { const int q = 1088 / 8, xcd = wgid % 8, off = wgid / 8; wgid = xcd * q + off; }
            const int nig = 8 * 17, gid = wgid / nig, fm = gid * 8; pm = fm + ((wgid % nig) % 8); pn = (wgid % nig) / 8; }
        u.A = A + (size_t)pm * 256 * DM * 2; u.B = B + (size_t)pn * 256 * DM * 2; u.rows_lds = 0; u.i0 = pm; u.i1 = pn; u.i2 = 0; u.i3 = 0; return true;
    }
};
constexpr int IN_ALL = 1093, IN_P1 = 992;
struct SchedMix {
    int G, c; const char *OA, *OB, *WF, *WS;
    __device__ __forceinline__ bool next(int i, pg8::Unit& u) const {
        if (i >= 2 || c >= 256) return false;
        int wgid = c; { const int q = 256 / 8, xcd = wgid % 8, off = wgid / 8; wgid = xcd * q + off; }
        const int nig = 8 * 4, gid = wgid / nig, fm = gid * 8, pm = fm + ((wgid % nig) % 8), pn = (wgid % nig) / 8;
        u.A = (i == 0 ? OA : OB) + (size_t)pm * 256 * 512 * 2; u.B = (i == 0 ? WF : WS) + (size_t)pn * 256 * 512 * 2; u.rows_lds = 0; u.i0 = pm; u.i1 = pn; u.i2 = i; u.i3 = 0; return true;
    }
};
struct SchedOut {
    int G, c; const char *A, *B;
    __device__ __forceinline__ bool next(int i, pg8::Unit& u) const {
        if (i >= 1 || c >= 256) return false;
        int wgid = c; { const int q = 256 / 8, xcd = wgid % 8, off = wgid / 8; wgid = xcd * q + off; }
        const int nig = 8 * 4, gid = wgid / nig, fm = gid * 8, pm = fm + ((wgid % nig) % 8), pn = (wgid % nig) / 8;
        u.A = A + (size_t)pm * 256 * DM * 2; u.B = B + (size_t)pn * 256 * DM * 2; u.rows_lds = 0; u.i0 = pm; u.i1 = pn; u.i2 = 0; u.i3 = 0; return true;
    }
};
struct SchedMoe {
    int G, c, NPN; const LAS int* utab; const char* A; const char* B; int gather, pb;
    __device__ __forceinline__ bool next(int i, pg8::Unit& u) const {
        if (i >= 10) return false;
        const i32x4 t = *(const LAS i32x4*)(utab + 4 * i);
        if (__builtin_amdgcn_readfirstlane(t.w) == 0) return false;
        const int tau = __builtin_amdgcn_readfirstlane(t.x), e = __builtin_amdgcn_readfirstlane(t.y), pn = __builtin_amdgcn_readfirstlane(t.w) - 1;
        u.i0 = tau; u.i1 = pn; u.i2 = e; u.i3 = __builtin_amdgcn_readfirstlane(t.z);
        u.rows_lds = ROWS_OFF + i * 1024;
        u.A = gather ? A : A + (size_t)tau * 256 * pb;
        u.B = B + ((size_t)e * (NPN * 256) + (size_t)pn * 256) * pb;
        return true;
    }
};
__device__ __forceinline__ void moe_units(LAS int* utab, const LAS int* tab, int T, int NPN, int G, int c, int tid) {
    if (tid < 10) { const int x = c & 7, k = c >> 3, nx = (G - x + 7) >> 3, t0 = (T * x) >> 3, t1 = (T * (x + 1)) >> 3;
        const int L = t0 * NPN + tid * nx + k; i32x4 t = {0, 0, 0, 0};
        if (L < t1 * NPN) { const int tau = L / NPN; int e = 0;
            for (int j = 1; j < NE; ++j) e += (tab[32 + j] <= tau) ? 1 : 0;
            t = (i32x4){tau, e, tab[e] - (tau - tab[32 + e]) * 256, 1 + L % NPN}; }
        *(LAS i32x4*)(utab + 4 * tid) = t; }
    __syncthreads();
}

struct EpiIn {
    __device__ __forceinline__ bool keep_acc(const pg8::Unit&) const { return false; }
    static constexpr int NS = 16;
    __device__ __forceinline__ bool relax_ok(const pg8::Unit& u) const { return u.i0 < 64; }
    bf16_t *FQ, *FK, *FV, *SQ, *SK, *SV, *GA, *GB; const float *gfq, *gfk, *gsq, *gsk;
    __device__ __forceinline__ void operator()(const f32x4 (&acc)[2][2][4][2], const pg8::Unit& u, int wr, int wc, int fr, int fq) const {
        const int pm = u.i0, pn = u.i1;
        if (pn >= 9) {
            bf16_t* G = (pn < 13) ? GA : GB; const int colt = (pn < 13 ? pn - 9 : pn - 13) * 256 + wc * 32 + 8 * fq;
#pragma unroll
            for (int ai = 0; ai < 2; ++ai)
#pragma unroll
                for (int m = 0; m < 4; ++m) { const int row = pm * 256 + ai * 128 + wr * 64 + m * 16 + fr; bf16_t* rowp = G + (size_t)row * DM + colt;
#pragma unroll
                    for (int bj = 0; bj < 2; ++bj) { const f32x4 v0 = acc[ai][bj][m][0], v1 = acc[ai][bj][m][1]; u32x4 w;
                        w.x = pk2(sigmoidf_fast(v0[0]), sigmoidf_fast(v0[1])); w.y = pk2(sigmoidf_fast(v0[2]), sigmoidf_fast(v0[3]));
                        w.z = pk2(sigmoidf_fast(v1[0]), sigmoidf_fast(v1[1])); w.w = pk2(sigmoidf_fast(v1[2]), sigmoidf_fast(v1[3]));
                        *(GAS u32x4*)(rowp + bj * 128) = w; } }
            return;
        }
        bf16_t* dst; int pitch, hcol, metaslot; bool kv, donorm; const float* gain; float scale = 1.f;
        if (pn < 2)      { dst = FQ; pitch = 512; hcol = (4 * pn + wc) * 64;       kv = false; donorm = true;  gain = gfq; scale = C2; metaslot = 0; }
        else if (pn < 4) { dst = FK; pitch = 512; hcol = (4 * (pn - 2) + wc) * 64; kv = true;  donorm = true;  gain = gfk; metaslot = 48; }
        else if (pn < 6) { dst = FV; pitch = 512; hcol = (4 * (pn - 4) + wc) * 64; kv = true;  donorm = false; gain = gfk; metaslot = 48; }
        else if (pn < 8) { dst = SQ; pitch = 512; hcol = (4 * (pn - 6) + wc) * 64; kv = false; donorm = true;  gain = gsq; scale = C2; metaslot = 0; }
        else if (wc < 2) { dst = SK; pitch = 128; hcol = wc * 64;                  kv = true;  donorm = true;  gain = gsk; metaslot = 112; }
        else             { dst = SV; pitch = 128; hcol = (wc - 2) * 64;            kv = true;  donorm = false; gain = gsk; metaslot = 112; }
        f32x4 gv[2][2];
#pragma unroll
        for (int bj = 0; bj < 2; ++bj)
#pragma unroll
            for (int n = 0; n < 2; ++n) { const f32x4 gl = *(const GAS f32x4*)(gain + 32 * bj + 8 * fq + 4 * n); gv[bj][n] = gl * (donorm ? scale : 0.f) + (donorm ? 0.f : 1.f); }
#pragma unroll
        for (int ai = 0; ai < 2; ++ai)
#pragma unroll
            for (int m = 0; m < 4; ++m) {
                float ss = 0.f;
#pragma unroll
                for (int bj = 0; bj < 2; ++bj)
#pragma unroll
                    for (int n = 0; n < 2; ++n) { const f32x4 x = acc[ai][bj][m][n]; ss += (x[0] * x[0] + x[1] * x[1]) + (x[2] * x[2] + x[3] * x[3]); }
                ss += __shfl_xor(ss, 16); ss += __shfl_xor(ss, 32);
                const float r = donorm ? __builtin_amdgcn_rsqf(ss * (1.f / 64.f) + RMS_EPS) : 1.f;
                u32x4 w[2];
#pragma unroll
                for (int bj = 0; bj < 2; ++bj) { const f32x4 v0 = acc[ai][bj][m][0] * gv[bj][0] * r, v1 = acc[ai][bj][m][1] * gv[bj][1] * r;
                    w[bj].x = pk2(v0[0], v0[1]); w[bj].y = pk2(v0[2], v0[3]); w[bj].z = pk2(v1[0], v1[1]); w[bj].w = pk2(v1[2], v1[3]); }
                const int lrow = ai * 128 + wr * 64 + m * 16 + fr;
                if (pm < 64) { const int tok = pm * 256 + lrow; const int drow = kv ? (tok >> 12) * LP + 128 + (tok & 4095) : tok;
                    bf16_t* rowp = dst + (size_t)drow * pitch + hcol + 8 * fq;
                    *(GAS u32x4*)(rowp) = w[0]; *(GAS u32x4*)(rowp + 32) = w[1]; }
                else if (lrow < NMETA && kv) {
#pragma unroll
                    for (int b = 0; b < NB; ++b) { bf16_t* rowp = dst + (size_t)(b * LP + metaslot + lrow) * pitch + hcol + 8 * fq;
                        *(GAS u32x4*)(rowp) = w[0]; *(GAS u32x4*)(rowp + 32) = w[1]; } }
            }
    }
};
struct EpiMix {
    static constexpr int NS = 32;
    __device__ __forceinline__ bool relax_ok(const pg8::Unit& u) const { return true; }
    bf16_t* MIX; const bf16_t *GA, *GB;
    __device__ __forceinline__ bool keep_acc(const pg8::Unit& u) const { return u.i2 == 0; }
    __device__ __forceinline__ void operator()(f32x4 (&acc)[2][2][4][2], const pg8::Unit& u, int wr, int wc, int fr, int fq) const {
        const int pm = u.i0, pn = u.i1, part = u.i2;
#pragma unroll
        for (int ai = 0; ai < 2; ++ai) {
            u32x4 ga[4][2], gb[4][2];
#pragma unroll
            for (int m = 0; m < 4; ++m) { const size_t off = (size_t)(pm * 256 + ai * 128 + wr * 64 + m * 16 + fr) * DM + pn * 256 + wc * 32 + 8 * fq;
#pragma unroll
                for (int bj = 0; bj < 2; ++bj) { gb[m][bj] = *(const GAS u32x4*)(GB + off + bj * 128); ga[m][bj] = part ? gb[m][bj] : *(const GAS u32x4*)(GA + off + bj * 128); } }
#pragma unroll
            for (int m = 0; m < 4; ++m) { const size_t off = (size_t)(pm * 256 + ai * 128 + wr * 64 + m * 16 + fr) * DM + pn * 256 + wc * 32 + 8 * fq;
#pragma unroll
                for (int bj = 0; bj < 2; ++bj) { const u32x4 a_ = ga[m][bj], b_ = gb[m][bj]; f32x4& v0 = acc[ai][bj][m][0]; f32x4& v1 = acc[ai][bj][m][1];
                    if (part == 0) {
                        v0[0] *= bflo(a_.x) * __builtin_amdgcn_rcpf(bflo(b_.x)); v0[1] *= bfhi(a_.x) * __builtin_amdgcn_rcpf(bfhi(b_.x)); v0[2] *= bflo(a_.y) * __builtin_amdgcn_rcpf(bflo(b_.y)); v0[3] *= bfhi(a_.y) * __builtin_amdgcn_rcpf(bfhi(b_.y));
                        v1[0] *= bflo(a_.z) * __builtin_amdgcn_rcpf(bflo(b_.z)); v1[1] *= bfhi(a_.z) * __builtin_amdgcn_rcpf(bfhi(b_.z)); v1[2] *= bflo(a_.w) * __builtin_amdgcn_rcpf(bflo(b_.w)); v1[3] *= bfhi(a_.w) * __builtin_amdgcn_rcpf(bfhi(b_.w));
                    } else {
                        u32x4 w; w.x = pk2(v0[0] * bflo(b_.x), v0[1] * bfhi(b_.x)); w.y = pk2(v0[2] * bflo(b_.y), v0[3] * bfhi(b_.y)); w.z = pk2(v1[0] * bflo(b_.z), v1[1] * bfhi(b_.z)); w.w = pk2(v1[2] * bflo(b_.w), v1[3] * bfhi(b_.w));
                        *(GAS u32x4*)(MIX + off + bj * 128) = w; } } }
        }
    }
};
struct EpiOut {
    __device__ __forceinline__ bool keep_acc(const pg8::Unit&) const { return false; }
    static constexpr int NS = 48;
    __device__ __forceinline__ bool relax_ok(const pg8::Unit& u) const { return true; }
    bf16_t* H; const float* X;
    __device__ __forceinline__ void operator()(const f32x4 (&acc)[2][2][4][2], const pg8::Unit& u, int wr, int wc, int fr, int fq) const {
        const int pm = u.i0, pn = u.i1;
#pragma unroll
        for (int ai = 0; ai < 2; ++ai) {
            f32x4 xv[4][2][2];
#pragma unroll
            for (int m = 0; m < 4; ++m) { const size_t off = (size_t)(pm * 256 + ai * 128 + wr * 64 + m * 16 + fr) * DM + pn * 256 + wc * 32 + 8 * fq;
#pragma unroll
                for (int bj = 0; bj < 2; ++bj)
#pragma unroll
                    for (int n = 0; n < 2; ++n) xv[m][bj][n] = __builtin_nontemporal_load((const GAS f32x4*)(X + off + bj * 128 + 4 * n)); }
#pragma unroll
            for (int m = 0; m < 4; ++m) { const size_t off = (size_t)(pm * 256 + ai * 128 + wr * 64 + m * 16 + fr) * DM + pn * 256 + wc * 32 + 8 * fq;
#pragma unroll
                for (int bj = 0; bj < 2; ++bj) { const f32x4 v0 = xv[m][bj][0] + acc[ai][bj][m][0], v1 = xv[m][bj][1] + acc[ai][bj][m][1];
                    u32x4 w; w.x = pk2(v0[0], v0[1]); w.y = pk2(v0[2], v0[3]); w.z = pk2(v1[0], v1[1]); w.w = pk2(v1[2], v1[3]);
                    *(GAS u32x4*)(H + off + bj * 128) = w; } }
        }
    }
};
__device__ __forceinline__ float swiglu_act(float g, float u) {
    g = fminf(g, 7.f); u = fminf(fmaxf(u, -7.f), 7.f);
    return (u + 1.f) * (g * __builtin_amdgcn_rcpf(1.f + __builtin_amdgcn_exp2f(-1.702f * LOG2E * g)));
}
struct EpiUp {
    __device__ __forceinline__ bool keep_acc(const pg8::Unit&) const { return false; }
    static constexpr int NS = 12;
    __device__ __forceinline__ bool relax_ok(const pg8::Unit& u) const { return true; }
    unsigned char* ACT; const float* bup;
    __device__ __forceinline__ void operator()(const f32x4 (&acc)[2][2][4][2], const pg8::Unit& u, int wr, int wc, int fr, int fq) const {
        const int tau = u.i0, pn = u.i1, e = u.i2; const int gcol = pn * 128 + wc * 32 + 8 * fq; constexpr float us = 1.f / (SC_H * SC_W);
        f32x2 bg[4], bu[4];
#pragma unroll
        for (int n = 0; n < 2; ++n) { const f32x4 g4 = *(const GAS f32x4*)(bup + (size_t)e * 2048 + gcol + 4 * n), u4 = *(const GAS f32x4*)(bup + (size_t)e * 2048 + 1024 + gcol + 4 * n);
            bg[2 * n] = (f32x2){g4.x, g4.y}; bg[2 * n + 1] = (f32x2){g4.z, g4.w}; bu[2 * n] = (f32x2){u4.x, u4.y} * SC_A + SC_A; bu[2 * n + 1] = (f32x2){u4.z, u4.w} * SC_A + SC_A; }
#pragma unroll
        for (int ai = 0; ai < 2; ++ai)
#pragma unroll
            for (int m = 0; m < 4; ++m) { const size_t off = (size_t)(tau * 256 + ai * 128 + wr * 64 + m * 16 + fr) * DM + gcol;
                f32x2 o[4];
#pragma unroll
                for (int p = 0; p < 4; ++p) { const f32x4 ag = acc[ai][0][m][p >> 1], au = acc[ai][1][m][p >> 1];
                    f32x2 g = ((p & 1) ? (f32x2){ag.z, ag.w} : (f32x2){ag.x, ag.y}) * us + bg[p];
                    f32x2 uu = ((p & 1) ? (f32x2){au.z, au.w} : (f32x2){au.x, au.y}) * (us * SC_A) + bu[p];
                    g.x = fminf(g.x, 7.f); g.y = fminf(g.y, 7.f);
                    uu.x = __builtin_amdgcn_fmed3f(uu.x, -6.f * SC_A, 8.f * SC_A); uu.y = __builtin_amdgcn_fmed3f(uu.y, -6.f * SC_A, 8.f * SC_A);
                    const f32x2 t = g * (-1.702f * LOG2E); f32x2 d; d.x = __builtin_amdgcn_exp2f(t.x); d.y = __builtin_amdgcn_exp2f(t.y); d = d + 1.f;
                    f32x2 r; r.x = __builtin_amdgcn_rcpf(d.x); r.y = __builtin_amdgcn_rcpf(d.y);
                    o[p] = uu * (g * r); }
                u32x2 w; w.x = pk4_fp8(o[0].x, o[0].y, o[1].x, o[1].y); w.y = pk4_fp8(o[2].x, o[2].y, o[3].x, o[3].y);
                *(GAS u32x2*)(ACT + off) = w; }
    }
};
struct EpiDown {
    __device__ __forceinline__ bool keep_acc(const pg8::Unit&) const { return false; }
    static constexpr int NS = 20;
    __device__ __forceinline__ bool relax_ok(const pg8::Unit& u) const { return true; }
    unsigned char* YS; const float* bdn; const float* roww; const LAS int* tab;
    __device__ __forceinline__ void operator()(const f32x4 (&acc)[2][2][4][2], const pg8::Unit& u, int wr, int wc, int fr, int fq) const {
        const int tau = u.i0, pn = u.i1, e = u.i2, nvalid = u.i3; const int col = pn * 256 + wc * 32 + 8 * fq; const int lt0 = (tau - tab[32 + e]) * 256;
        f32x4 bv[2][2];
#pragma unroll
        for (int bj = 0; bj < 2; ++bj)
#pragma unroll
            for (int n = 0; n < 2; ++n) bv[bj][n] = *(const GAS f32x4*)(bdn + (size_t)e * DM + col + bj * 128 + 4 * n);
        float wv[8];
#pragma unroll
        for (int q = 0; q < 8; ++q) { const int lrow = (q >> 2) * 128 + wr * 64 + (q & 3) * 16 + fr; const int lr = lrow < nvalid ? lrow : 0; wv[q] = roww[(size_t)e * ECAP + lt0 + lr]; wv[q] = lrow < nvalid ? wv[q] : 0.f; }
#pragma unroll
        for (int ai = 0; ai < 2; ++ai)
#pragma unroll
            for (int m = 0; m < 4; ++m) { const int lrow = ai * 128 + wr * 64 + m * 16 + fr; const size_t off = (size_t)(tau * 256 + lrow) * DM + col;
                const float w = wv[ai * 4 + m];
#pragma unroll
                for (int bj = 0; bj < 2; ++bj) { constexpr float us = 1.f / (SC_A * SC_W); const float ws = w * SC_Y; const f32x4 lim = {448.f, 448.f, 448.f, 448.f};
                    const f32x4 v0 = __builtin_elementwise_min(__builtin_elementwise_max((acc[ai][bj][m][0] * us + bv[bj][0]) * ws, -lim), lim), v1 = __builtin_elementwise_min(__builtin_elementwise_max((acc[ai][bj][m][1] * us + bv[bj][1]) * ws, -lim), lim);
                    u32x2 o; o.x = pk4_fp8(v0[0], v0[1], v0[2], v0[3]); o.y = pk4_fp8(v1[0], v1[1], v1[2], v1[3]);
                    *(GAS u32x2*)(YS + off + bj * 128) = o; } }
    }
};
__device__ __forceinline__ void router_finish(float (&p)[32], float brt, int lane, int lt, LAS int* hist, LAS int* sel_e, LAS float* sel_g, LAS int* sel_r) {
#pragma unroll
    for (int e = 0; e < 16; ++e) { const bool up = (lane & 32) != 0; const float send = up ? p[e] : p[e + 16]; const float keep = up ? p[e + 16] : p[e]; p[e] = keep + __shfl_xor(send, 32); }
#pragma unroll
    for (int e = 0; e < 8; ++e) { const bool up = (lane & 16) != 0; const float send = up ? p[e] : p[e + 8]; const float keep = up ? p[e + 8] : p[e]; p[e] = keep + __shfl_xor(send, 16); }
#pragma unroll
    for (int e = 0; e < 4; ++e) { const bool up = (lane & 8) != 0; const float send = up ? p[e] : p[e + 4]; const float keep = up ? p[e + 4] : p[e]; p[e] = keep + __shfl_xor(send, 8); }
#pragma unroll
    for (int e = 0; e < 2; ++e) { const bool up = (lane & 4) != 0; const float send = up ? p[e] : p[e + 2]; const float keep = up ? p[e + 2] : p[e]; p[e] = keep + __shfl_xor(send, 4); }
    { const bool up = (lane & 2) != 0; const float send = up ? p[0] : p[1]; const float keep = up ? p[1] : p[0]; p[0] = keep + __shfl_xor(send, 2); }
    const float logit = p[0] + __shfl_xor(p[0], 1) + brt;
    const int my_e = lane >> 1;
    float cur = (lane & 1) ? -INFINITY : logit; int rank = 4; float vmax = 0.f;
#pragma unroll
    for (int r = 0; r < 4; ++r) { const float mx = wave_max(cur); const unsigned long long bal = __ballot(cur == mx); const int win = __ffsll((long long)bal) - 1;
        if (r == 0) vmax = mx;
        if (lane == win) { rank = r; cur = -INFINITY; } }
    const bool selected = rank < 4;
    const float ex = selected ? expf(logit - vmax) : 0.f;
    const float den = wave_sum(ex);
    if (selected) { const int lr = __hip_atomic_fetch_add(hist + my_e, 1, __ATOMIC_RELAXED, __HIP_MEMORY_SCOPE_WORKGROUP); sel_e[lt * 4 + rank] = my_e; sel_g[lt * 4 + rank] = ex / den; sel_r[lt * 4 + rank] = lr; }
}
__device__ __forceinline__ void naive_attn_row(const bf16_t* q, const bf16_t* Kb, const bf16_t* Vb, int pitch, const float* bias, int k0, int k1, bool has_sink, float sinkv, bf16_t* out, int lane) {
    u32x4 qw[8];
#pragma unroll
    for (int j = 0; j < 8; ++j) qw[j] = *(const GAS u32x4*)(q + 8 * j);
    float m = -1e20f, l = 0.f, o = 0.f;
    for (int kb = k0; kb <= k1; kb += 64) {
        const int k = kb + lane; const bool valid = k <= k1; const int kc = valid ? k : k1;
        const bf16_t* kr = Kb + (size_t)kc * pitch;
        float s = 0.f;
#pragma unroll
        for (int j = 0; j < 8; ++j) { const u32x4 kw = *(const GAS u32x4*)(kr + 8 * j);
            s += bflo(qw[j].x) * bflo(kw.x) + bfhi(qw[j].x) * bfhi(kw.x) + bflo(qw[j].y) * bflo(kw.y) + bfhi(qw[j].y) * bfhi(kw.y)
               + bflo(qw[j].z) * bflo(kw.z) + bfhi(qw[j].z) * bfhi(kw.z) + bflo(qw[j].w) * bflo(kw.w) + bfhi(qw[j].w) * bfhi(kw.w); }
        s = valid ? s - bias[kc] : -BIGB;
        const float mn = fmaxf(m, wave_max(s));
        const float alpha = __builtin_amdgcn_exp2f(m - mn);
        const float p = __builtin_amdgcn_exp2f(s - mn);
        l = l * alpha + wave_sum(p); o *= alpha; m = mn;
        const int nk = (k1 - kb + 1 < 64) ? (k1 - kb + 1) : 64;
        for (int j = 0; j < nk; ++j) { const float pj = __shfl(p, j); o += pj * bf2f(Vb[(size_t)(kb + j) * pitch + lane]); }
    }
    if (has_sink) l += __builtin_amdgcn_exp2f(sinkv - m);
    out[lane] = (bf16_t)f2bf(o / l);
}

#define in_x     (args.in[0])
#define meta     (args.in[1])
#define g1       (args.in[2])
#define w_in     (args.in[3])
#define b_forget (args.in[4])
#define gfq      (args.in[5])
#define gfk      (args.in[6])
#define gsq      (args.in[7])
#define gsk      (args.in[8])
#define sinks    (args.in[9])
#define w_fo     (args.in[10])
#define w_so     (args.in[11])
#define w_out    (args.in[12])
#define g2       (args.in[13])
#define w_router (args.in[14])
#define b_router (args.in[15])
#define w_up     (args.in[16])
#define b_up     (args.in[17])
#define w_down   (args.in[18])
#define b_down   (args.in[19])
#define WIN  ((bf16_t*)(ws + WS_WIN))
#define WFO  ((bf16_t*)(ws + WS_WFO))
#define WSO  ((bf16_t*)(ws + WS_WSO))
#define WOUT ((bf16_t*)(ws + WS_WOUT))
#define WUP  ((unsigned char*)(ws + WS_WUP))
#define WDN  ((unsigned char*)(ws + WS_WDN))
#define XN   ((bf16_t*)(ws + WS_XN))
#define LOGF ((float*)(ws + WS_LOGF))
#define FB   ((float*)(ws + WS_FB))
#define SBIAS ((float*)(ws + WS_SBIAS))
#define FQ   ((bf16_t*)(ws + WS_FQ))
#define FK   ((bf16_t*)(ws + WS_FK))
#define FV   ((bf16_t*)(ws + WS_FV))
#define SQ   ((bf16_t*)(ws + WS_SQ))
#define SK   ((bf16_t*)(ws + WS_SK))
#define SV   ((bf16_t*)(ws + WS_SV))
#define GA   ((bf16_t*)(ws + WS_GA))
#define GB   ((bf16_t*)(ws + WS_GB))
#define OA   ((bf16_t*)(ws + WS_OA))
#define OB   ((bf16_t*)(ws + WS_OB))
#define MIX  ((bf16_t*)(ws + WS_MIX))
#define HRES ((bf16_t*)(ws + WS_HRES))
#define H2   ((unsigned char*)(ws + WS_H2))
#define TOKDEST ((int*)(ws + WS_TOKDEST))
#define ROWTOK ((int*)(ws + WS_ROWTOK))
#define ROWW ((float*)(ws + WS_ROWW))
#define ACT  ((unsigned char*)(ws + WS_ACT))
#define YS   ((unsigned char*)(ws + WS_YS))
__global__ void __launch_bounds__(NWAVES * 64, 2) hybrid_fwd(Args args) {
    extern __shared__ __attribute__((aligned(16))) unsigned char lds_raw[];
    Frame F;
    F.lds = (LAS unsigned char*)lds_raw;
    F.MISC = (volatile LAS unsigned*)(F.lds + MISC_OFF);
    F.tid = threadIdx.x; F.lane = F.tid & 63; F.wave = __builtin_amdgcn_readfirstlane(F.tid >> 6);
    F.G = gridDim.x; F.gw = blockIdx.x * NWAVES + F.wave; F.NGW = F.G * NWAVES;
    F.ws = args.ws; F.ctl = (gu32*)(F.ws + WS_CTL);
    unsigned char* ws = args.ws;
    const int tid = F.tid, lane = F.lane, wave = F.wave, gw = F.gw, NGW = F.NGW, c = blockIdx.x, G = F.G;
    for (int u = tid; u < (LDS_BYTES - LDSCTL_OFF) / 4; u += NWAVES * 64) ((LAS unsigned*)(F.lds + LDSCTL_OFF))[u] = 0u;
    __syncthreads();
    XcdBarrier bar = xcd_barrier_post((unsigned*)(F.ctl + CW_BAR), F.MISC + 8);

    LAS int* tab = (LAS int*)(F.lds + TAB_OFF);

#ifndef NO_P0
    {
        LAS float* scr = (LAS float*)(F.lds + RING_OFF + wave * 17664);
        for (int i = gw; i < NB * 112; i += NGW) { const int b = i / 112, r = i % 112, slot = (r < 48) ? r : r + 16;
            GAS u32x4* pk = (GAS u32x4*)(FK + (size_t)(b * LP + slot) * 512) + lane; GAS u32x4* pv = (GAS u32x4*)(FV + (size_t)(b * LP + slot) * 512) + lane;
            *pk = (u32x4){0u, 0u, 0u, 0u}; *pv = (u32x4){0u, 0u, 0u, 0u};
            if (lane < 16) { *((GAS u32x4*)(SK + (size_t)(b * LP + r) * 128) + lane) = (u32x4){0u, 0u, 0u, 0u}; *((GAS u32x4*)(SV + (size_t)(b * LP + r) * 128) + lane) = (u32x4){0u, 0u, 0u, 0u}; } }
        for (int i = gw * 64 + lane; i < 8 * LP; i += NGW * 64) { const int h = i / LP, slot = i % LP; const float slope = exp2f(-(float)(h + 1));
            SBIAS[i] = (slot < 112) ? BIGB : -slope * (float)slot * LOG2E; }
        for (int m = NTOK + NMETA + gw; m < MROWS; m += NGW) { GAS u32x2* o8 = (GAS u32x2*)(XN + (size_t)m * DM) + lane;
#pragma unroll
            for (int j = 0; j < 4; ++j) o8[64 * j] = (u32x2){0u, 0u}; }
        {
            f32x4 wf[16][2];
#pragma unroll
            for (int q = 0; q < 16; ++q) { const float* wp = w_in + (size_t)(4 * lane + 256 * (q >> 2) + (q & 3)) * INW + 1536; wf[q][0] = *(const GAS f32x4*)wp; wf[q][1] = *(const GAS f32x4*)(wp + 4); }
            const int NRW = G * 8;
            for (int m0 = c * 8 + wave; m0 < NTOK + NMETA; m0 += 2 * NRW) {
                const int m1 = m0 + NRW; const bool has1 = m1 < NTOK + NMETA; const int mm[2] = {m0, has1 ? m1 : m0};
                f32x4 v[2][4]; float s2[2] = {0.f, 0.f};
#pragma unroll
                for (int r = 0; r < 2; ++r) { const float* xrow = (mm[r] < NTOK) ? in_x + (size_t)mm[r] * DM : meta + (size_t)(mm[r] - NTOK) * DM; const GAS f32x4* xr = (const GAS f32x4*)xrow + lane;
#pragma unroll
                    for (int j = 0; j < 4; ++j) v[r][j] = __builtin_nontemporal_load(xr + 64 * j); }
#pragma unroll
                for (int r = 0; r < 2; ++r)
#pragma unroll
                    for (int j = 0; j < 4; ++j) s2[r] += (v[r][j].x * v[r][j].x + v[r][j].y * v[r][j].y) + (v[r][j].z * v[r][j].z + v[r][j].w * v[r][j].w);
                s2[0] = wave_sum(s2[0]); s2[1] = wave_sum(s2[1]);
                float fl[2][8];
#pragma unroll
                for (int r = 0; r < 2; ++r) { const float rstd = 1.f / sqrtf(s2[r] * (1.f / DM) + RMS_EPS);
#pragma unroll
                    for (int h = 0; h < 8; ++h) fl[r][h] = 0.f;
                    GAS u32x2* o8 = (GAS u32x2*)(XN + (size_t)mm[r] * DM) + lane;
#pragma unroll
                    for (int j = 0; j < 4; ++j) { const f32x4 gg = *((const GAS f32x4*)g1 + lane + 64 * j); v[r][j] = v[r][j] * rstd * gg;
                        if (r == 0 || has1) o8[64 * j] = (u32x2){pk2(v[r][j].x, v[r][j].y), pk2(v[r][j].z, v[r][j].w)};
#pragma unroll
                        for (int cc = 0; cc < 4; ++cc) { const float hv = v[r][j][cc]; const f32x4 w0 = wf[4 * j + cc][0], w1 = wf[4 * j + cc][1];
                            fl[r][0] += hv * w0.x; fl[r][1] += hv * w0.y; fl[r][2] += hv * w0.z; fl[r][3] += hv * w0.w; fl[r][4] += hv * w1.x; fl[r][5] += hv * w1.y; fl[r][6] += hv * w1.z; fl[r][7] += hv * w1.w; } } }
#pragma unroll
                for (int r = 0; r < 2; ++r)
#pragma unroll
                    for (int h = 0; h < 8; ++h) fl[r][h] = wave_sum(fl[r][h]);
#pragma unroll
                for (int r = 0; r < 2; ++r)
                    if (lane < 8 && (r == 0 || has1)) { float z = 0.f;
#pragma unroll
                        for (int h = 0; h < 8; ++h) z = (lane == h) ? fl[r][h] : z;
                        z += b_forget[lane];
                        LOGF[(size_t)mm[r] * 8 + lane] = fminf(z, 0.f) - log1pf(expf(-fabsf(z))); }
            }
        }
        constexpr int I_IN = 16 * (NPHYS / 32), I_FO = 8 * 32, I_SO = 8 * 32, I_OUT = 16 * 32, NITEMS = I_IN + I_FO + I_SO + I_OUT;
        constexpr int I_UP = NE * 8 * 64, I_DN = NE * 8 * 32;
        const int fp8_per_wg = 0, ntask = (NITEMS / 2 + G - 1) / G;
        (void)I_UP; (void)I_DN;
        LAS int* qctr = (LAS int*)(F.lds + MISC_OFF + 132);
        for (;;) {
            int t = 0; if (lane == 0) t = __hip_atomic_fetch_add(qctr, 1, __ATOMIC_RELAXED, __HIP_MEMORY_SCOPE_WORKGROUP);
            t = __builtin_amdgcn_readfirstlane(t);
            if (t >= ntask) break;
            if (t < fp8_per_wg) { const int it = c * fp8_per_wg + t;
                if (it < I_UP) { const int e = it / (8 * 64), q = it % (8 * 64), kb = q / 64, nb = q % 64;
                    const int lcol = ((nb >> 2) & 1) * 1024 + (nb >> 3) * 128 + (nb & 3) * 32;
                    tr8_item(w_up + (size_t)e * DM * 2048, 2048, lcol, kb * 128, WUP + (size_t)e * 2048 * DM, DM, nb * 32, scr, lane); }
                else { const int r = it - I_UP, e = r / (8 * 32), q = r % (8 * 32), kb = q / 32, nb = q % 32;
                    tr8_item(w_down + (size_t)e * DM * DM, DM, nb * 32, kb * 128, WDN + (size_t)e * DM * DM, DM, nb * 32, scr, lane); }
            } else { const int it = 2 * (c + (t - fp8_per_wg) * G); if (it >= NITEMS) continue;
                TrItem ti[2];
#pragma unroll
                for (int q2 = 0; q2 < 2; ++q2) { int r = it + q2; TrItem tt;
                    if (r < I_IN) { const int kb = r / (NPHYS / 32), nb = r % (NPHYS / 32); tt = TrItem{w_in, INW, win_logical_col(nb * 32), kb * 64, WIN, DM, nb * 32}; }
                    else if ((r -= I_IN) < I_FO) { const int kb = r / 32, nb = r % 32; tt = TrItem{w_fo, DM, nb * 32, kb * 64, WFO, 512, nb * 32}; }
                    else if ((r -= I_FO) < I_SO) { const int kb = r / 32, nb = r % 32; tt = TrItem{w_so, DM, nb * 32, kb * 64, WSO, 512, nb * 32}; }
                    else { r -= I_SO; const int kb = r / 32, nb = r % 32; tt = TrItem{w_out, DM, nb * 32, kb * 64, WOUT, DM, nb * 32}; }
                    ti[q2] = tt; }
                f32x4 va[8], vb[8];
                tr_load(ti[0], va, lane); tr_load(ti[1], vb, lane);
                tr_store(ti[0], va, scr, lane); tr_store(ti[1], vb, scr, lane);
            }
        }
    }
#endif
    xcd_barrier(bar);

#ifndef NO_P1
    if (c >= G - 32) {
        const int tid = fresh_tid(), lane = tid & 63;
        const int bh_ = c - (G - 32), b = bh_ >> 3, h = bh_ & 7; LAS float* sc = (LAS float*)(F.lds + RING_OFF);
        float v[9]; float run = 0.f;
#pragma unroll
        for (int j = 0; j < 9; ++j) { const int t = 9 * tid + j; float lf = 0.f;
            if (t < NMETA + SEQ) lf = (t < NMETA) ? LOGF[(size_t)(NTOK + t) * 8 + h] : LOGF[(size_t)(b * SEQ + t - NMETA) * 8 + h];
            run += lf; v[j] = run; }
        sc[tid] = run; __syncthreads();
        if (wave == 0) { float carry = 0.f;
            for (int k = 0; k < 8; ++k) { float xv = sc[k * 64 + lane]; float inc = xv;
#pragma unroll
                for (int o = 1; o < 64; o <<= 1) { const float y = __shfl_up(inc, o); if (lane >= o) inc += y; }
                sc[k * 64 + lane] = carry + inc - xv; carry += __shfl(inc, 63); } }
        __syncthreads();
        const float base = sc[tid]; float* fb = FB + (size_t)(b * 8 + h) * LP;
#pragma unroll
        for (int j = 0; j < 9; ++j) { const int t = 9 * tid + j; if (t < NMETA + SEQ) { const int slot = (t < NMETA) ? 48 + t : 128 + (t - NMETA); fb[slot] = (base + v[j]) * LOG2E; } }
        if (tid < 112) fb[(tid < 48) ? tid : tid + 16] = BIGB;
        __syncthreads();
    }
    {
        SchedIn S{G, c, 0, IN_P1, (const char*)XN, (const char*)WIN};
        EpiIn E{FQ, FK, FV, SQ, SK, SV, GA, GB, gfq, gfk, gsq, gsk};
        pg8::gemm_phase<2 * DM, false, false, EpiIn, SchedIn>(F.lds + RING_OFF, S, E);
    }
    if (c >= G - 32) {
        conv_batch(2 * (c - (G - 32)), w_up, w_down, WUP, WDN, F.lds + RING_OFF);
        conv_batch(2 * (c - (G - 32)) + 1, w_up, w_down, WUP, WDN, F.lds + RING_OFF);
    }
#endif
    xcd_barrier(bar);

#ifndef NO_P2
#ifdef NAIVE_ATTN
    for (int T = gw; T < 2 * NTOK * 8; T += NGW) {
        const int which = T / (NTOK * 8), r = T % (NTOK * 8), h = r & 7, tokp = r >> 3;
        const int tok = tokp; const int b = tok >> 12, s = tok & 4095;
        if (which == 0) naive_attn_row(FQ + (size_t)tok * 512 + h * 64, FK + (size_t)b * LP * 512 + h * 64, FV + (size_t)b * LP * 512 + h * 64, 512, FB + (size_t)(b * 8 + h) * LP, 0, 128 + s, false, 0.f, OA + (size_t)tok * 512 + h * 64, lane);
        else { const int p = 128 + s; const float slope = exp2f(-(float)(h + 1));
            naive_attn_row(SQ + (size_t)tok * 512 + h * 64, SK + (size_t)b * LP * 128 + (h >> 2) * 64, SV + (size_t)b * LP * 128 + (h >> 2) * 64, 128, SBIAS + (size_t)h * LP, p - 127, p, true, (sinks[h] + slope * (float)p) * LOG2E, OB + (size_t)tok * 512 + h * 64, lane); }
    }
#else
    {
        {
            SchedIn S{G, c, IN_P1, IN_ALL, (const char*)XN, (const char*)WIN};
            EpiIn E{FQ, FK, FV, SQ, SK, SV, GA, GB, gfq, gfk, gsq, gsk};
            pg8::gemm_phase<2 * DM, false, false, EpiIn, SchedIn>(F.lds + RING_OFF, S, E);
        }
        char* shm = (char*)lds_raw + RING_OFF;
        const int tid = fresh_tid(), lane = tid & 63;
        float gq = fabsf(gfq[lane]), gk = fabsf(gfk[lane]); gq = wave_max(gq); gk = wave_max(gk);
        const float prune_thr = 2.f * (64.f * gq * gk * C2) + 40.f;
        volatile LAS int* qslot = (volatile LAS int*)(F.lds + MISC_OFF + 128);
        int unext = 0;
        if (tid == 0) unext = (int)__hip_atomic_fetch_add((unsigned*)(F.ctl + CW_QUEUE), 1u, __ATOMIC_RELAXED, __HIP_MEMORY_SCOPE_AGENT);
        for (;;) {
            if (tid == 0) *qslot = unext;
            __syncthreads();
            const int uq = __builtin_amdgcn_readfirstlane(*qslot);
            if (uq >= 1024 + NCB_P2) break;
            if (tid == 0) unext = (int)__hip_atomic_fetch_add((unsigned*)(F.ctl + CW_QUEUE), 1u, __ATOMIC_RELAXED, __HIP_MEMORY_SCOPE_AGENT);
            if (uq < 2 * NCB_P2 && (uq & 1)) { conv_batch(NCB_P1 + (uq >> 1), w_up, w_down, WUP, WDN, F.lds + RING_OFF); continue; }
            const int u = (uq < 2 * NCB_P2) ? (uq >> 1) : uq - NCB_P2;
            if (u < 512) {
                const int j = 15 - (u >> 5), b = (u >> 3) & 3, h = u & 7; int NT = 4 * j + 6;
                const float* fb = FB + (size_t)(b * 8 + h) * LP; const int refidx = 128 + 256 * j;
                int ts = 0;
                { const float bref = fb[refidx]; bool c0 = false, c1 = false; const int t0 = lane, t1 = lane + 64;
                  if (t0 >= 2 && t0 <= NT - 7) c0 = (fb[64 * t0 + 63] - bref) >= prune_thr;
                  if (t1 <= NT - 7) c1 = (fb[64 * t1 + 63] - bref) >= prune_thr;
                  const unsigned long long m0 = __ballot(c0), m1 = __ballot(c1);
                  if (m1) ts = 64 + (63 - __builtin_clzll(m1)) + 1; else if (m0) ts = (63 - __builtin_clzll(m0)) + 1;
                  ts &= ~1; ts = __builtin_amdgcn_readfirstlane(ts); }
                NT -= ts;
                attn::attn_unit<512, false, 8>(FQ + (size_t)(b * SEQ + 256 * j) * 512 + h * 64, FK + ((size_t)b * LP + 64 * ts) * 512 + h * 64, FV + ((size_t)b * LP + 64 * ts) * 512 + h * 64,
                                               OA + (size_t)(b * SEQ + 256 * j) * 512 + h * 64, NT, fb + 64 * ts, refidx - 64 * ts, 0.f, 0.f, shm);
            } else {
                const int w = u - 512, b = w >> 7, h = (w >> 4) & 7, j = w & 15, g = h >> 2; const float slope = exp2f(-(float)(h + 1));
                attn::attn_unit<128, true, 8>(SQ + (size_t)(b * SEQ + 256 * j) * 512 + h * 64, SK + ((size_t)b * LP + 256 * j) * 128 + g * 64, SV + ((size_t)b * LP + 256 * j) * 128 + g * 64,
                                              OB + (size_t)(b * SEQ + 256 * j) * 512 + h * 64, 6, SBIAS + (size_t)h * LP + 256 * j, 128, sinks[h] * LOG2E, slope * LOG2E, shm);
            }
        }
    }
#endif
#endif
    xcd_barrier(bar);

#ifndef NO_P3
    {
        SchedMix S{G, c, (const char*)OA, (const char*)OB, (const char*)WFO, (const char*)WSO};
        EpiMix E{MIX, GA, GB};
        pg8::gemm_phase<2 * 512, false, false, EpiMix, SchedMix>(F.lds + RING_OFF, S, E);
    }
#endif
    xcd_barrier(bar);

#ifndef NO_P4
    {
        SchedOut S{G, c, (const char*)MIX, (const char*)WOUT};
        EpiOut E{HRES, in_x};
        pg8::gemm_phase<2 * DM, false, false, EpiOut, SchedOut>(F.lds + RING_OFF, S, E);
    }
#endif
    xcd_barrier(bar);

#if defined(STOP_AFTER) && STOP_AFTER == 4
    for (int tok = gw; tok < NTOK; tok += NGW) {
#pragma unroll
        for (int j = 0; j < 4; ++j) *((GAS f32x4*)(args.out + (size_t)tok * DM) + lane + 64 * j) = *((const GAS f32x4*)(HRES + (size_t)tok * DM) + lane + 64 * j); }
    return;
#endif
#ifndef NO_P5
    {
        const int tid = fresh_tid(), lane = tid & 63;
        LAS float* WRT = (LAS float*)(F.lds + RING_OFF);
        { f32x4 wv_[16];
#pragma unroll
          for (int k = 0; k < 16; ++k) wv_[k] = *((const GAS f32x4*)w_router + tid + 512 * k);
#pragma unroll
          for (int k = 0; k < 16; ++k) { const int i4 = (tid + 512 * k) * 4, d = i4 >> 5, e0 = i4 & 31; WRT[(e0 + 0) * DM + d] = wv_[k].x; WRT[(e0 + 1) * DM + d] = wv_[k].y; WRT[(e0 + 2) * DM + d] = wv_[k].z; WRT[(e0 + 3) * DM + d] = wv_[k].w; } }
        LAS int* hist = tab + 96; LAS int* basee = tab + 128;
        LAS int* sel_e = (LAS int*)(F.lds + ROWS_OFF); LAS float* sel_g = (LAS float*)(F.lds + ROWS_OFF + 1024); LAS int* sel_r = (LAS int*)(F.lds + ROWS_OFF + 2048);
        if (tid < 32) hist[tid] = 0;
        __syncthreads();
        const int ntb = NTOK / G;
        constexpr int NTK = 4;
        for (int lt0 = wave * NTK; lt0 < ntb; lt0 += NWAVES * NTK) {
            f32x4 v[NTK][4]; float s2[NTK];
#pragma unroll
            for (int q = 0; q < NTK; ++q) { const GAS u32x2* hr = (const GAS u32x2*)(HRES + (size_t)(c * ntb + lt0 + q) * DM) + lane;
#pragma unroll
                for (int j = 0; j < 4; ++j) { const u32x2 w = hr[64 * j]; v[q][j] = (f32x4){bflo(w.x), bfhi(w.x), bflo(w.y), bfhi(w.y)}; } }
#pragma unroll
            for (int q = 0; q < NTK; ++q) { float a = 0.f;
#pragma unroll
                for (int j = 0; j < 4; ++j) a += (v[q][j].x * v[q][j].x + v[q][j].y * v[q][j].y) + (v[q][j].z * v[q][j].z + v[q][j].w * v[q][j].w);
                s2[q] = a; }
#pragma unroll
            for (int q = 0; q < NTK; ++q) s2[q] = wave_sum(s2[q]);
#pragma unroll
            for (int q = 0; q < NTK; ++q) { const float rstd = 1.f / sqrtf(s2[q] * (1.f / DM) + RMS_EPS);
                GAS unsigned* o8 = (GAS unsigned*)(H2 + (size_t)(c * ntb + lt0 + q) * DM) + lane;
#pragma unroll
                for (int j = 0; j < 4; ++j) { const f32x4 gg = *((const GAS f32x4*)g2 + lane + 64 * j); v[q][j] = v[q][j] * rstd * gg; const f32x4 qq = __builtin_elementwise_min(__builtin_elementwise_max(v[q][j] * SC_H, (f32x4){-448.f, -448.f, -448.f, -448.f}), (f32x4){448.f, 448.f, 448.f, 448.f}); o8[64 * j] = pk4_fp8(qq.x, qq.y, qq.z, qq.w); } }
            float pe[NTK][32];
            unsigned wb0 = (unsigned)(RING_OFF + 16 * lane), wb1 = wb0 + 65536u; asm volatile("" : "+v"(wb0), "+v"(wb1));
#pragma unroll
            for (int e = 0; e < 32; ++e) { float a[NTK]; _Pragma("unroll") for (int q = 0; q < NTK; ++q) a[q] = 0.f; const unsigned wb = (e < 16) ? wb0 : wb1;
#pragma unroll
                for (int j = 0; j < 4; ++j) { const f32x4 w = *(const LAS f32x4*)(F.lds + wb + ((e & 15) * 4096 + j * 1024));
#pragma unroll
                    for (int q = 0; q < NTK; ++q) a[q] += (v[q][j].x * w.x + v[q][j].y * w.y) + (v[q][j].z * w.z + v[q][j].w * w.w); }
#pragma unroll
                for (int q = 0; q < NTK; ++q) { asm volatile("" : "+v"(a[q])); pe[q][e] = a[q]; } }
            const int my_e = lane >> 1;
            const float brt = b_router[my_e];
            router_finish(pe[0], brt, lane, lt0 + 0, hist, sel_e, sel_g, sel_r);
            if constexpr (NTK > 1) router_finish(pe[1 % NTK], brt, lane, lt0 + 1, hist, sel_e, sel_g, sel_r);
            if constexpr (NTK > 2) { router_finish(pe[2 % NTK], brt, lane, lt0 + 2, hist, sel_e, sel_g, sel_r); router_finish(pe[3 % NTK], brt, lane, lt0 + 3, hist, sel_e, sel_g, sel_r); }
        }
        __syncthreads();
        if (tid < 32) basee[tid] = (int)atomicAdd((unsigned*)(F.ctl + CW_CNT + 64 * tid), (unsigned)hist[tid]);
        __syncthreads();
        for (int i = tid; i < ntb * 4; i += NWAVES * 64) { const int tok = c * ntb + (i >> 2); const int e = sel_e[i]; const int pos = basee[e] + sel_r[i];
            ROWTOK[(size_t)e * ECAP + pos] = tok; ROWW[(size_t)e * ECAP + pos] = sel_g[i]; TOKDEST[(size_t)tok * 4 + (i & 3)] = e * ECAP + pos; }
    }
#endif
    xcd_barrier(bar);

    int T_tiles;
    {
        const int tid = fresh_tid();
        if (tid < 32) tab[tid] = (int)__hip_atomic_load(F.ctl + CW_CNT + 64 * tid, RLX_AGENT);
        __syncthreads();
        if (tid < 64) { const int nt_ = (tid < NE) ? ((tab[tid] + 255) >> 8) : 0; int inc = nt_;
#pragma unroll
            for (int o = 1; o < 32; o <<= 1) { const int y = __shfl_up(inc, o); if ((tid & 63) >= o) inc += y; }
            if (tid < NE) tab[32 + tid] = inc - nt_; if (tid == NE - 1) tab[32 + NE] = inc; }
        __syncthreads();
        T_tiles = tab[32 + NE];
    }
#ifndef NO_P6
    {
        const int tid = fresh_tid();
        LAS int* utab = (LAS int*)(F.lds + UTAB_OFF); moe_units(utab, tab, T_tiles, 8, G, c, tid);
        SchedMoe S{G, c, 8, utab, (const char*)H2, (const char*)WUP, 1, DM};
        for (int i = 0; i < 10; ++i) { pg8::Unit u; if (!S.next(i, u)) break;
            if (tid < 256) { const int e = u.i2, lt0 = (u.i0 - tab[32 + e]) * 256; ((LAS int*)(F.lds + ROWS_OFF + i * 1024))[tid] = (tid < u.i3) ? ROWTOK[(size_t)e * ECAP + lt0 + tid] : 0; } }
        __syncthreads();
        EpiUp E{ACT, b_up};
        pg8::gemm_phase<DM, true, true, EpiUp, SchedMoe>(F.lds + RING_OFF, S, E);
        volatile LAS int* qslot = (volatile LAS int*)(F.lds + MISC_OFF + 128);
        for (;;) {
            if (fresh_tid() == 0) *qslot = (int)__hip_atomic_fetch_add((unsigned*)(F.ctl + CW_QUEUE + 64), 1u, __ATOMIC_RELAXED, __HIP_MEMORY_SCOPE_AGENT);
            __syncthreads();
            const int b6 = __builtin_amdgcn_readfirstlane(*qslot);
            __syncthreads();
            if (b6 >= NCB_P6) break;
            conv_batch(1024 - NCB_P6 + b6, w_up, w_down, WUP, WDN, F.lds + RING_OFF);
        }
    }
#endif
    xcd_barrier(bar);

#ifndef NO_P7
    {
        LAS int* utab = (LAS int*)(F.lds + UTAB_OFF); moe_units(utab, tab, T_tiles, 4, G, c, fresh_tid());
        SchedMoe S{G, c, 4, utab, (const char*)ACT, (const char*)WDN, 0, DM};
        EpiDown E{YS, b_down, ROWW, tab};
        pg8::gemm_phase<DM, true, false, EpiDown, SchedMoe>(F.lds + RING_OFF, S, E);
    }
#endif
    xcd_barrier(bar);

#ifndef NO_P8
    {
        const int lane = fresh_tid() & 63;
        const bool poison = (__hip_atomic_load(F.ctl + CW_BAR + XB_TMO, RLX_AGENT) != 0u) || (T_tiles > MAXTILES);
        for (int tok0 = gw; tok0 < NTOK; tok0 += 2 * NGW) {
            const int tk[2] = {tok0, tok0 + NGW};
            u32x4 y[2][4]; u32x4 hb[2][2];
#pragma unroll
            for (int q = 0; q < 2; ++q) {
#pragma unroll
                for (int k = 0; k < 4; ++k) { const int d = TOKDEST[(size_t)tk[q] * 4 + k]; const int e = d / ECAP, pos = d % ECAP; const int row = tab[32 + e] * 256 + pos;
                    y[q][k] = __builtin_nontemporal_load((const GAS u32x4*)(YS + (size_t)row * DM) + lane); }
#pragma unroll
                for (int j = 0; j < 2; ++j) hb[q][j] = *((const GAS u32x4*)(HRES + (size_t)tk[q] * DM) + 2 * lane + j); }
#pragma unroll
            for (int q = 0; q < 2; ++q)
#pragma unroll
                for (int j = 0; j < 4; ++j) { f32x2 lo = {0.f, 0.f}, hi = {0.f, 0.f};
#pragma unroll
                    for (int k = 0; k < 4; ++k) { const unsigned w = y[q][k][j]; lo += __builtin_amdgcn_cvt_pk_f32_fp8((int)w, false); hi += __builtin_amdgcn_cvt_pk_f32_fp8((int)w, true); }
                    const unsigned h0 = hb[q][j >> 1][2 * (j & 1)], h1 = hb[q][j >> 1][2 * (j & 1) + 1]; f32x4 a = {bflo(h0), bfhi(h0), bflo(h1), bfhi(h1)}; a.x += lo.x * (1.f / SC_Y); a.y += lo.y * (1.f / SC_Y); a.z += hi.x * (1.f / SC_Y); a.w += hi.y * (1.f / SC_Y);
                    if (poison) a = (f32x4){__builtin_nanf(""), __builtin_nanf(""), __builtin_nanf(""), __builtin_nanf("")};
                    __builtin_nontemporal_store(a, (GAS f32x4*)(args.out + (size_t)tk[q] * DM) + 4 * lane + j); }
        }
    }
#endif
}

extern "C" void kernel_launch(void* const* d_in, const int* in_sizes, int n_in, void* d_out, int out_size, void* d_ws, size_t ws_size, hipStream_t stream) {
    static int grid = 0;
    if (grid == 0) {
        if (n_in != 20 || in_sizes[0] != NTOK * DM || out_size != NTOK * DM || ws_size < WS_END) { fprintf(stderr, "kernel_launch: unexpected shapes / workspace (%d inputs, ws %zu)\n", n_in, ws_size); grid = -1; return; }
        int dev = 0, cus = 0, per_cu = 0;
        if (hipGetDevice(&dev) != hipSuccess || hipDeviceGetAttribute(&cus, hipDeviceAttributeMultiprocessorCount, dev) != hipSuccess) { grid = -1; return; }
        if (hipFuncSetAttribute((const void*)hybrid_fwd, hipFuncAttributeMaxDynamicSharedMemorySize, LDS_BYTES) != hipSuccess) { grid = -1; return; }
        if (hipOccupancyMaxActiveBlocksPerMultiprocessor(&per_cu, (const void*)hybrid_fwd, NWAVES * 64, LDS_BYTES) != hipSuccess || per_cu < 1) { fprintf(stderr, "kernel_launch: occupancy query says %d\n", per_cu); }
        (void)hipGetLastError();
        grid = cus;
        if (grid > 256) grid = 256;
    }
    if (grid < 0) return;
    if (hipMemsetAsync((char*)d_ws + WS_CTL, 0, CTL_ZERO_BYTES, stream) != hipSuccess) return;
    Args a{};
    for (int i = 0; i < 20; ++i) a.in[i] = (const float*)d_in[i];
    a.out = (float*)d_out; a.ws = (unsigned char*)d_ws;
    hipLaunchKernelGGL(hybrid_fwd, dim3(grid), dim3(NWAVES * 64), LDS_BYTES, stream, a);
}
```

```cpp
#include <hip/hip_runtime.h>
#include <cstdio>
#include <cstdint>

#define GAS __attribute__((address_space(1)))
#define LAS __attribute__((address_space(3)))
typedef unsigned short bf16_t;
typedef short bf16x8 __attribute__((ext_vector_type(8)));
typedef float f32x4 __attribute__((ext_vector_type(4)));
typedef float f32x2 __attribute__((ext_vector_type(2)));
typedef unsigned u32x4 __attribute__((ext_vector_type(4)));
typedef unsigned u32x2 __attribute__((ext_vector_type(2)));
typedef GAS unsigned gu32;
typedef int i32x4 __attribute__((ext_vector_type(4)));
typedef int i32x8 __attribute__((ext_vector_type(8)));
#define RLX_AGENT __ATOMIC_RELAXED, __HIP_MEMORY_SCOPE_AGENT
#define LDS_WAIT() asm volatile("s_waitcnt lgkmcnt(0)" ::: "memory")
#define VM_WAIT() asm volatile("s_waitcnt vmcnt(0)" ::: "memory")

constexpr int NB = 4, SEQ = 4096, DM = 1024, NTOK = NB * SEQ, NMETA = 16, MROWS = 16640, LP = 4224;
constexpr int HD = 64, NE = 32, INW = 4360, NPHYS = 4352;
constexpr int MAXTILES = 288, MAXROWS = MAXTILES * 256, ECAP = 16384;
constexpr float RMS_EPS = 1e-6f, LOG2E = 1.4426950408889634f, C2 = 0.125f * LOG2E, BIGB = 1e30f;
constexpr int NWAVES = 8;
constexpr float SC_W = 256.f, SC_H = 16.f, SC_A = 4.f, SC_Y = 64.f;

constexpr size_t MiB = 1u << 20;
constexpr size_t WS_CTL = 0, CTL_ZERO_BYTES = 1 * MiB;
constexpr size_t WS_WIN = 2 * MiB, WS_WFO = 11 * MiB, WS_WSO = 12 * MiB, WS_WOUT = 13 * MiB, WS_WUP = 16 * MiB, WS_WDN = 144 * MiB;
constexpr size_t WS_XN = 208 * MiB, WS_LOGF = 241 * MiB, WS_FB = 242 * MiB, WS_SBIAS = 243 * MiB;
constexpr size_t WS_FQ = 244 * MiB, WS_FK = 260 * MiB, WS_FV = 277 * MiB, WS_SQ = 294 * MiB, WS_SK = 310 * MiB, WS_SV = 315 * MiB;
constexpr size_t WS_GA = 320 * MiB, WS_GB = 352 * MiB, WS_OA = 384 * MiB, WS_OB = 400 * MiB, WS_MIX = 416 * MiB, WS_HRES = 448 * MiB, WS_H2 = 512 * MiB;
constexpr size_t WS_TOKDEST = 544 * MiB, WS_ROWTOK = 545 * MiB, WS_ROWW = 547 * MiB, WS_ACT = 550 * MiB, WS_YS = 694 * MiB, WS_END = 838 * MiB;
constexpr int CW_TMO = 0, CW_CODE = 1, CW_BAR = 4096, CW_CNT = 8192, CW_QUEUE = 12288;

constexpr int RING_OFF = 0, RING_BYTES = 131072;
constexpr int ROWS_OFF = RING_BYTES;
constexpr int ROWS_BYTES = 10 * 1024;
constexpr int LDSCTL_OFF = ROWS_OFF + ROWS_BYTES;
constexpr int MISC_OFF = LDSCTL_OFF;
constexpr int TAB_OFF = MISC_OFF + 256;
constexpr int UTAB_OFF = TAB_OFF + 1024;
constexpr int LDS_BYTES = 147456;
static_assert(UTAB_OFF + 256 <= LDS_BYTES, "LDS map");

__device__ __forceinline__ unsigned f2bf(float f) { unsigned u = __builtin_bit_cast(unsigned, f); return (u + 0x7fffu + ((u >> 16) & 1u)) >> 16; }
__device__ __forceinline__ unsigned pk2(float lo, float hi) { return f2bf(lo) | (f2bf(hi) << 16); }
__device__ __forceinline__ float bf2f(unsigned short b) { return __builtin_bit_cast(float, (unsigned)b << 16); }
__device__ __forceinline__ float bflo(unsigned w) { return __builtin_bit_cast(float, w << 16); }
__device__ __forceinline__ float bfhi(unsigned w) { return __builtin_bit_cast(float, w & 0xffff0000u); }
__device__ __forceinline__ float wave_sum(float v) {
#pragma unroll
    for (int o = 1; o < 64; o <<= 1) v += __shfl_xor(v, o);
    return v;
}
__device__ __forceinline__ float wave_max(float v) {
#pragma unroll
    for (int o = 1; o < 64; o <<= 1) v = fmaxf(v, __shfl_xor(v, o));
    return v;
}
__device__ __forceinline__ int fresh_tid() { int t = threadIdx.x; asm volatile("" : "+v"(t)); return t; }
__device__ __forceinline__ unsigned pk4_fp8(float a, float b, float c, float d) { int w = __builtin_amdgcn_cvt_pk_fp8_f32(a, b, 0, false); w = __builtin_amdgcn_cvt_pk_fp8_f32(c, d, w, true); return (unsigned)w; }
__device__ __forceinline__ float sigmoidf_fast(float x) { return __builtin_amdgcn_rcpf(1.f + __builtin_amdgcn_exp2f(-x * LOG2E)); }

namespace pg8 {
constexpr int BM = 256, BK = 64, HALF = 128, HTB = HALF * BK * 2, STAGE_BYTES = 8 * HTB;
__host__ __device__ __forceinline__ int lds_byte(int r, int c) { const int st = (r >> 4) * 2 + (c >> 5), rr = r & 15, cc = c & 31, ob = rr * 64 + cc * 2; return st * 1024 + (ob ^ (((ob >> 9) & 1) << 5)); }
__host__ __device__ __forceinline__ void stage_rc(int b, int& R, int& C) { const int st = b / 1024, sb = b % 1024, swz = sb ^ (((sb >> 9) & 1) << 5); R = (st >> 1) * 16 + swz / 64; C = (st & 1) * 32 + (swz % 64) / 2; }
__host__ __device__ __forceinline__ int perm32(int rho) { const int n = rho >> 4, i = rho & 15; return 8 * (i >> 2) + 4 * n + (i & 3); }

struct Unit { const char* A; const char* B; int rows_lds; int i0, i1, i2, i3; };

template <int PB, bool FP8, bool GATHER, class Epi, class Sched>
__device__ __forceinline__ void gemm_phase(LAS unsigned char* lds, const Sched& S, const Epi& E) {
    int tid_ = threadIdx.x; asm volatile("" : "+v"(tid_));
    const int tid = tid_, wid = __builtin_amdgcn_readfirstlane(tid >> 6), lane = tid & 63, wr = wid >> 2, wc = wid & 3, fr = lane & 15, fq = lane >> 4;
    constexpr int nt = PB / 128;
    int Rs[2], Cs[2]; unsigned voffB[2];
#pragma unroll
    for (int i = 0; i < 2; ++i) { int R, C; stage_rc(tid * 16 + i * 8192, R, C); Rs[i] = R; Cs[i] = C; const int Rb = (R & ~31) + perm32(R & 31); voffB[i] = (unsigned)(Rb * PB + C * 2); }
    constexpr size_t kstep = (size_t)(BK * 2);
    constexpr size_t hstep = (size_t)HALF * PB;
    const unsigned ldsw = (unsigned)wid * 1024u;
    const int aoff = lds_byte(wr * 64 + fr, fq * 8), boff = lds_byte(wc * 32 + fr, fq * 8);
#define PG8_SA(b, h) (((b) * 2 + (h)) * HTB)
#define PG8_SB(b, h) ((4 + (b) * 2 + (h)) * HTB)
#define PG8_STAGE(bufoff, gbase, v0, v1) do { \
        __builtin_amdgcn_global_load_lds((const unsigned*)((const char*)(gbase) + (v0)), (LAS unsigned*)(lds + (bufoff) + ldsw), 16, 0, 0); \
        __builtin_amdgcn_global_load_lds((const unsigned*)((const char*)(gbase) + (v1)), (LAS unsigned*)(lds + (bufoff) + ldsw + 8192), 16, 0, 0); } while (0)
#define PG8_STB(bufoff, gbase) PG8_STAGE(bufoff, gbase, voffB[0], voffB[1])
#define PG8_LDA(dst, b, h) do { _Pragma("unroll") for (int m = 0; m < 4; ++m) _Pragma("unroll") for (int k = 0; k < 2; ++k) dst[m][k] = *(const LAS bf16x8*)(lds + PG8_SA(b, h) + aoff + m * 2048 + k * 1024); } while (0)
#define PG8_LDB(dst, b, h) do { _Pragma("unroll") for (int n = 0; n < 2; ++n) _Pragma("unroll") for (int k = 0; k < 2; ++k) dst[n][k] = *(const LAS bf16x8*)(lds + PG8_SB(b, h) + boff + n * 2048 + k * 1024); } while (0)
#define PG8_CAT(x0, x1) __builtin_shufflevector(__builtin_bit_cast(i32x4, x0), __builtin_bit_cast(i32x4, x1), 0, 1, 2, 3, 4, 5, 6, 7)
#define PG8_MMA(ai, bj, At, Bt) do { __builtin_amdgcn_s_setprio(1); _Pragma("unroll") for (int m = 0; m < 4; ++m) _Pragma("unroll") for (int n = 0; n < 2; ++n) { \
        if constexpr (FP8) { asm volatile("v_mfma_scale_f32_16x16x128_f8f6f4 %0, %1, %2, %0, %3, %3 op_sel_hi:[0,0,0]" : "+v"(acc[ai][bj][m][n]) : "v"(PG8_CAT(Bt[n][0], Bt[n][1])), "v"(PG8_CAT(At[m][0], At[m][1])), "v"(scl)); }   \
        else { _Pragma("unroll") for (int k = 0; k < 2; ++k) acc[ai][bj][m][n] = __builtin_amdgcn_mfma_f32_16x16x32_bf16(Bt[n][k], At[m][k], acc[ai][bj][m][n], 0, 0, 0); } } \
        __builtin_amdgcn_s_setprio(0); } while (0)
#define PG8_WAIT_V(n) asm volatile("s_waitcnt vmcnt(" #n ")" ::: "memory")
#define PG8_WAIT_L(n) asm volatile("s_waitcnt lgkmcnt(" #n ")" ::: "memory")
#define PG8_BAR __builtin_amdgcn_s_barrier()
#define PG8_SCHED __builtin_amdgcn_sched_barrier(0)
#define PG8_SETA(v, u) do { _Pragma("unroll") for (int h = 0; h < 2; ++h) _Pragma("unroll") for (int i = 0; i < 2; ++i) { \
        if constexpr (GATHER) { const int tk = *(const LAS int*)(lds + (u).rows_lds + 4 * (h * HALF + Rs[i])); v[h][i] = (unsigned)(tk * PB + Cs[i] * 2); } \
        else v[h][i] = (unsigned)((h * HALF + Rs[i]) * PB + Cs[i] * 2); } } while (0)
    Unit cur, nxt; int ui = 0; bool relax_prev = false;
    if (!S.next(0, cur)) return;
    int scl = 0x7F7F7F7F; asm volatile("" : "+v"(scl));
    f32x4 acc[2][2][4][2];
#pragma unroll
    for (int a = 0; a < 2; ++a)
#pragma unroll
        for (int b = 0; b < 2; ++b)
#pragma unroll
            for (int m = 0; m < 4; ++m)
#pragma unroll
                for (int n = 0; n < 2; ++n) acc[a][b][m][n] = (f32x4){0.f, 0.f, 0.f, 0.f};
    bf16x8 At[4][2], B0[2][2], B1[2][2];
    unsigned vAc[2][2], vAn[2][2];
    PG8_SETA(vAc, cur);
    if constexpr (GATHER) { PG8_WAIT_L(0); }
    const char* cA = cur.A; const char* cB = cur.B;
    PG8_STB(PG8_SB(0, 0), cB); PG8_STB(PG8_SB(0, 1), cB + hstep); PG8_STAGE(PG8_SA(0, 0), cA, vAc[0][0], vAc[0][1]); PG8_STAGE(PG8_SA(0, 1), cA, vAc[1][0], vAc[1][1]);
    if (wr == 1) PG8_BAR;
    PG8_WAIT_V(2); PG8_BAR;
    PG8_STB(PG8_SB(1, 0), cB + kstep); PG8_STAGE(PG8_SA(1, 0), cA + kstep, vAc[0][0], vAc[0][1]); PG8_STB(PG8_SB(1, 1), cB + hstep + kstep);
    PG8_WAIT_V(6); PG8_BAR;
    for (;;) {
        const bool has_next = S.next(ui + 1, nxt);
        const char* nA = has_next ? nxt.A : cA; const char* nB = has_next ? nxt.B : cB;
        if constexpr (GATHER) { if (has_next) { PG8_SETA(vAn, nxt); } else {
#pragma unroll
            for (int h = 0; h < 2; ++h)
#pragma unroll
                for (int i = 0; i < 2; ++i) vAn[h][i] = vAc[h][i]; } }
#pragma unroll 1
        for (int t = 0; t < nt; t += 2) {
            const bool last = (t == nt - 2);
            const bool first = (t == 0) && (ui > 0), relax = first && relax_prev;
            const char* a1 = cA + (size_t)(t + 1) * kstep;
            const char* a2 = last ? nA : cA + (size_t)(t + 2) * kstep; const char* b2 = last ? nB : cB + (size_t)(t + 2) * kstep;
            const char* a3 = a2 + kstep; const char* b3 = b2 + kstep;
            unsigned w00, w01, w10, w11;
            if constexpr (GATHER) { w00 = last ? vAn[0][0] : vAc[0][0]; w01 = last ? vAn[0][1] : vAc[0][1]; w10 = last ? vAn[1][0] : vAc[1][0]; w11 = last ? vAn[1][1] : vAc[1][1]; }
            else { w00 = vAc[0][0]; w01 = vAc[0][1]; w10 = vAc[1][0]; w11 = vAc[1][1]; }
#define PG8_WAIT_VR() do { if (relax) asm volatile("s_waitcnt vmcnt(%0)" :: "n"(8 + Epi::NS) : "memory"); else PG8_WAIT_V(8); } while (0)
            PG8_LDB(B0, 0, 0); PG8_LDB(B1, 0, 1); PG8_SCHED; PG8_LDA(At, 0, 0); if (!first) PG8_STAGE(PG8_SA(1, 1), a1, vAc[1][0], vAc[1][1]);
            PG8_WAIT_VR(); PG8_WAIT_L(0); PG8_BAR; PG8_MMA(0, 0, At, B0); PG8_MMA(0, 1, At, B1); PG8_BAR; PG8_SCHED;
            PG8_LDA(At, 0, 1); PG8_STB(PG8_SB(0, 0), b2); PG8_STB(PG8_SB(0, 1), b2 + hstep); PG8_STAGE(PG8_SA(0, 0), a2, w00, w01);
            PG8_WAIT_VR(); PG8_WAIT_L(0); PG8_BAR; PG8_MMA(1, 0, At, B0); PG8_MMA(1, 1, At, B1); PG8_BAR; PG8_SCHED;
            PG8_LDB(B0, 1, 0); PG8_LDB(B1, 1, 1); PG8_SCHED; PG8_LDA(At, 1, 0); PG8_STAGE(PG8_SA(0, 1), a2, w10, w11);
            PG8_WAIT_VR(); PG8_WAIT_L(0); PG8_BAR; PG8_MMA(0, 0, At, B0); PG8_MMA(0, 1, At, B1); PG8_BAR; PG8_SCHED;
            PG8_LDA(At, 1, 1); PG8_STB(PG8_SB(1, 0), b3); PG8_STB(PG8_SB(1, 1), b3 + hstep); PG8_STAGE(PG8_SA(1, 0), a3, w00, w01);
            PG8_WAIT_V(8); PG8_WAIT_L(0); PG8_BAR; PG8_MMA(1, 0, At, B0); PG8_MMA(1, 1, At, B1); PG8_BAR; PG8_SCHED;
#undef PG8_WAIT_VR
        }
        if (has_next) { if constexpr (GATHER) PG8_STAGE(PG8_SA(1, 1), nA + kstep, vAn[1][0], vAn[1][1]); else PG8_STAGE(PG8_SA(1, 1), nA + kstep, vAc[1][0], vAc[1][1]); }
        asm volatile("" ::: "memory");
        relax_prev = E.relax_ok(cur);
        if (wr == 0) PG8_BAR;
        if constexpr (FP8) asm volatile("s_nop 15\n\ts_nop 7" ::: "memory");
        E(acc, cur, wr, wc, fr, fq);
        if (!has_next) break;
        if (!E.keep_acc(cur)) {
#pragma unroll
        for (int a = 0; a < 2; ++a)
#pragma unroll
            for (int b = 0; b < 2; ++b)
#pragma unroll
                for (int m = 0; m < 4; ++m)
#pragma unroll
                    for (int n = 0; n < 2; ++n) acc[a][b][m][n] = (f32x4){0.f, 0.f, 0.f, 0.f};
        }
        cur = nxt; cA = nA; cB = nB; ++ui;
        if constexpr (GATHER) {
#pragma unroll
            for (int h = 0; h < 2; ++h)
#pragma unroll
                for (int i = 0; i < 2; ++i) vAc[h][i] = vAn[h][i]; }
        if (wr == 1) PG8_BAR;
    }
    PG8_WAIT_V(0);
    PG8_BAR;
#undef PG8_SA
#undef PG8_SB
#undef PG8_STAGE
#undef PG8_STB
#undef PG8_LDA
#undef PG8_LDB
#undef PG8_MMA
#undef PG8_CAT
#undef PG8_WAIT_V
#undef PG8_WAIT_L
#undef PG8_BAR
#undef PG8_SCHED
#undef PG8_SETA
}
}

namespace attn {
using s16x4 = __attribute__((ext_vector_type(4))) short;
using f32x16 = __attribute__((ext_vector_type(16))) float;
constexpr int NW = 8, QBLK = 32, QB = QBLK * NW, KVBLK = 64, QP = 512;
__device__ __forceinline__ int crow(int r, int hi) { return (r & 3) + 8 * (r >> 2) + 4 * hi; }
#define SBAR() __builtin_amdgcn_sched_barrier(0)
__device__ __forceinline__ void cmask(f32x16& p0, f32x16& p1, int jb, int qrel, int hi) {
  const float NEG = -INFINITY; int kb = 64 * jb + 4 * hi;
  #pragma unroll
  for (int r = 0; r < 16; ++r) { int kv = kb + (r & 3) + 8 * (r >> 2); if (kv > qrel) p0[r] = NEG; if (kv + 32 > qrel) p1[r] = NEG; }
}
__device__ __forceinline__ void wmask(f32x16& p0, f32x16& p1, int t, int qrel, int hi) {
  const float NEG = -INFINITY; int kb = 64 * t + 4 * hi;
  #pragma unroll
  for (int r = 0; r < 16; ++r) { int kv = kb + (r & 3) + 8 * (r >> 2); if (kv <= qrel) p0[r] = NEG; if (kv + 32 <= qrel) p1[r] = NEG; }
}
constexpr int NSLOT = 3, SLOTB = 8192;
constexpr int LDS_K = 0, LDS_V = NSLOT * SLOTB, LDS_WS = 2 * NSLOT * SLOTB, LDS_OST = LDS_WS + NW * 64 * 4, LDS_BIAS = LDS_OST + NW * 4096, LDS_BYTES = LDS_BIAS + LP * 4;
__device__ __forceinline__ void glds16(const void* gsrc, unsigned lds_dst) { unsigned keep;
  asm volatile("s_mov_b32 %0, m0\n\ts_mov_b32 m0, %2\n\ts_nop 0\n\tglobal_load_lds_dwordx4 %1, off\n\ts_mov_b32 m0, %0" : "=&s"(keep) : "v"(gsrc), "s"(lds_dst) : "memory"); }
__device__ __forceinline__ float max3f(float a, float b, float c) { float r; asm("v_max3_f32 %0, %1, %2, %3" : "=v"(r) : "v"(a), "v"(b), "v"(c)); return r; }
__device__ __forceinline__ float max2f(float a, float b) { float r; asm("v_max_f32_e32 %0, %1, %2" : "=v"(r) : "v"(a), "v"(b)); return r; }
__device__ __forceinline__ float fadd_s(float a, float b) { float r; asm("v_add_f32_e32 %0, %1, %2" : "=v"(r) : "v"(a), "v"(b)); return r; }
__device__ __forceinline__ float fsub_s(float a, float b) { float r; asm("v_sub_f32_e32 %0, %1, %2" : "=v"(r) : "v"(a), "v"(b)); return r; }
typedef float f32x2_t __attribute__((ext_vector_type(2))); typedef __bf16 bf16x2_t __attribute__((ext_vector_type(2)));
__device__ __forceinline__ unsigned cvtpk_s(float lo, float hi) { f32x2_t v = {lo, hi}; bf16x2_t b = __builtin_convertvector(v, bf16x2_t); return __builtin_bit_cast(unsigned, b); }
#define WAIT_BAR(N) asm volatile("s_waitcnt vmcnt(" #N ") lgkmcnt(0)\n\ts_barrier" ::: "memory")
typedef __attribute__((address_space(3))) const char* lds_cptr;
typedef short v4i16_t __attribute__((ext_vector_type(4)));
__device__ __forceinline__ void qkt(f32x16& p0, f32x16& p1, lds_cptr Kslot, const bf16x8* qr, int r32, int hi) {
  lds_cptr kb = Kslot + hi * 1024 + r32 * 16;
  #pragma unroll
  for (int d0 = 0; d0 < 4; ++d0) {
    const bf16x8 b0 = *(const LAS bf16x8*)(kb + d0 * 2048);
    const bf16x8 b1 = *(const LAS bf16x8*)(kb + d0 * 2048 + 512);
    p0 = __builtin_amdgcn_mfma_f32_32x32x16_bf16(b0, qr[d0], p0, 0, 0, 0); p1 = __builtin_amdgcn_mfma_f32_32x32x16_bf16(b1, qr[d0], p1, 0, 0, 0); }
}
__device__ __forceinline__ void kload8(bf16x8* kf, lds_cptr kp) {
  kf[0] = *(const LAS bf16x8*)(kp);        kf[1] = *(const LAS bf16x8*)(kp + 512);
  kf[2] = *(const LAS bf16x8*)(kp + 2048); kf[3] = *(const LAS bf16x8*)(kp + 2560);
  kf[4] = *(const LAS bf16x8*)(kp + 4096); kf[5] = *(const LAS bf16x8*)(kp + 4608);
  kf[6] = *(const LAS bf16x8*)(kp + 6144); kf[7] = *(const LAS bf16x8*)(kp + 6656);
}
__device__ __forceinline__ void kload2(bf16x8* kf, lds_cptr kp, int j) { kf[2 * j] = *(const LAS bf16x8*)(kp + j * 2048); kf[2 * j + 1] = *(const LAS bf16x8*)(kp + j * 2048 + 512); }
__device__ __forceinline__ s16x4 vtr(lds_cptr p) { return __builtin_bit_cast(s16x4, __builtin_amdgcn_ds_read_tr16_b64_v4i16((LAS v4i16_t*)p)); }
__device__ __forceinline__ float rowmax(const f32x16& p0, const f32x16& p1) {
  float a = max3f(p0[0], p0[1], p1[0]), b = max3f(p0[2], p0[3], p1[1]); a = max3f(a, p1[2], p1[3]);
  #pragma unroll
  for (int r = 4; r < 16; r += 4) { a = max3f(a, p0[r], p0[r + 1]); b = max3f(b, p0[r + 2], p0[r + 3]); a = max3f(a, p1[r], p1[r + 1]); b = max3f(b, p1[r + 2], p1[r + 3]); }
  const float m = max2f(a, b);
  auto rr = __builtin_amdgcn_permlane32_swap(__float_as_uint(m), __float_as_uint(m), false, false);
  return max2f(__uint_as_float(rr[0]), __uint_as_float(rr[1]));
}
__device__ __forceinline__ void pv(f32x16* o, int vb, bf16x8 pa0, bf16x8 pa1, bf16x8 pa2, bf16x8 pa3) {
  #pragma unroll
  for (int d0 = 0; d0 < 2; ++d0) { s16x4 lo[4], hi[4];
    #pragma unroll
    for (int ks = 0; ks < 4; ++ks) {
      asm volatile("ds_read_b64_tr_b16 %0,%1 offset:%c2" : "=&v"(lo[ks]) : "v"(vb), "i"(d0 * 4096 + ks * 1024) : "memory");
      asm volatile("ds_read_b64_tr_b16 %0,%1 offset:%c2" : "=&v"(hi[ks]) : "v"(vb), "i"(d0 * 4096 + ks * 1024 + 512) : "memory"); }
    asm volatile("s_waitcnt lgkmcnt(0)" ::: "memory"); SBAR();
    #define PK(k) (bf16x8){lo[k][0], lo[k][1], lo[k][2], lo[k][3], hi[k][0], hi[k][1], hi[k][2], hi[k][3]}
    o[d0] = __builtin_amdgcn_mfma_f32_32x32x16_bf16(pa0, PK(0), o[d0], 0, 0, 0);
    o[d0] = __builtin_amdgcn_mfma_f32_32x32x16_bf16(pa1, PK(1), o[d0], 0, 0, 0);
    o[d0] = __builtin_amdgcn_mfma_f32_32x32x16_bf16(pa2, PK(2), o[d0], 0, 0, 0);
    o[d0] = __builtin_amdgcn_mfma_f32_32x32x16_bf16(pa3, PK(3), o[d0], 0, 0, 0);
    #undef PK
  }
}
template <int KP, bool SWA, int THRL>
__device__ __forceinline__ void attn_unit(const bf16_t* Qu, const bf16_t* __restrict__ Kh, const bf16_t* __restrict__ Vh, bf16_t* Ou, const int NT, const float* biasg, const int refidx, const float sink0, const float sinkstep, char* shm) {
  int tid_ = threadIdx.x; asm volatile("" : "+v"(tid_));
  const int tid = tid_, lane = tid & 63, r32 = lane & 31, hi = lane >> 5; const int wid = __builtin_amdgcn_readfirstlane(tid >> 6);
  const bf16_t* Qw = Qu + (size_t)(wid * QBLK) * QP;
  const unsigned lds0 = (unsigned)(uintptr_t)shm;
  float* wsf = (float*)(shm + LDS_WS) + wid * 64;
  const bf16_t* ksrc = Kh + (long)lane * KP + wid * 8;
  const bf16_t* vsrc = Vh + (long)(16 * (wid & 3) + (lane >> 2)) * KP + (wid >> 2) * 32 + (lane & 3) * 8;
  const unsigned kdst = lds0 + LDS_K + wid * 1024, vdst = lds0 + LDS_V + wid * 1024;
  #define DMA_K(t, slot) glds16(ksrc + (long)(t) * KVBLK * KP, (unsigned)__builtin_amdgcn_readfirstlane(kdst + (slot)))
  #define DMA_V(t, slot) glds16(vsrc + (long)(t) * KVBLK * KP, (unsigned)__builtin_amdgcn_readfirstlane(vdst + (slot)))
  const int vb0 = (int)(lds0 + LDS_V) + ((lane >> 4) & 1) * 32 + (lane & 3) * 8 + (4 * hi + ((lane & 15) >> 2)) * 64;
  bf16x8 kf[8];
  const lds_cptr shm3 = (lds_cptr)shm; const lds_cptr kp0 = shm3 + LDS_K + hi * 1024 + r32 * 16; const lds_cptr vp0 = shm3 + LDS_V + ((lane >> 4) & 1) * 32 + (lane & 3) * 8 + (4 * hi + ((lane & 15) >> 2)) * 64;
  const lds_cptr bp0 = shm3 + LDS_BIAS + hi * 16;
  const int nb4 = NT * 16; f32x4 bv[3];
  #pragma unroll
  for (int k = 0; k < 3; ++k) { const int idx = tid + 512 * k; bv[k] = (idx < nb4) ? *((const GAS f32x4*)biasg + idx) : (f32x4){0.f, 0.f, 0.f, 0.f}; }
  DMA_K(0, 0); DMA_V(0, 0); DMA_K(1, SLOTB);
  bf16x8 qr[4];
  #pragma unroll
  for (int d0 = 0; d0 < 4; ++d0) qr[d0] = *reinterpret_cast<const bf16x8*>(&Qw[(long)r32 * QP + d0 * 16 + hi * 8]);
  float mhat = 0.f, nmh = 0.f, bref = 0.f, l_reg = 0.f; f32x16 o[2]; o[0] = f32x16{}; o[1] = f32x16{};
  const int qrel = wid * QBLK + r32;
  #define CMASK(P0, P1, t) do { int jb_ = (t) - (NT - 4); if (jb_ >= 0) cmask(P0, P1, jb_, qrel, hi); } while (0)
  #define WMASK(P0, P1, t) do { if constexpr (SWA) { if ((t) < 4) wmask(P0, P1, (t), qrel, hi); } } while (0)
  #define BIASC(C0, C1, t) do { const LAS f32x4* bp_ = (const LAS f32x4*)(bp0 + (t) * 256); \
    _Pragma("unroll") for (int g_ = 0; g_ < 4; ++g_) { const f32x4 x0_ = bp_[2 * g_], x1_ = bp_[8 + 2 * g_]; \
      _Pragma("unroll") for (int c_ = 0; c_ < 4; ++c_) { C0[4 * g_ + c_] = nmh - x0_[c_]; C1[4 * g_ + c_] = nmh - x1_[c_]; } } } while (0)
  bool resc = false;
  #define START(P0, P1) do { const float rm = rowmax(P0, P1); resc = false; \
    { const float dl = (rm > -1e29f) ? rm : 0.f; mhat = fadd_s(mhat, dl); \
      _Pragma("unroll") for (int r = 0; r < 16; ++r) { P0[r] = fsub_s(P0[r], dl); P1[r] = fsub_s(P1[r], dl); } \
      nmh = bref - mhat; } \
    _Pragma("unroll") for (int r = 0; r < 16; ++r) P0[r] = __builtin_amdgcn_exp2f(P0[r]); } while (0)
  #define RESC() do { if (resc) { asm volatile("s_waitcnt lgkmcnt(0)" ::: "memory"); \
      _Pragma("unroll") for (int d_ = 0; d_ < 2; ++d_) _Pragma("unroll") for (int r = 0; r < 16; ++r) o[d_][r] *= wsf[crow(r, hi)]; } } while (0)
  f32x16 pA0, pA1, pB0, pB1;
  int sl_prev = 0, sl_cur = 0, sl_next = SLOTB;
  #define ROT() do { sl_prev = sl_cur; sl_cur = sl_next; sl_next = (sl_next == (NSLOT - 1) * SLOTB) ? 0 : sl_next + SLOTB; } while (0)
  DMA_K(2, 2 * SLOTB);
  #pragma unroll
  for (int k = 0; k < 3; ++k) { const int idx = tid + 512 * k; if (idx < nb4) *((LAS f32x4*)(shm3 + LDS_BIAS) + idx) = bv[k]; }
  WAIT_BAR(3);
  bref = *(const LAS float*)(shm3 + LDS_BIAS + refidx * 4); nmh = bref;
  BIASC(pA0, pA1, 0);
  qkt(pA0, pA1, shm3 + LDS_K, qr, r32, hi); asm volatile("s_nop 15\n\ts_nop 7" : "+v"(pA0), "+v"(pA1)); CMASK(pA0, pA1, 0); WMASK(pA0, pA1, 0);
  START(pA0, pA1);
  _Pragma("unroll") for (int r = 0; r < 16; ++r) pA1[r] = __builtin_amdgcn_exp2f(pA1[r]);
  WAIT_BAR(0);
  DMA_K(3, 0); DMA_V(1, SLOTB);
  ROT();
  kload8(kf, kp0 + sl_cur);
  WAIT_BAR(2);
  s16x4 vlo[8], vhi[8]; u32x4 pw0, pw1, pw2, pw3;
  #define PKW(P, B) cvtpk_s(P[B], P[B + 1])
  #define PAF(k) __builtin_bit_cast(bf16x8, pw##k)
  #define VFR(i) (bf16x8){vlo[i][0], vlo[i][1], vlo[i][2], vlo[i][3], vhi[i][0], vhi[i][1], vhi[i][2], vhi[i][3]}
  #define PIN(x) asm volatile("" : "+v"(x))
  #define MX3(a, b, c) __builtin_fmaxf(__builtin_fmaxf((a), (b)), (c))
  #define GAPA(MF, A0, A1, A2, A3, W0, W1, PW) do { MF; sacc += A0; sacc += A1; sacc += A2; sacc += A3; PIN(sacc); W0; W1; PIN(PW); SBAR(); } while (0)
  #define EX(v) __builtin_amdgcn_exp2f(v)
  #define GAPB(MF, X, B) do { MF; X[B] = EX(X[B]); X[B + 1] = EX(X[B + 1]); X[B + 2] = EX(X[B + 2]); X[B + 3] = EX(X[B + 3]); PIN(X); SBAR(); } while (0)
  #define VRD(i) do { vlo[i] = vtr(vp_ + (((i) >> 2) * 4096 + ((i) & 3) * 1024)); vhi[i] = vtr(vp_ + (((i) >> 2) * 4096 + ((i) & 3) * 1024 + 512)); } while (0)
  #define KRD(G, j) do { if (G) { kload2(kf, kp0 + sl_next, j); SBAR(); } } while (0)
  #define MF32(a, b, c) __builtin_amdgcn_mfma_f32_32x32x16_bf16(a, b, c, 0, 0, 0)
  #define STEP(C0, C1, P0, P1, t, GK, GV, GL) do { SBAR(); \
    BIASC(C0, C1, t); SBAR(); \
    const lds_cptr vp_ = vp0 + sl_prev; \
    VRD(0); SBAR(); float sacc = (P0[0] + P0[1]); \
    GAPA(C0 = MF32(kf[0], qr[0], C0), P0[2], P0[3], P0[4], P0[5],     pw0[0] = PKW(P0, 0), pw0[1] = PKW(P0, 2), pw0); \
    VRD(4); SBAR(); GAPA(C1 = MF32(kf[1], qr[0], C1), P0[6], P0[7], P0[8], P0[9],     pw0[2] = PKW(P0, 4), pw0[3] = PKW(P0, 6), pw0); \
    VRD(1); SBAR(); GAPA(C0 = MF32(kf[2], qr[1], C0), P0[10], P0[11], P0[12], P0[13], pw1[0] = PKW(P0, 8), pw1[1] = PKW(P0, 10), pw1); \
    VRD(5); SBAR(); GAPA(C1 = MF32(kf[3], qr[1], C1), P0[14], P0[15], P1[0], P1[1],   pw1[2] = PKW(P0, 12), pw1[3] = PKW(P0, 14), pw1); \
    VRD(2); SBAR(); GAPA(C0 = MF32(kf[4], qr[2], C0), P1[2], P1[3], P1[4], P1[5],     pw2[0] = PKW(P1, 0), pw2[1] = PKW(P1, 2), pw2); \
    VRD(6); SBAR(); GAPA(C1 = MF32(kf[5], qr[2], C1), P1[6], P1[7], P1[8], P1[9],     pw2[2] = PKW(P1, 4), pw2[3] = PKW(P1, 6), pw2); \
    VRD(3); SBAR(); GAPA(C0 = MF32(kf[6], qr[3], C0), P1[10], P1[11], P1[12], P1[13], pw3[0] = PKW(P1, 8), pw3[1] = PKW(P1, 10), pw3); \
    VRD(7); SBAR(); GAPA(C1 = MF32(kf[7], qr[3], C1), P1[14], P1[15], 0.f, 0.f,       pw3[2] = PKW(P1, 12), pw3[3] = PKW(P1, 14), pw3); \
    l_reg += sacc; \
    if (GK) { DMA_K((t) + 3, sl_cur); } if (GV) { DMA_V((t) + 1, sl_next); } \
    CMASK(C0, C1, t); WMASK(C0, C1, t); \
    { float a = MX3(C0[0], C0[1], C1[0]), b = MX3(C0[2], C0[3], C1[1]); a = MX3(a, C1[2], C1[3]); \
      _Pragma("unroll") for (int r = 4; r < 16; r += 4) { a = MX3(a, C0[r], C0[r + 1]); b = MX3(b, C0[r + 2], C0[r + 3]); a = MX3(a, C1[r], C1[r + 1]); b = MX3(b, C1[r + 2], C1[r + 3]); } \
      float rm = __builtin_fmaxf(a, b); { auto rr = __builtin_amdgcn_permlane32_swap(__float_as_uint(rm), __float_as_uint(rm), false, false); rm = __builtin_fmaxf(__uint_as_float(rr[0]), __uint_as_float(rr[1])); } \
      resc = false; \
      if (__builtin_expect(__any(rm > (float)THRL), 0)) { const float dl = __builtin_fmaxf(rm, 0.f); mhat += dl; \
        _Pragma("unroll") for (int r = 0; r < 16; ++r) { C0[r] -= dl; C1[r] -= dl; } \
        nmh = bref - mhat; \
        const float f = __builtin_amdgcn_exp2f(-dl); l_reg *= f; if (hi == 0) wsf[r32] = f; resc = true; } } \
    SBAR(); \
    GAPB(o[0] = MF32(PAF(0), VFR(0), o[0]), C0, 0); \
    GAPB(o[1] = MF32(PAF(0), VFR(4), o[1]), C0, 4); \
    KRD(GL, 0); GAPB(o[0] = MF32(PAF(1), VFR(1), o[0]), C0, 8); \
    KRD(GL, 1); GAPB(o[1] = MF32(PAF(1), VFR(5), o[1]), C0, 12); \
    KRD(GL, 2); GAPB(o[0] = MF32(PAF(2), VFR(2), o[0]), C1, 0); \
    KRD(GL, 3); GAPB(o[1] = MF32(PAF(2), VFR(6), o[1]), C1, 4); \
    GAPB(o[0] = MF32(PAF(3), VFR(3), o[0]), C1, 8); \
    GAPB(o[1] = MF32(PAF(3), VFR(7), o[1]), C1, 12); \
    } while (0)
  int t = 1;
  #undef CMASK
  #define CMASK(P0, P1, t) do {} while (0)
  for (; t + 5 < NT; t += 2) {
    STEP(pB0, pB1, pA0, pA1, t, true, true, true);     WAIT_BAR(2); RESC(); ROT();
    STEP(pA0, pA1, pB0, pB1, t + 1, true, true, true); WAIT_BAR(2); RESC(); ROT();
  }
  #undef CMASK
  #define CMASK(P0, P1, t) do { int jb_ = (t) - (NT - 4); if (jb_ >= 0) cmask(P0, P1, jb_, qrel, hi); } while (0)
  #define ENDW(tt) do { if ((tt) + 3 < NT) { WAIT_BAR(2); } else if ((tt) + 2 < NT) { WAIT_BAR(1); } else { WAIT_BAR(0); } } while (0)
  for (; t + 1 < NT; t += 2) {
    STEP(pB0, pB1, pA0, pA1, t, (t + 3 < NT), (t + 1 < NT), (t + 1 < NT));         ENDW(t);     RESC(); ROT();
    STEP(pA0, pA1, pB0, pB1, t + 1, (t + 4 < NT), (t + 2 < NT), (t + 2 < NT));     ENDW(t + 1); RESC(); ROT();
  }
  STEP(pB0, pB1, pA0, pA1, NT - 1, false, false, false); RESC();
  { float sacc = pB0[0] + pB0[1]; _Pragma("unroll") for (int r = 2; r < 16; ++r) sacc += pB0[r]; _Pragma("unroll") for (int r = 0; r < 16; ++r) sacc += pB1[r]; l_reg += sacc;
    pw0 = (u32x4){PKW(pB0, 0), PKW(pB0, 2), PKW(pB0, 4), PKW(pB0, 6)}; pw1 = (u32x4){PKW(pB0, 8), PKW(pB0, 10), PKW(pB0, 12), PKW(pB0, 14)}; pw2 = (u32x4){PKW(pB1, 0), PKW(pB1, 2), PKW(pB1, 4), PKW(pB1, 6)}; pw3 = (u32x4){PKW(pB1, 8), PKW(pB1, 10), PKW(pB1, 12), PKW(pB1, 14)};
    SBAR(); pv(o, vb0 + sl_cur, PAF(0), PAF(1), PAF(2), PAF(3)); }
  #undef PKW
  #undef PAF
  #undef VFR
  #undef PIN
  #undef MX3
  #undef GAPA
  #undef GAPB
  #undef EX
  #undef VRD
  #undef KRD
  #undef STEP
  #undef ENDW
  #undef MF32
  { auto rr = __builtin_amdgcn_permlane32_swap(__float_as_uint(l_reg), __float_as_uint(l_reg), false, false); l_reg = __uint_as_float(rr[0]) + __uint_as_float(rr[1]); }
  if constexpr (SWA) l_reg += __builtin_amdgcn_exp2f(sink0 + sinkstep * (float)qrel - mhat);
  if (hi == 0) wsf[32 + r32] = l_reg; asm volatile("s_waitcnt lgkmcnt(0)" ::: "memory");
  float rli[16];
  #pragma unroll
  for (int r = 0; r < 16; ++r) rli[r] = __builtin_amdgcn_rcpf(wsf[32 + crow(r, hi)]);
  bf16_t* Ow = Ou + (size_t)(wid * QBLK) * QP;
  { bf16_t* stg = (bf16_t*)(shm + LDS_OST) + wid * 2048;
    #pragma unroll
    for (int r = 0; r < 16; ++r) { const int orow = crow(r, hi);
      #pragma unroll
      for (int d0 = 0; d0 < 2; ++d0) stg[orow * 64 + d0 * 32 + r32] = (bf16_t)f2bf(o[d0][r] * rli[r]); }
    asm volatile("s_waitcnt lgkmcnt(0)" ::: "memory");
    #pragma unroll
    for (int i = 0; i < 4; ++i) { const int row = i * 8 + (lane >> 3), ch = lane & 7; const u32x4 v = *(const u32x4*)(stg + row * 64 + ch * 8); *(u32x4*)(Ow + (long)row * QP + ch * 8) = v; } }
  asm volatile("s_waitcnt lgkmcnt(0)\n\ts_barrier" ::: "memory");
  #undef DMA_K
  #undef DMA_V
  #undef CMASK
  #undef WMASK
  #undef BIASC
  #undef START
  #undef RESC
  #undef ROT
}
#undef SBAR
#undef WAIT_BAR
}

#define XB_TMO      128
#define XB_XCNT(j)  (256  + 64 * (j))
#define XB_XSUB(j)  (1280 + 64 * (j))
#define XB_XGEN(j)  (2304 + 64 * (j))
#define XB_TOP      3328
#define XB_TOPGEN   3392
#define XCD_BAR_WORDS 3456
#define XB_SPIN_CAP (1u << 18)
__device__ __forceinline__ unsigned xb_ld(unsigned* p)              { return __hip_atomic_load(p, __ATOMIC_RELAXED, __HIP_MEMORY_SCOPE_AGENT); }
__device__ __forceinline__ unsigned xb_add(unsigned* p, unsigned v) { return __hip_atomic_fetch_add(p, v, __ATOMIC_RELAXED, __HIP_MEMORY_SCOPE_AGENT); }
__device__ __forceinline__ unsigned xb_xcc_id() { return (unsigned)__builtin_amdgcn_s_getreg((3 << 11) | 20) & 0xFu; }
#define XB_SPIN(cond, bar) do { unsigned _sp = 0; while (cond) { __builtin_amdgcn_s_sleep(1); \
    if ((++_sp & 255u) == 0u) { if (xb_ld(&(bar)[XB_TMO])) break; if (_sp > XB_SPIN_CAP) { atomicAdd(&(bar)[XB_TMO], 1u); break; } } } } while (0)
struct XcdBarrier { unsigned* bar; unsigned x; volatile LAS unsigned* st; };
__device__ __forceinline__ XcdBarrier xcd_barrier_post(unsigned* bar, volatile LAS unsigned* st) {
    XcdBarrier b; b.bar = bar; b.x = xb_xcc_id(); b.st = st;
    if (threadIdx.x == 0) (void)xb_add(&bar[XB_XCNT(b.x)], 1u);
    return b;
}
__device__ __forceinline__ void xcd_barrier_complete(unsigned* bar, unsigned x, unsigned& nloc, unsigned& nx) {
    const unsigned G = gridDim.x * gridDim.y * gridDim.z;
    unsigned sum, cnt, mine, sp = 0u;
    for (;;) {
        sum = 0u; cnt = 0u; mine = 0u;
#pragma unroll
        for (unsigned j = 0; j < 16; ++j) { const unsigned c = xb_ld(&bar[XB_XCNT(j)]); sum += c; cnt += (c > 0u) ? 1u : 0u; mine = (j == x) ? c : mine; }
        if (sum == G) break;
        __builtin_amdgcn_s_sleep(1);
        if ((++sp & 255u) == 0u) { if (xb_ld(&bar[XB_TMO])) break; if (sp > XB_SPIN_CAP) { atomicAdd(&bar[XB_TMO], 1u); break; } }
    }
    nloc = mine > 0u ? mine : 1u; nx = cnt > 0u ? cnt : 1u;
}
__device__ __forceinline__ void xcd_barrier(const XcdBarrier& b) {
    asm volatile("s_waitcnt vmcnt(0)" ::: "memory");
    __syncthreads();
    if (threadIdx.x == 0) {
        unsigned* bar = b.bar;
        __builtin_amdgcn_s_waitcnt(0);
        unsigned nloc = b.st[0], nx = b.st[1];
        if (nloc == 0u) { xcd_barrier_complete(bar, b.x, nloc, nx); b.st[0] = nloc; b.st[1] = nx; }
        const unsigned old = xb_add(&bar[XB_XSUB(b.x)], 1u);
        const unsigned gen = old / nloc;
        if (old + 1u == (gen + 1u) * nloc) {
            __builtin_amdgcn_fence(__ATOMIC_RELEASE, "agent");
            asm volatile("s_waitcnt vmcnt(0)" ::: "memory");
            const unsigned og = xb_add(&bar[XB_TOP], 1u);
            const unsigned tg = og / nx;
            if (og + 1u == (tg + 1u) * nx) xb_add(&bar[XB_TOPGEN], 1u);
            else XB_SPIN(xb_ld(&bar[XB_TOPGEN]) == tg, bar);
            __builtin_amdgcn_fence(__ATOMIC_ACQUIRE, "agent");
            xb_add(&bar[XB_XGEN(b.x)], 1u);
            asm volatile("s_waitcnt vmcnt(0)" ::: "memory");
        } else {
            XB_SPIN(xb_ld(&bar[XB_XGEN(b.x)]) == gen, bar);
            __builtin_amdgcn_fence(__ATOMIC_ACQUIRE, "agent");
            asm volatile("s_waitcnt vmcnt(0)" ::: "memory");
        }
    }
    __syncthreads();
}

struct Args { const float* in[20]; float* out; unsigned char* ws; };

struct Frame {
    LAS unsigned char* lds; volatile LAS unsigned* MISC; gu32* ctl;
    int tid, lane, wave, G, gw, NGW;
    unsigned char* ws;
};

struct TrItem { const float* W; int ldw, col0, k0; bf16_t* WT; int ldt, row0; };
__device__ __forceinline__ void tr_load(const TrItem& t, f32x4 (&v)[8], int lane) {
    const float* p = t.W + (size_t)(t.k0 + (lane >> 3)) * t.ldw + t.col0 + 4 * (lane & 7);
#pragma unroll
    for (int i = 0; i < 8; ++i) v[i] = __builtin_nontemporal_load((const GAS f32x4*)(p + (size_t)(8 * i) * t.ldw));
}
__device__ __forceinline__ void tr_store(const TrItem& t, const f32x4 (&v)[8], LAS float* scr, int lane) {
    LAS float* w = scr + (lane >> 3) * 33 + 4 * (lane & 7);
#pragma unroll
    for (int i = 0; i < 8; ++i) { w[(8 * i) * 33 + 0] = v[i].x; w[(8 * i) * 33 + 1] = v[i].y; w[(8 * i) * 33 + 2] = v[i].z; w[(8 * i) * 33 + 3] = v[i].w; }
    LDS_WAIT(); asm volatile("" ::: "memory");
    const int c = lane & 7;
#pragma unroll
    for (int j = 0; j < 4; ++j) { const int n = (lane >> 3) + 8 * j; const LAS float* s = scr + (8 * c) * 33 + n;
        u32x4 o; o.x = pk2(s[0 * 33], s[1 * 33]); o.y = pk2(s[2 * 33], s[3 * 33]); o.z = pk2(s[4 * 33], s[5 * 33]); o.w = pk2(s[6 * 33], s[7 * 33]);
        *(GAS u32x4*)(t.WT + (size_t)(t.row0 + n) * t.ldt + t.k0 + 8 * c) = o; }
    LDS_WAIT(); asm volatile("" ::: "memory");
}
__device__ __forceinline__ void tr8_item(const float* W, int ldw, int col0, int k0, unsigned char* WT, int ldt, int row0, LAS float* scr, int lane) {
    const float* p = W + (size_t)(k0 + (lane >> 3)) * ldw + col0 + 4 * (lane & 7);
    f32x4 v[16];
#pragma unroll
    for (int i = 0; i < 16; ++i) v[i] = __builtin_nontemporal_load((const GAS f32x4*)(p + (size_t)(8 * i) * ldw));
    LAS float* w = scr + (lane >> 3) * 33 + 4 * (lane & 7);
#pragma unroll
    for (int i = 0; i < 16; ++i) { w[(8 * i) * 33 + 0] = v[i].x; w[(8 * i) * 33 + 1] = v[i].y; w[(8 * i) * 33 + 2] = v[i].z; w[(8 * i) * 33 + 3] = v[i].w; }
    LDS_WAIT(); asm volatile("" ::: "memory");
    const int c = lane & 7;
#pragma unroll
    for (int j = 0; j < 4; ++j) { const int n = (lane >> 3) + 8 * j; const LAS float* s = scr + (16 * c) * 33 + n;
        u32x4 o; o.x = pk4_fp8(s[0 * 33] * SC_W, s[1 * 33] * SC_W, s[2 * 33] * SC_W, s[3 * 33] * SC_W); o.y = pk4_fp8(s[4 * 33] * SC_W, s[5 * 33] * SC_W, s[6 * 33] * SC_W, s[7 * 33] * SC_W);
        o.z = pk4_fp8(s[8 * 33] * SC_W, s[9 * 33] * SC_W, s[10 * 33] * SC_W, s[11 * 33] * SC_W); o.w = pk4_fp8(s[12 * 33] * SC_W, s[13 * 33] * SC_W, s[14 * 33] * SC_W, s[15 * 33] * SC_W);
        __builtin_nontemporal_store(o, (GAS u32x4*)(WT + (size_t)(row0 + n) * ldt + k0 + 16 * c)); }
    LDS_WAIT(); asm volatile("" ::: "memory");
}
constexpr int NCB_P1 = 64, NCB_P6 = 160, NCB_P2 = 1024 - NCB_P1 - NCB_P6;
__device__ __forceinline__ void conv_batch(int bat, const float* w_up_, const float* w_down_, unsigned char* wup8, unsigned char* wdn8, LAS unsigned char* ring) {
    constexpr int I_UP = NE * 8 * 64; const int t2 = fresh_tid(), lane = t2 & 63, wv = __builtin_amdgcn_readfirstlane(t2 >> 6);
    LAS float* scr = (LAS float*)(ring + wv * 17664);
#pragma unroll 1
    for (int k3 = 0; k3 < 3; ++k3) { const int it = bat * 24 + 8 * k3 + wv;
        if (it < I_UP) { const int e = it / (8 * 64), q = it % (8 * 64), kb = q / 64, nb = q % 64;
            const int lcol = ((nb >> 2) & 1) * 1024 + (nb >> 3) * 128 + (nb & 3) * 32;
            tr8_item(w_up_ + (size_t)e * DM * 2048, 2048, lcol, kb * 128, wup8 + (size_t)e * 2048 * DM, DM, nb * 32, scr, lane); }
        else { const int r = it - I_UP, e = r / (8 * 32), q = r % (8 * 32), kb = q / 32, nb = q % 32;
            tr8_item(w_down_ + (size_t)e * DM * DM, DM, nb * 32, kb * 128, wdn8 + (size_t)e * DM * DM, DM, nb * 32, scr, lane); } }
}
__device__ __forceinline__ int win_logical_col(int p) {
    const int tile = p >> 8, q = p & 255, bj = q >> 7, hh = (q >> 5) & 3;
    if (tile >= 9) { return (tile < 13 ? 2312 + (tile - 9) * 256 : 3336 + (tile - 13) * 256) + q; }
    const int hoff = hh * 64 + bj * 32;
    if (tile < 6) return tile * 256 + hoff;
    if (tile < 8) return 1544 + (tile - 6) * 256 + hoff;
    return 2056 + hoff;
}

struct SchedIn {
    int G, c, lo, hi; const char* A; const char* B;
    __device__ __forceinline__ bool next(int i, pg8::Unit& u) const {
        const int n = lo + i * G + c; int pm, pn;
        if (n >= hi) return false;
        if (n < 5) { pm = 64; pn = (n < 4) ? 2 + n : 8; }
        else { int wgid = n - 5; { const int q = 1088 / 8, xcd = wgid % 8, off = wgid / 8; wgid = xcd * q + off; }
            const int nig = 8 * 17, gid = wgid / nig, fm = gid * 8; pm = fm + ((wgid % nig) % 8); pn = (wgid % nig) / 8; }
        u.A = A + (size_t)pm * 256 * DM * 2; u.B = B + (size_t)pn * 256 * DM * 2; u.rows_lds = 0; u.i0 = pm; u.i1 = pn; u.i2 = 0; u.i3 = 0; return true;
    }
};
constexpr int IN_ALL = 1093, IN_P1 = 992;
struct SchedMix {
    int G, c; const char *OA, *OB, *WF, *WS;
    __device__ __forceinline__ bool next(int i, pg8::Unit& u) const {
        if (i >= 2 || c >= 256) return false;
        int wgid = c; { const int q = 256 / 8, xcd = wgid % 8, off = wgid / 8; wgid = xcd * q + off; }
        const int nig = 8 * 4, gid = wgid / nig, fm = gid * 8, pm = fm + ((wgid % nig) % 8), pn = (wgid % nig) / 8;
        u.A = (i == 0 ? OA : OB) + (size_t)pm * 256 * 512 * 2; u.B = (i == 0 ? WF : WS) + (size_t)pn * 256 * 512 * 2; u.rows_lds = 0; u.i0 = pm; u.i1 = pn; u.i2 = i; u.i3 = 0; return true;
    }
};
struct SchedOut {
    int G, c; const char *A, *B;
    __device__ __forceinline__ bool next(int i, pg8::Unit& u) const {
        if (i >= 1 || c >= 256) return false;
        int wgid = c; { const int q = 256 / 8, xcd = wgid % 8, off = wgid / 8; wgid = xcd * q + off; }
        const int nig = 8 * 4, gid = wgid / nig, fm = gid * 8, pm = fm + ((wgid % nig) % 8), pn = (wgid % nig) / 8;
        u.A = A + (size_t)pm * 256 * DM * 2; u.B = B + (size_t)pn * 256 * DM * 2; u.rows_lds = 0; u.i0 = pm; u.i1 = pn; u.i2 = 0; u.i3 = 0; return true;
    }
};
struct SchedMoe {
    int G, c, NPN; const LAS int* utab; const char* A; const char* B; int gather, pb;
    __device__ __forceinline__ bool next(int i, pg8::Unit& u) const {
        if (i >= 10) return false;
        const i32x4 t = *(const LAS i32x4*)(utab + 4 * i);
        if (__builtin_amdgcn_readfirstlane(t.w) == 0) return false;
        const int tau = __builtin_amdgcn_readfirstlane(t.x), e = __builtin_amdgcn_readfirstlane(t.y), pn = __builtin_amdgcn_readfirstlane(t.w) - 1;
        u.i0 = tau; u.i1 = pn; u.i2 = e; u.i3 = __builtin_amdgcn_readfirstlane(t.z);
        u.rows_lds = ROWS_OFF + i * 1024;
        u.A = gather ? A : A + (size_t)tau * 256 * pb;
        u.B = B + ((size_t)e * (NPN * 256) + (size_t)pn * 256) * pb;
        return true;
    }
};
__device__ __forceinline__ void moe_units(LAS int* utab, const LAS int* tab, int T, int NPN, int G, int c, int tid) {
    if (tid < 10) { const int x = c & 7, k = c >> 3, nx = (G - x + 7) >> 3, t0 = (T * x) >> 3, t1 = (T * (x + 1)) >> 3;
        const int L = t0 * NPN + tid * nx + k; i32x4 t = {0, 0, 0, 0};
        if (L < t1 * NPN) { const int tau = L / NPN; int e = 0;
            for (int j = 1; j < NE; ++j) e += (tab[32 + j] <= tau) ? 1 : 0;
            t = (i32x4){tau, e, tab[e] - (tau - tab[32 + e]) * 256, 1 + L % NPN}; }
        *(LAS i32x4*)(utab + 4 * tid) = t; }
    __syncthreads();
}

struct EpiIn {
    __device__ __forceinline__ bool keep_acc(const pg8::Unit&) const { return false; }
    static constexpr int NS = 16;
    __device__ __forceinline__ bool relax_ok(const pg8::Unit& u) const { return u.i0 < 64; }
    bf16_t *FQ, *FK, *FV, *SQ, *SK, *SV, *GA, *GB; const float *gfq, *gfk, *gsq, *gsk;
    __device__ __forceinline__ void operator()(const f32x4 (&acc)[2][2][4][2], const pg8::Unit& u, int wr, int wc, int fr, int fq) const {
        const int pm = u.i0, pn = u.i1;
        if (pn >= 9) {
            bf16_t* G = (pn < 13) ? GA : GB; const int colt = (pn < 13 ? pn - 9 : pn - 13) * 256 + wc * 32 + 8 * fq;
#pragma unroll
            for (int ai = 0; ai < 2; ++ai)
#pragma unroll
                for (int m = 0; m < 4; ++m) { const int row = pm * 256 + ai * 128 + wr * 64 + m * 16 + fr; bf16_t* rowp = G + (size_t)row * DM + colt;
#pragma unroll
                    for (int bj = 0; bj < 2; ++bj) { const f32x4 v0 = acc[ai][bj][m][0], v1 = acc[ai][bj][m][1]; u32x4 w;
                        w.x = pk2(sigmoidf_fast(v0[0]), sigmoidf_fast(v0[1])); w.y = pk2(sigmoidf_fast(v0[2]), sigmoidf_fast(v0[3]));
                        w.z = pk2(sigmoidf_fast(v1[0]), sigmoidf_fast(v1[1])); w.w = pk2(sigmoidf_fast(v1[2]), sigmoidf_fast(v1[3]));
                        *(GAS u32x4*)(rowp + bj * 128) = w; } }
            return;
        }
        bf16_t* dst; int pitch, hcol, metaslot; bool kv, donorm; const float* gain; float scale = 1.f;
        if (pn < 2)      { dst = FQ; pitch = 512; hcol = (4 * pn + wc) * 64;       kv = false; donorm = true;  gain = gfq; scale = C2; metaslot = 0; }
        else if (pn < 4) { dst = FK; pitch = 512; hcol = (4 * (pn - 2) + wc) * 64; kv = true;  donorm = true;  gain = gfk; metaslot = 48; }
        else if (pn < 6) { dst = FV; pitch = 512; hcol = (4 * (pn - 4) + wc) * 64; kv = true;  donorm = false; gain = gfk; metaslot = 48; }
        else if (pn < 8) { dst = SQ; pitch = 512; hcol = (4 * (pn - 6) + wc) * 64; kv = false; donorm = true;  gain = gsq; scale = C2; metaslot = 0; }
        else if (wc < 2) { dst = SK; pitch = 128; hcol = wc * 64;                  kv = true;  donorm = true;  gain = gsk; metaslot = 112; }
        else             { dst = SV; pitch = 128; hcol = (wc - 2) * 64;            kv = true;  donorm = false; gain = gsk; metaslot = 112; }
        f32x4 gv[2][2];
#pragma unroll
        for (int bj = 0; bj < 2; ++bj)
#pragma unroll
            for (int n = 0; n < 2; ++n) { const f32x4 gl = *(const GAS f32x4*)(gain + 32 * bj + 8 * fq + 4 * n); gv[bj][n] = gl * (donorm ? scale : 0.f) + (donorm ? 0.f : 1.f); }
#pragma unroll
        for (int ai = 0; ai < 2; ++ai)
#pragma unroll
            for (int m = 0; m < 4; ++m) {
                float ss = 0.f;
#pragma unroll
                for (int bj = 0; bj < 2; ++bj)
#pragma unroll
                    for (int n = 0; n < 2; ++n) { const f32x4 x = acc[ai][bj][m][n]; ss += (x[0] * x[0] + x[1] * x[1]) + (x[2] * x[2] + x[3] * x[3]); }
                ss += __shfl_xor(ss, 16); ss += __shfl_xor(ss, 32);
                const float r = donorm ? __builtin_amdgcn_rsqf(ss * (1.f / 64.f) + RMS_EPS) : 1.f;
                u32x4 w[2];
#pragma unroll
                for (int bj = 0; bj < 2; ++bj) { const f32x4 v0 = acc[ai][bj][m][0] * gv[bj][0] * r, v1 = acc[ai][bj][m][1] * gv[bj][1] * r;
                    w[bj].x = pk2(v0[0], v0[1]); w[bj].y = pk2(v0[2], v0[3]); w[bj].z = pk2(v1[0], v1[1]); w[bj].w = pk2(v1[2], v1[3]); }
                const int lrow = ai * 128 + wr * 64 + m * 16 + fr;
                if (pm < 64) { const int tok = pm * 256 + lrow; const int drow = kv ? (tok >> 12) * LP + 128 + (tok & 4095) : tok;
                    bf16_t* rowp = dst + (size_t)drow * pitch + hcol + 8 * fq;
                    *(GAS u32x4*)(rowp) = w[0]; *(GAS u32x4*)(rowp + 32) = w[1]; }
                else if (lrow < NMETA && kv) {
#pragma unroll
                    for (int b = 0; b < NB; ++b) { bf16_t* rowp = dst + (size_t)(b * LP + metaslot + lrow) * pitch + hcol + 8 * fq;
                        *(GAS u32x4*)(rowp) = w[0]; *(GAS u32x4*)(rowp + 32) = w[1]; } }
            }
    }
};
struct EpiMix {
    static constexpr int NS = 32;
    __device__ __forceinline__ bool relax_ok(const pg8::Unit& u) const { return true; }
    bf16_t* MIX; const bf16_t *GA, *GB;
    __device__ __forceinline__ bool keep_acc(const pg8::Unit& u) const { return u.i2 == 0; }
    __device__ __forceinline__ void operator()(f32x4 (&acc)[2][2][4][2], const pg8::Unit& u, int wr, int wc, int fr, int fq) const {
        const int pm = u.i0, pn = u.i1, part = u.i2;
#pragma unroll
        for (int ai = 0; ai < 2; ++ai) {
            u32x4 ga[4][2], gb[4][2];
#pragma unroll
            for (int m = 0; m < 4; ++m) { const size_t off = (size_t)(pm * 256 + ai * 128 + wr * 64 + m * 16 + fr) * DM + pn * 256 + wc * 32 + 8 * fq;
#pragma unroll
                for (int bj = 0; bj < 2; ++bj) { gb[m][bj] = *(const GAS u32x4*)(GB + off + bj * 128); ga[m][bj] = part ? gb[m][bj] : *(const GAS u32x4*)(GA + off + bj * 128); } }
#pragma unroll
            for (int m = 0; m < 4; ++m) { const size_t off = (size_t)(pm * 256 + ai * 128 + wr * 64 + m * 16 + fr) * DM + pn * 256 + wc * 32 + 8 * fq;
#pragma unroll
                for (int bj = 0; bj < 2; ++bj) { const u32x4 a_ = ga[m][bj], b_ = gb[m][bj]; f32x4& v0 = acc[ai][bj][m][0]; f32x4& v1 = acc[ai][bj][m][1];
                    if (part == 0) {
                        v0[0] *= bflo(a_.x) * __builtin_amdgcn_rcpf(bflo(b_.x)); v0[1] *= bfhi(a_.x) * __builtin_amdgcn_rcpf(bfhi(b_.x)); v0[2] *= bflo(a_.y) * __builtin_amdgcn_rcpf(bflo(b_.y)); v0[3] *= bfhi(a_.y) * __builtin_amdgcn_rcpf(bfhi(b_.y));
                        v1[0] *= bflo(a_.z) * __builtin_amdgcn_rcpf(bflo(b_.z)); v1[1] *= bfhi(a_.z) * __builtin_amdgcn_rcpf(bfhi(b_.z)); v1[2] *= bflo(a_.w) * __builtin_amdgcn_rcpf(bflo(b_.w)); v1[3] *= bfhi(a_.w) * __builtin_amdgcn_rcpf(bfhi(b_.w));
                    } else {
                        u32x4 w; w.x = pk2(v0[0] * bflo(b_.x), v0[1] * bfhi(b_.x)); w.y = pk2(v0[2] * bflo(b_.y), v0[3] * bfhi(b_.y)); w.z = pk2(v1[0] * bflo(b_.z), v1[1] * bfhi(b_.z)); w.w = pk2(v1[2] * bflo(b_.w), v1[3] * bfhi(b_.w));
                        *(GAS u32x4*)(MIX + off + bj * 128) = w; } } }
        }
    }
};
struct EpiOut {
    __device__ __forceinline__ bool keep_acc(const pg8::Unit&) const { return false; }
    static constexpr int NS = 48;
    __device__ __forceinline__ bool relax_ok(const pg8::Unit& u) const { return true; }
    bf16_t* H; const float* X;
    __device__ __forceinline__ void operator()(const f32x4 (&acc)[2][2][4][2], const pg8::Unit& u, int wr, int wc, int fr, int fq) const {
        const int pm = u.i0, pn = u.i1;
#pragma unroll
        for (int ai = 0; ai < 2; ++ai) {
            f32x4 xv[4][2][2];
#pragma unroll
            for (int m = 0; m < 4; ++m) { const size_t off = (size_t)(pm * 256 + ai * 128 + wr * 64 + m * 16 + fr) * DM + pn * 256 + wc * 32 + 8 * fq;
#pragma unroll
                for (int bj = 0; bj < 2; ++bj)
#pragma unroll
                    for (int n = 0; n < 2; ++n) xv[m][bj][n] = __builtin_nontemporal_load((const GAS f32x4*)(X + off + bj * 128 + 4 * n)); }
#pragma unroll
            for (int m = 0; m < 4; ++m) { const size_t off = (size_t)(pm * 256 + ai * 128 + wr * 64 + m * 16 + fr) * DM + pn * 256 + wc * 32 + 8 * fq;
#pragma unroll
                for (int bj = 0; bj < 2; ++bj) { const f32x4 v0 = xv[m][bj][0] + acc[ai][bj][m][0], v1 = xv[m][bj][1] + acc[ai][bj][m][1];
                    u32x4 w; w.x = pk2(v0[0], v0[1]); w.y = pk2(v0[2], v0[3]); w.z = pk2(v1[0], v1[1]); w.w = pk2(v1[2], v1[3]);
                    *(GAS u32x4*)(H + off + bj * 128) = w; } }
        }
    }
};
__device__ __forceinline__ float swiglu_act(float g, float u) {
    g = fminf(g, 7.f); u = fminf(fmaxf(u, -7.f), 7.f);
    return (u + 1.f) * (g * __builtin_amdgcn_rcpf(1.f + __builtin_amdgcn_exp2f(-1.702f * LOG2E * g)));
}
struct EpiUp {
    __device__ __forceinline__ bool keep_acc(const pg8::Unit&) const { return false; }
    static constexpr int NS = 12;
    __device__ __forceinline__ bool relax_ok(const pg8::Unit& u) const { return true; }
    unsigned char* ACT; const float* bup;
    __device__ __forceinline__ void operator()(const f32x4 (&acc)[2][2][4][2], const pg8::Unit& u, int wr, int wc, int fr, int fq) const {
        const int tau = u.i0, pn = u.i1, e = u.i2; const int gcol = pn * 128 + wc * 32 + 8 * fq; constexpr float us = 1.f / (SC_H * SC_W);
        f32x2 bg[4], bu[4];
#pragma unroll
        for (int n = 0; n < 2; ++n) { const f32x4 g4 = *(const GAS f32x4*)(bup + (size_t)e * 2048 + gcol + 4 * n), u4 = *(const GAS f32x4*)(bup + (size_t)e * 2048 + 1024 + gcol + 4 * n);
            bg[2 * n] = (f32x2){g4.x, g4.y}; bg[2 * n + 1] = (f32x2){g4.z, g4.w}; bu[2 * n] = (f32x2){u4.x, u4.y} * SC_A + SC_A; bu[2 * n + 1] = (f32x2){u4.z, u4.w} * SC_A + SC_A; }
#pragma unroll
        for (int ai = 0; ai < 2; ++ai)
#pragma unroll
            for (int m = 0; m < 4; ++m) { const size_t off = (size_t)(tau * 256 + ai * 128 + wr * 64 + m * 16 + fr) * DM + gcol;
                f32x2 o[4];
#pragma unroll
                for (int p = 0; p < 4; ++p) { const f32x4 ag = acc[ai][0][m][p >> 1], au = acc[ai][1][m][p >> 1];
                    f32x2 g = ((p & 1) ? (f32x2){ag.z, ag.w} : (f32x2){ag.x, ag.y}) * us + bg[p];
                    f32x2 uu = ((p & 1) ? (f32x2){au.z, au.w} : (f32x2){au.x, au.y}) * (us * SC_A) + bu[p];
                    g.x = fminf(g.x, 7.f); g.y = fminf(g.y, 7.f);
                    uu.x = __builtin_amdgcn_fmed3f(uu.x, -6.f * SC_A, 8.f * SC_A); uu.y = __builtin_amdgcn_fmed3f(uu.y, -6.f * SC_A, 8.f * SC_A);
                    const f32x2 t = g * (-1.702f * LOG2E); f32x2 d; d.x = __builtin_amdgcn_exp2f(t.x); d.y = __builtin_amdgcn_exp2f(t.y); d = d + 1.f;
                    f32x2 r; r.x = __builtin_amdgcn_rcpf(d.x); r.y = __builtin_amdgcn_rcpf(d.y);
                    o[p] = uu * (g * r); }
                u32x2 w; w.x = pk4_fp8(o[0].x, o[0].y, o[1].x, o[1].y); w.y = pk4_fp8(o[2].x, o[2].y, o[3].x, o[3].y);
                *(GAS u32x2*)(ACT + off) = w; }
    }
};
struct EpiDown {
    __device__ __forceinline__ bool keep_acc(const pg8::Unit&) const { return false; }
    static constexpr int NS = 20;
    __device__ __forceinline__ bool relax_ok(const pg8::Unit& u) const { return true; }
    unsigned char* YS; const float* bdn; const float* roww; const LAS int* tab;
    __device__ __forceinline__ void operator()(const f32x4 (&acc)[2][2][4][2], const pg8::Unit& u, int wr, int wc, int fr, int fq) const {
        const int tau = u.i0, pn = u.i1, e = u.i2, nvalid = u.i3; const int col = pn * 256 + wc * 32 + 8 * fq; const int lt0 = (tau - tab[32 + e]) * 256;
        f32x4 bv[2][2];
#pragma unroll
        for (int bj = 0; bj < 2; ++bj)
#pragma unroll
            for (int n = 0; n < 2; ++n) bv[bj][n] = *(const GAS f32x4*)(bdn + (size_t)e * DM + col + bj * 128 + 4 * n);
        float wv[8];
#pragma unroll
        for (int q = 0; q < 8; ++q) { const int lrow = (q >> 2) * 128 + wr * 64 + (q & 3) * 16 + fr; const int lr = lrow < nvalid ? lrow : 0; wv[q] = roww[(size_t)e * ECAP + lt0 + lr]; wv[q] = lrow < nvalid ? wv[q] : 0.f; }
#pragma unroll
        for (int ai = 0; ai < 2; ++ai)
#pragma unroll
            for (int m = 0; m < 4; ++m) { const int lrow = ai * 128 + wr * 64 + m * 16 + fr; const size_t off = (size_t)(tau * 256 + lrow) * DM + col;
                const float w = wv[ai * 4 + m];
#pragma unroll
                for (int bj = 0; bj < 2; ++bj) { constexpr float us = 1.f / (SC_A * SC_W); const float ws = w * SC_Y; const f32x4 lim = {448.f, 448.f, 448.f, 448.f};
                    const f32x4 v0 = __builtin_elementwise_min(__builtin_elementwise_max((acc[ai][bj][m][0] * us + bv[bj][0]) * ws, -lim), lim), v1 = __builtin_elementwise_min(__builtin_elementwise_max((acc[ai][bj][m][1] * us + bv[bj][1]) * ws, -lim), lim);
                    u32x2 o; o.x = pk4_fp8(v0[0], v0[1], v0[2], v0[3]); o.y = pk4_fp8(v1[0], v1[1], v1[2], v1[3]);
                    *(GAS u32x2*)(YS + off + bj * 128) = o; } }
    }
};
__device__ __forceinline__ void router_finish(float (&p)[32], float brt, int lane, int lt, LAS int* hist, LAS int* sel_e, LAS float* sel_g, LAS int* sel_r) {
#pragma unroll
    for (int e = 0; e < 16; ++e) { const bool up = (lane & 32) != 0; const float send = up ? p[e] : p[e + 16]; const float keep = up ? p[e + 16] : p[e]; p[e] = keep + __shfl_xor(send, 32); }
#pragma unroll
    for (int e = 0; e < 8; ++e) { const bool up = (lane & 16) != 0; const float send = up ? p[e] : p[e + 8]; const float keep = up ? p[e + 8] : p[e]; p[e] = keep + __shfl_xor(send, 16); }
#pragma unroll
    for (int e = 0; e < 4; ++e) { const bool up = (lane & 8) != 0; const float send = up ? p[e] : p[e + 4]; const float keep = up ? p[e + 4] : p[e]; p[e] = keep + __shfl_xor(send, 8); }
#pragma unroll
    for (int e = 0; e < 2; ++e) { const bool up = (lane & 4) != 0; const float send = up ? p[e] : p[e + 2]; const float keep = up ? p[e + 2] : p[e]; p[e] = keep + __shfl_xor(send, 4); }
    { const bool up = (lane & 2) != 0; const float send = up ? p[0] : p[1]; const float keep = up ? p[1] : p[0]; p[0] = keep + __shfl_xor(send, 2); }
    const float logit = p[0] + __shfl_xor(p[0], 1) + brt;
    const int my_e = lane >> 1;
    float cur = (lane & 1) ? -INFINITY : logit; int rank = 4; float vmax = 0.f;
#pragma unroll
    for (int r = 0; r < 4; ++r) { const float mx = wave_max(cur); const unsigned long long bal = __ballot(cur == mx); const int win = __ffsll((long long)bal) - 1;
        if (r == 0) vmax = mx;
        if (lane == win) { rank = r; cur = -INFINITY; } }
    const bool selected = rank < 4;
    const float ex = selected ? expf(logit - vmax) : 0.f;
    const float den = wave_sum(ex);
    if (selected) { const int lr = __hip_atomic_fetch_add(hist + my_e, 1, __ATOMIC_RELAXED, __HIP_MEMORY_SCOPE_WORKGROUP); sel_e[lt * 4 + rank] = my_e; sel_g[lt * 4 + rank] = ex / den; sel_r[lt * 4 + rank] = lr; }
}
__device__ __forceinline__ void naive_attn_row(const bf16_t* q, const bf16_t* Kb, const bf16_t* Vb, int pitch, const float* bias, int k0, int k1, bool has_sink, float sinkv, bf16_t* out, int lane) {
    u32x4 qw[8];
#pragma unroll
    for (int j = 0; j < 8; ++j) qw[j] = *(const GAS u32x4*)(q + 8 * j);
    float m = -1e20f, l = 0.f, o = 0.f;
    for (int kb = k0; kb <= k1; kb += 64) {
        const int k = kb + lane; const bool valid = k <= k1; const int kc = valid ? k : k1;
        const bf16_t* kr = Kb + (size_t)kc * pitch;
        float s = 0.f;
#pragma unroll
        for (int j = 0; j < 8; ++j) { const u32x4 kw = *(const GAS u32x4*)(kr + 8 * j);
            s += bflo(qw[j].x) * bflo(kw.x) + bfhi(qw[j].x) * bfhi(kw.x) + bflo(qw[j].y) * bflo(kw.y) + bfhi(qw[j].y) * bfhi(kw.y)
               + bflo(qw[j].z) * bflo(kw.z) + bfhi(qw[j].z) * bfhi(kw.z) + bflo(qw[j].w) * bflo(kw.w) + bfhi(qw[j].w) * bfhi(kw.w); }
        s = valid ? s - bias[kc] : -BIGB;
        const float mn = fmaxf(m, wave_max(s));
        const float alpha = __builtin_amdgcn_exp2f(m - mn);
        const float p = __builtin_amdgcn_exp2f(s - mn);
        l = l * alpha + wave_sum(p); o *= alpha; m = mn;
        const int nk = (k1 - kb + 1 < 64) ? (k1 - kb + 1) : 64;
        for (int j = 0; j < nk; ++j) { const float pj = __shfl(p, j); o += pj * bf2f(Vb[(size_t)(kb + j) * pitch + lane]); }
    }
    if (has_sink) l += __builtin_amdgcn_exp2f(sinkv - m);
    out[lane] = (bf16_t)f2bf(o / l);
}

#define in_x     (args.in[0])
#define meta     (args.in[1])
#define g1       (args.in[2])
#define w_in     (args.in[3])
#define b_forget (args.in[4])
#define gfq      (args.in[5])
#define gfk      (args.in[6])
#define gsq      (args.in[7])
#define gsk      (args.in[8])
#define sinks    (args.in[9])
#define w_fo     (args.in[10])
#define w_so     (args.in[11])
#define w_out    (args.in[12])
#define g2       (args.in[13])
#define w_router (args.in[14])
#define b_router (args.in[15])
#define w_up     (args.in[16])
#define b_up     (args.in[17])
#define w_down   (args.in[18])
#define b_down   (args.in[19])
#define WIN  ((bf16_t*)(ws + WS_WIN))
#define WFO  ((bf16_t*)(ws + WS_WFO))
#define WSO  ((bf16_t*)(ws + WS_WSO))
#define WOUT ((bf16_t*)(ws + WS_WOUT))
#define WUP  ((unsigned char*)(ws + WS_WUP))
#define WDN  ((unsigned char*)(ws + WS_WDN))
#define XN   ((bf16_t*)(ws + WS_XN))
#define LOGF ((float*)(ws + WS_LOGF))
#define FB   ((float*)(ws + WS_FB))
#define SBIAS ((float*)(ws + WS_SBIAS))
#define FQ   ((bf16_t*)(ws + WS_FQ))
#define FK   ((bf16_t*)(ws + WS_FK))
#define FV   ((bf16_t*)(ws + WS_FV))
#define SQ   ((bf16_t*)(ws + WS_SQ))
#define SK   ((bf16_t*)(ws + WS_SK))
#define SV   ((bf16_t*)(ws + WS_SV))
#define GA   ((bf16_t*)(ws + WS_GA))
#define GB   ((bf16_t*)(ws + WS_GB))
#define OA   ((bf16_t*)(ws + WS_OA))
#define OB   ((bf16_t*)(ws + WS_OB))
#define MIX  ((bf16_t*)(ws + WS_MIX))
#define HRES ((bf16_t*)(ws + WS_HRES))
#define H2   ((unsigned char*)(ws + WS_H2))
#define TOKDEST ((int*)(ws + WS_TOKDEST))
#define ROWTOK ((int*)(ws + WS_ROWTOK))
#define ROWW ((float*)(ws + WS_ROWW))
#define ACT  ((unsigned char*)(ws + WS_ACT))
#define YS   ((unsigned char*)(ws + WS_YS))
__global__ void __launch_bounds__(NWAVES * 64, 2) hybrid_fwd(Args args) {
    extern __shared__ __attribute__((aligned(16))) unsigned char lds_raw[];
    Frame F;
    F.lds = (LAS unsigned char*)lds_raw;
    F.MISC = (volatile LAS unsigned*)(F.lds + MISC_OFF);
    F.tid = threadIdx.x; F.lane = F.tid & 63; F.wave = __builtin_amdgcn_readfirstlane(F.tid >> 6);
    F.G = gridDim.x; F.gw = blockIdx.x * NWAVES + F.wave; F.NGW = F.G * NWAVES;
    F.ws = args.ws; F.ctl = (gu32*)(F.ws + WS_CTL);
    unsigned char* ws = args.ws;
    const int tid = F.tid, lane = F.lane, wave = F.wave, gw = F.gw, NGW = F.NGW, c = blockIdx.x, G = F.G;
    for (int u = tid; u < (LDS_BYTES - LDSCTL_OFF) / 4; u += NWAVES * 64) ((LAS unsigned*)(F.lds + LDSCTL_OFF))[u] = 0u;
    __syncthreads();
    XcdBarrier bar = xcd_barrier_post((unsigned*)(F.ctl + CW_BAR), F.MISC + 8);

    LAS int* tab = (LAS int*)(F.lds + TAB_OFF);

#ifndef NO_P0
    {
        LAS float* scr = (LAS float*)(F.lds + RING_OFF + wave * 17664);
        for (int i = gw; i < NB * 112; i += NGW) { const int b = i / 112, r = i % 112, slot = (r < 48) ? r : r + 16;
            GAS u32x4* pk = (GAS u32x4*)(FK + (size_t)(b * LP + slot) * 512) + lane; GAS u32x4* pv = (GAS u32x4*)(FV + (size_t)(b * LP + slot) * 512) + lane;
            *pk = (u32x4){0u, 0u, 0u, 0u}; *pv = (u32x4){0u, 0u, 0u, 0u};
            if (lane < 16) { *((GAS u32x4*)(SK + (size_t)(b * LP + r) * 128) + lane) = (u32x4){0u, 0u, 0u, 0u}; *((GAS u32x4*)(SV + (size_t)(b * LP + r) * 128) + lane) = (u32x4){0u, 0u, 0u, 0u}; } }
        for (int i = gw * 64 + lane; i < 8 * LP; i += NGW * 64) { const int h = i / LP, slot = i % LP; const float slope = exp2f(-(float)(h + 1));
            SBIAS[i] = (slot < 112) ? BIGB : -slope * (float)slot * LOG2E; }
        for (int m = NTOK + NMETA + gw; m < MROWS; m += NGW) { GAS u32x2* o8 = (GAS u32x2*)(XN + (size_t)m * DM) + lane;
#pragma unroll
            for (int j = 0; j < 4; ++j) o8[64 * j] = (u32x2){0u, 0u}; }
        {
            f32x4 wf[16][2];
            {
                LAS f32x4* wfa = (LAS f32x4*)(F.lds + RING_OFF); LAS f32x4* wfb = wfa + 1024;
                for (int r = tid; r < DM; r += NWAVES * 64) { const float* wp = w_in + (size_t)r * INW + 1536; const int ql = (((r >> 8) * 4 + (r & 3)) << 6) + ((r & 255) >> 2);
                    wfa[ql] = *(const GAS f32x4*)wp; wfb[ql] = *(const GAS f32x4*)(wp + 4); }
                __syncthreads();
#pragma unroll
                for (int q = 0; q < 16; ++q) { wf[q][0] = wfa[q * 64 + lane]; wf[q][1] = wfb[q * 64 + lane]; }
                __syncthreads();
            }
            const int NRW = G * 8;
            for (int m0 = c * 8 + wave; m0 < NTOK + NMETA; m0 += 2 * NRW) {
                const int m1 = m0 + NRW; const bool has1 = m1 < NTOK + NMETA; const int mm[2] = {m0, has1 ? m1 : m0};
                f32x4 v[2][4]; float s2[2] = {0.f, 0.f};
#pragma unroll
                for (int r = 0; r < 2; ++r) { const float* xrow = (mm[r] < NTOK) ? in_x + (size_t)mm[r] * DM : meta + (size_t)(mm[r] - NTOK) * DM; const GAS f32x4* xr = (const GAS f32x4*)xrow + lane;
#pragma unroll
                    for (int j = 0; j < 4; ++j) v[r][j] = __builtin_nontemporal_load(xr + 64 * j); }
#pragma unroll
                for (int r = 0; r < 2; ++r)
#pragma unroll
                    for (int j = 0; j < 4; ++j) s2[r] += (v[r][j].x * v[r][j].x + v[r][j].y * v[r][j].y) + (v[r][j].z * v[r][j].z + v[r][j].w * v[r][j].w);
                s2[0] = wave_sum(s2[0]); s2[1] = wave_sum(s2[1]);
                float fl[2][8];
#pragma unroll
                for (int r = 0; r < 2; ++r) { const float rstd = 1.f / sqrtf(s2[r] * (1.f / DM) + RMS_EPS);
#pragma unroll
                    for (int h = 0; h < 8; ++h) fl[r][h] = 0.f;
                    GAS u32x2* o8 = (GAS u32x2*)(XN + (size_t)mm[r] * DM) + lane;
#pragma unroll
                    for (int j = 0; j < 4; ++j) { const f32x4 gg = *((const GAS f32x4*)g1 + lane + 64 * j); v[r][j] = v[r][j] * rstd * gg;
                        if (r == 0 || has1) o8[64 * j] = (u32x2){pk2(v[r][j].x, v[r][j].y), pk2(v[r][j].z, v[r][j].w)};
#pragma unroll
                        for (int cc = 0; cc < 4; ++cc) { const float hv = v[r][j][cc]; const f32x4 w0 = wf[4 * j + cc][0], w1 = wf[4 * j + cc][1];
                            fl[r][0] += hv * w0.x; fl[r][1] += hv * w0.y; fl[r][2] += hv * w0.z; fl[r][3] += hv * w0.w; fl[r][4] += hv * w1.x; fl[r][5] += hv * w1.y; fl[r][6] += hv * w1.z; fl[r][7] += hv * w1.w; } } }
#pragma unroll
                for (int r = 0; r < 2; ++r)
#pragma unroll
                    for (int h = 0; h < 8; ++h) fl[r][h] = wave_sum(fl[r][h]);
#pragma unroll
                for (int r = 0; r < 2; ++r)
                    if (lane < 8 && (r == 0 || has1)) { float z = 0.f;
#pragma unroll
                        for (int h = 0; h < 8; ++h) z = (lane == h) ? fl[r][h] : z;
                        z += b_forget[lane];
                        LOGF[(size_t)mm[r] * 8 + lane] = fminf(z, 0.f) - log1pf(expf(-fabsf(z))); }
            }
        }
        constexpr int I_IN = 16 * (NPHYS / 32), I_FO = 8 * 32, I_SO = 8 * 32, I_OUT = 16 * 32, NITEMS = I_IN + I_FO + I_SO + I_OUT;
        constexpr int I_UP = NE * 8 * 64, I_DN = NE * 8 * 32;
        const int fp8_per_wg = 0, ntask = (NITEMS / 2 + G - 1) / G;
        (void)I_UP; (void)I_DN;
        LAS int* qctr = (LAS int*)(F.lds + MISC_OFF + 132);
        for (;;) {
            int t = 0; if (lane == 0) t = __hip_atomic_fetch_add(qctr, 1, __ATOMIC_RELAXED, __HIP_MEMORY_SCOPE_WORKGROUP);
            t = __builtin_amdgcn_readfirstlane(t);
            if (t >= ntask) break;
            if (t < fp8_per_wg) { const int it = c * fp8_per_wg + t;
                if (it < I_UP) { const int e = it / (8 * 64), q = it % (8 * 64), kb = q / 64, nb = q % 64;
                    const int lcol = ((nb >> 2) & 1) * 1024 + (nb >> 3) * 128 + (nb & 3) * 32;
                    tr8_item(w_up + (size_t)e * DM * 2048, 2048, lcol, kb * 128, WUP + (size_t)e * 2048 * DM, DM, nb * 32, scr, lane); }
                else { const int r = it - I_UP, e = r / (8 * 32), q = r % (8 * 32), kb = q / 32, nb = q % 32;
                    tr8_item(w_down + (size_t)e * DM * DM, DM, nb * 32, kb * 128, WDN + (size_t)e * DM * DM, DM, nb * 32, scr, lane); }
            } else { const int it = 2 * (c + (t - fp8_per_wg) * G); if (it >= NITEMS) continue;
                TrItem ti[2];
#pragma unroll
                for (int q2 = 0; q2 < 2; ++q2) { int r = it + q2; TrItem tt;
                    if (r < I_IN) { const int kb = r / (NPHYS / 32), nb = r % (NPHYS / 32); tt = TrItem{w_in, INW, win_logical_col(nb * 32), kb * 64, WIN, DM, nb * 32}; }
                    else if ((r -= I_IN) < I_FO) { const int kb = r / 32, nb = r % 32; tt = TrItem{w_fo, DM, nb * 32, kb * 64, WFO, 512, nb * 32}; }
                    else if ((r -= I_FO) < I_SO) { const int kb = r / 32, nb = r % 32; tt = TrItem{w_so, DM, nb * 32, kb * 64, WSO, 512, nb * 32}; }
                    else { r -= I_SO; const int kb = r / 32, nb = r % 32; tt = TrItem{w_out, DM, nb * 32, kb * 64, WOUT, DM, nb * 32}; }
                    ti[q2] = tt; }
                f32x4 va[8], vb[8];
                tr_load(ti[0], va, lane); tr_load(ti[1], vb, lane);
                tr_store(ti[0], va, scr, lane); tr_store(ti[1], vb, scr, lane);
            }
        }
    }
#endif
    xcd_barrier(bar);

#ifndef NO_P1
    if (c >= G - 32) {
        const int tid = fresh_tid(), lane = tid & 63;
        const int bh_ = c - (G - 32), b = bh_ >> 3, h = bh_ & 7; LAS float* sc = (LAS float*)(F.lds + RING_OFF);
        float v[9]; float run = 0.f;
#pragma unroll
        for (int j = 0; j < 9; ++j) { const int t = 9 * tid + j; float lf = 0.f;
            if (t < NMETA + SEQ) lf = (t < NMETA) ? LOGF[(size_t)(NTOK + t) * 8 + h] : LOGF[(size_t)(b * SEQ + t - NMETA) * 8 + h];
            run += lf; v[j] = run; }
        sc[tid] = run; __syncthreads();
        if (wave == 0) { float carry = 0.f;
            for (int k = 0; k < 8; ++k) { float xv = sc[k * 64 + lane]; float inc = xv;
#pragma unroll
                for (int o = 1; o < 64; o <<= 1) { const float y = __shfl_up(inc, o); if (lane >= o) inc += y; }
                sc[k * 64 + lane] = carry + inc - xv; carry += __shfl(inc, 63); } }
        __syncthreads();
        const float base = sc[tid]; float* fb = FB + (size_t)(b * 8 + h) * LP;
#pragma unroll
        for (int j = 0; j < 9; ++j) { const int t = 9 * tid + j; if (t < NMETA + SEQ) { const int slot = (t < NMETA) ? 48 + t : 128 + (t - NMETA); fb[slot] = (base + v[j]) * LOG2E; } }
        if (tid < 112) fb[(tid < 48) ? tid : tid + 16] = BIGB;
        __syncthreads();
    }
    {
        SchedIn S{G, c, 0, IN_P1, (const char*)XN, (const char*)WIN};
        EpiIn E{FQ, FK, FV, SQ, SK, SV, GA, GB, gfq, gfk, gsq, gsk};
        pg8::gemm_phase<2 * DM, false, false, EpiIn, SchedIn>(F.lds + RING_OFF, S, E);
    }
    if (c >= G - 32) {
        conv_batch(2 * (c - (G - 32)), w_up, w_down, WUP, WDN, F.lds + RING_OFF);
        conv_batch(2 * (c - (G - 32)) + 1, w_up, w_down, WUP, WDN, F.lds + RING_OFF);
    }
#endif
    xcd_barrier(bar);

#ifndef NO_P2
#ifdef NAIVE_ATTN
    for (int T = gw; T < 2 * NTOK * 8; T += NGW) {
        const int which = T / (NTOK * 8), r = T % (NTOK * 8), h = r & 7, tokp = r >> 3;
        const int tok = tokp; const int b = tok >> 12, s = tok & 4095;
        if (which == 0) naive_attn_row(FQ + (size_t)tok * 512 + h * 64, FK + (size_t)b * LP * 512 + h * 64, FV + (size_t)b * LP * 512 + h * 64, 512, FB + (size_t)(b * 8 + h) * LP, 0, 128 + s, false, 0.f, OA + (size_t)tok * 512 + h * 64, lane);
        else { const int p = 128 + s; const float slope = exp2f(-(float)(h + 1));
            naive_attn_row(SQ + (size_t)tok * 512 + h * 64, SK + (size_t)b * LP * 128 + (h >> 2) * 64, SV + (size_t)b * LP * 128 + (h >> 2) * 64, 128, SBIAS + (size_t)h * LP, p - 127, p, true, (sinks[h] + slope * (float)p) * LOG2E, OB + (size_t)tok * 512 + h * 64, lane); }
    }
#else
    {
        {
            SchedIn S{G, c, IN_P1, IN_ALL, (const char*)XN, (const char*)WIN};
            EpiIn E{FQ, FK, FV, SQ, SK, SV, GA, GB, gfq, gfk, gsq, gsk};
            pg8::gemm_phase<2 * DM, false, false, EpiIn, SchedIn>(F.lds + RING_OFF, S, E);
        }
        char* shm = (char*)lds_raw + RING_OFF;
        const int tid = fresh_tid(), lane = tid & 63;
        float gq = fabsf(gfq[lane]), gk = fabsf(gfk[lane]); gq = wave_max(gq); gk = wave_max(gk);
        const float prune_thr = 2.f * (64.f * gq * gk * C2) + 40.f;
        volatile LAS int* qslot = (volatile LAS int*)(F.lds + MISC_OFF + 128);
        int unext = 0;
        if (tid == 0) unext = (int)__hip_atomic_fetch_add((unsigned*)(F.ctl + CW_QUEUE), 1u, __ATOMIC_RELAXED, __HIP_MEMORY_SCOPE_AGENT);
        for (;;) {
            if (tid == 0) *qslot = unext;
            __syncthreads();
            const int uq = __builtin_amdgcn_readfirstlane(*qslot);
            if (uq >= 1024 + NCB_P2) break;
            if (tid == 0) unext = (int)__hip_atomic_fetch_add((unsigned*)(F.ctl + CW_QUEUE), 1u, __ATOMIC_RELAXED, __HIP_MEMORY_SCOPE_AGENT);
            if (uq < 2 * NCB_P2 && (uq & 1)) { conv_batch(NCB_P1 + (uq >> 1), w_up, w_down, WUP, WDN, F.lds + RING_OFF); continue; }
            const int u = (uq < 2 * NCB_P2) ? (uq >> 1) : uq - NCB_P2;
            if (u < 512) {
                const int j = 15 - (u >> 5), b = (u >> 3) & 3, h = u & 7; int NT = 4 * j + 6;
                const float* fb = FB + (size_t)(b * 8 + h) * LP; const int refidx = 128 + 256 * j;
                int ts = 0;
                { const float bref = fb[refidx]; bool c0 = false, c1 = false; const int t0 = lane, t1 = lane + 64;
                  if (t0 >= 2 && t0 <= NT - 7) c0 = (fb[64 * t0 + 63] - bref) >= prune_thr;
                  if (t1 <= NT - 7) c1 = (fb[64 * t1 + 63] - bref) >= prune_thr;
                  const unsigned long long m0 = __ballot(c0), m1 = __ballot(c1);
                  if (m1) ts = 64 + (63 - __builtin_clzll(m1)) + 1; else if (m0) ts = (63 - __builtin_clzll(m0)) + 1;
                  ts &= ~1; ts = __builtin_amdgcn_readfirstlane(ts); }
                NT -= ts;
                attn::attn_unit<512, false, 8>(FQ + (size_t)(b * SEQ + 256 * j) * 512 + h * 64, FK + ((size_t)b * LP + 64 * ts) * 512 + h * 64, FV + ((size_t)b * LP + 64 * ts) * 512 + h * 64,
                                               OA + (size_t)(b * SEQ + 256 * j) * 512 + h * 64, NT, fb + 64 * ts, refidx - 64 * ts, 0.f, 0.f, shm);
            } else {
                const int w = u - 512, b = w >> 7, h = (w >> 4) & 7, j = w & 15, g = h >> 2; const float slope = exp2f(-(float)(h + 1));
                attn::attn_unit<128, true, 8>(SQ + (size_t)(b * SEQ + 256 * j) * 512 + h * 64, SK + ((size_t)b * LP + 256 * j) * 128 + g * 64, SV + ((size_t)b * LP + 256 * j) * 128 + g * 64,
                                              OB + (size_t)(b * SEQ + 256 * j) * 512 + h * 64, 6, SBIAS + (size_t)h * LP + 256 * j, 128, sinks[h] * LOG2E, slope * LOG2E, shm);
            }
        }
    }
#endif
#endif
    xcd_barrier(bar);

#ifndef NO_P3
    {
        SchedMix S{G, c, (const char*)OA, (const char*)OB, (const char*)WFO, (const char*)WSO};
        EpiMix E{MIX, GA, GB};
        pg8::gemm_phase<2 * 512, false, false, EpiMix, SchedMix>(F.lds + RING_OFF, S, E);
    }
#endif
    xcd_barrier(bar);

#ifndef NO_P4
    {
        SchedOut S{G, c, (const char*)MIX, (const char*)WOUT};
        EpiOut E{HRES, in_x};
        pg8::gemm_phase<2 * DM, false, false, EpiOut, SchedOut>(F.lds + RING_OFF, S, E);
    }
#endif
    xcd_barrier(bar);

#if defined(STOP_AFTER) && STOP_AFTER == 4
    for (int tok = gw; tok < NTOK; tok += NGW) {
#pragma unroll
        for (int j = 0; j < 4; ++j) *((GAS f32x4*)(args.out + (size_t)tok * DM) + lane + 64 * j) = *((const GAS f32x4*)(HRES + (size_t)tok * DM) + lane + 64 * j); }
    return;
#endif
#ifndef NO_P5
    {
        const int tid = fresh_tid(), lane = tid & 63;
        LAS float* WRT = (LAS float*)(F.lds + RING_OFF);
        { f32x4 wv_[16];
#pragma unroll
          for (int k = 0; k < 16; ++k) wv_[k] = *((const GAS f32x4*)w_router + tid + 512 * k);
#pragma unroll
          for (int k = 0; k < 16; ++k) { const int i4 = (tid + 512 * k) * 4, d = i4 >> 5, e0 = i4 & 31; WRT[(e0 + 0) * DM + d] = wv_[k].x; WRT[(e0 + 1) * DM + d] = wv_[k].y; WRT[(e0 + 2) * DM + d] = wv_[k].z; WRT[(e0 + 3) * DM + d] = wv_[k].w; } }
        LAS int* hist = tab + 96; LAS int* basee = tab + 128;
        LAS int* sel_e = (LAS int*)(F.lds + ROWS_OFF); LAS float* sel_g = (LAS float*)(F.lds + ROWS_OFF + 1024); LAS int* sel_r = (LAS int*)(F.lds + ROWS_OFF + 2048);
        if (tid < 32) hist[tid] = 0;
        __syncthreads();
        const int ntb = NTOK / G;
        constexpr int NTK = 4;
        for (int lt0 = wave * NTK; lt0 < ntb; lt0 += NWAVES * NTK) {
            f32x4 v[NTK][4]; float s2[NTK];
#pragma unroll
            for (int q = 0; q < NTK; ++q) { const GAS u32x2* hr = (const GAS u32x2*)(HRES + (size_t)(c * ntb + lt0 + q) * DM) + lane;
#pragma unroll
                for (int j = 0; j < 4; ++j) { const u32x2 w = hr[64 * j]; v[q][j] = (f32x4){bflo(w.x), bfhi(w.x), bflo(w.y), bfhi(w.y)}; } }
#pragma unroll
            for (int q = 0; q < NTK; ++q) { float a = 0.f;
#pragma unroll
                for (int j = 0; j < 4; ++j) a += (v[q][j].x * v[q][j].x + v[q][j].y * v[q][j].y) + (v[q][j].z * v[q][j].z + v[q][j].w * v[q][j].w);
                s2[q] = a; }
#pragma unroll
            for (int q = 0; q < NTK; ++q) s2[q] = wave_sum(s2[q]);
#pragma unroll
            for (int q = 0; q < NTK; ++q) { const float rstd = 1.f / sqrtf(s2[q] * (1.f / DM) + RMS_EPS);
                GAS unsigned* o8 = (GAS unsigned*)(H2 + (size_t)(c * ntb + lt0 + q) * DM) + lane;
#pragma unroll
                for (int j = 0; j < 4; ++j) { const f32x4 gg = *((const GAS f32x4*)g2 + lane + 64 * j); v[q][j] = v[q][j] * rstd * gg; const f32x4 qq = __builtin_elementwise_min(__builtin_elementwise_max(v[q][j] * SC_H, (f32x4){-448.f, -448.f, -448.f, -448.f}), (f32x4){448.f, 448.f, 448.f, 448.f}); o8[64 * j] = pk4_fp8(qq.x, qq.y, qq.z, qq.w); } }
            float pe[NTK][32];
            unsigned wb0 = (unsigned)(RING_OFF + 16 * lane), wb1 = wb0 + 65536u; asm volatile("" : "+v"(wb0), "+v"(wb1));
#pragma unroll
            for (int e = 0; e < 32; ++e) { float a[NTK]; _Pragma("unroll") for (int q = 0; q < NTK; ++q) a[q] = 0.f; const unsigned wb = (e < 16) ? wb0 : wb1;
#pragma unroll
                for (int j = 0; j < 4; ++j) { const f32x4 w = *(const LAS f32x4*)(F.lds + wb + ((e & 15) * 4096 + j * 1024));
#pragma unroll
                    for (int q = 0; q < NTK; ++q) a[q] += (v[q][j].x * w.x + v[q][j].y * w.y) + (v[q][j].z * w.z + v[q][j].w * w.w); }
#pragma unroll
                for (int q = 0; q < NTK; ++q) { asm volatile("" : "+v"(a[q])); pe[q][e] = a[q]; } }
            const int my_e = lane >> 1;
            const float brt = b_router[my_e];
            router_finish(pe[0], brt, lane, lt0 + 0, hist, sel_e, sel_g, sel_r);
            if constexpr (NTK > 1) router_finish(pe[1 % NTK], brt, lane, lt0 + 1, hist, sel_e, sel_g, sel_r);
            if constexpr (NTK > 2) { router_finish(pe[2 % NTK], brt, lane, lt0 + 2, hist, sel_e, sel_g, sel_r); router_finish(pe[3 % NTK], brt, lane, lt0 + 3, hist, sel_e, sel_g, sel_r); }
        }
        __syncthreads();
        if (tid < 32) basee[tid] = (int)atomicAdd((unsigned*)(F.ctl + CW_CNT + 64 * tid), (unsigned)hist[tid]);
        __syncthreads();
        for (int i = tid; i < ntb * 4; i += NWAVES * 64) { const int tok = c * ntb + (i >> 2); const int e = sel_e[i]; const int pos = basee[e] + sel_r[i];
            ROWTOK[(size_t)e * ECAP + pos] = tok; ROWW[(size_t)e * ECAP + pos] = sel_g[i]; TOKDEST[(size_t)tok * 4 + (i & 3)] = e * ECAP + pos; }
    }
#endif
    xcd_barrier(bar);

    int T_tiles;
    {
        const int tid = fresh_tid();
        if (tid < 32) tab[tid] = (int)__hip_atomic_load(F.ctl + CW_CNT + 64 * tid, RLX_AGENT);
        __syncthreads();
        if (tid < 64) { const int nt_ = (tid < NE) ? ((tab[tid] + 255) >> 8) : 0; int inc = nt_;
#pragma unroll
            for (int o = 1; o < 32; o <<= 1) { const int y = __shfl_up(inc, o); if ((tid & 63) >= o) inc += y; }
            if (tid < NE) tab[32 + tid] = inc - nt_; if (tid == NE - 1) tab[32 + NE] = inc; }
        __syncthreads();
        T_tiles = tab[32 + NE];
    }
#ifndef NO_P6
    {
        const int tid = fresh_tid();
        LAS int* utab = (LAS int*)(F.lds + UTAB_OFF); moe_units(utab, tab, T_tiles, 8, G, c, tid);
        SchedMoe S{G, c, 8, utab, (const char*)H2, (const char*)WUP, 1, DM};
        for (int i = 0; i < 10; ++i) { pg8::Unit u; if (!S.next(i, u)) break;
            if (tid < 256) { const int e = u.i2, lt0 = (u.i0 - tab[32 + e]) * 256; ((LAS int*)(F.lds + ROWS_OFF + i * 1024))[tid] = (tid < u.i3) ? ROWTOK[(size_t)e * ECAP + lt0 + tid] : 0; } }
        __syncthreads();
        EpiUp E{ACT, b_up};
        pg8::gemm_phase<DM, true, true, EpiUp, SchedMoe>(F.lds + RING_OFF, S, E);
        volatile LAS int* qslot = (volatile LAS int*)(F.lds + MISC_OFF + 128);
        for (;;) {
            if (fresh_tid() == 0) *qslot = (int)__hip_atomic_fetch_add((unsigned*)(F.ctl + CW_QUEUE + 64), 1u, __ATOMIC_RELAXED, __HIP_MEMORY_SCOPE_AGENT);
            __syncthreads();
            const int b6 = __builtin_amdgcn_readfirstlane(*qslot);
            __syncthreads();
            if (b6 >= NCB_P6) break;
            conv_batch(1024 - NCB_P6 + b6, w_up, w_down, WUP, WDN, F.lds + RING_OFF);
        }
    }
#endif
    xcd_barrier(bar);

#ifndef NO_P7
    {
        LAS int* utab = (LAS int*)(F.lds + UTAB_OFF); moe_units(utab, tab, T_tiles, 4, G, c, fresh_tid());
        SchedMoe S{G, c, 4, utab, (const char*)ACT, (const char*)WDN, 0, DM};
        EpiDown E{YS, b_down, ROWW, tab};
        pg8::gemm_phase<DM, true, false, EpiDown, SchedMoe>(F.lds + RING_OFF, S, E);
    }
#endif
    xcd_barrier(bar);

#ifndef NO_P8
    {
        const int lane = fresh_tid() & 63;
        const bool poison = (__hip_atomic_load(F.ctl + CW_BAR + XB_TMO, RLX_AGENT) != 0u) || (T_tiles > MAXTILES);
        for (int tok0 = gw; tok0 < NTOK; tok0 += 2 * NGW) {
            const int tk[2] = {tok0, tok0 + NGW};
            u32x4 y[2][4]; u32x4 hb[2][2];
#pragma unroll
            for (int q = 0; q < 2; ++q) {
#pragma unroll
                for (int k = 0; k < 4; ++k) { const int d = TOKDEST[(size_t)tk[q] * 4 + k]; const int e = d / ECAP, pos = d % ECAP; const int row = tab[32 + e] * 256 + pos;
                    y[q][k] = __builtin_nontemporal_load((const GAS u32x4*)(YS + (size_t)row * DM) + lane); }
#pragma unroll
                for (int j = 0; j < 2; ++j) hb[q][j] = *((const GAS u32x4*)(HRES + (size_t)tk[q] * DM) + 2 * lane + j); }
#pragma unroll
            for (int q = 0; q < 2; ++q)
#pragma unroll
                for (int j = 0; j < 4; ++j) { f32x2 lo = {0.f, 0.f}, hi = {0.f, 0.f};
#pragma unroll
                    for (int k = 0; k < 4; ++k) { const unsigned w = y[q][k][j]; lo += __builtin_amdgcn_cvt_pk_f32_fp8((int)w, false); hi += __builtin_amdgcn_cvt_pk_f32_fp8((int)w, true); }
                    const unsigned h0 = hb[q][j >> 1][2 * (j & 1)], h1 = hb[q][j >> 1][2 * (j & 1) + 1]; f32x4 a = {bflo(h0), bfhi(h0), bflo(h1), bfhi(h1)}; a.x += lo.x * (1.f / SC_Y); a.y += lo.y * (1.f / SC_Y); a.z += hi.x * (1.f / SC_Y); a.w += hi.y * (1.f / SC_Y);
                    if (poison) a = (f32x4){__builtin_nanf(""), __builtin_nanf(""), __builtin_nanf(""), __builtin_nanf("")};
                    __builtin_nontemporal_store(a, (GAS f32x4*)(args.out + (size_t)tk[q] * DM) + 4 * lane + j); }
        }
    }
#endif
}

extern "C" void kernel_launch(void* const* d_in, const int* in_sizes, int n_in, void* d_out, int out_size, void* d_ws, size_t ws_size, hipStream_t stream) {
    static int grid = 0;
    if (grid == 0) {
        if (n_in != 20 || in_sizes[0] != NTOK * DM || out_size != NTOK * DM || ws_size < WS_END) { fprintf(stderr, "kernel_launch: unexpected shapes / workspace (%d inputs, ws %zu)\n", n_in, ws_size); grid = -1; return; }
        int dev = 0, cus = 0, per_cu = 0;
        if (hipGetDevice(&dev) != hipSuccess || hipDeviceGetAttribute(&cus, hipDeviceAttributeMultiprocessorCount, dev) != hipSuccess) { grid = -1; return; }
        if (hipFuncSetAttribute((const void*)hybrid_fwd, hipFuncAttributeMaxDynamicSharedMemorySize, LDS_BYTES) != hipSuccess) { grid = -1; return; }
        if (hipOccupancyMaxActiveBlocksPerMultiprocessor(&per_cu, (const void*)hybrid_fwd, NWAVES * 64, LDS_BYTES) != hipSuccess || per_cu < 1) { fprintf(stderr, "kernel_launch: occupancy query says %d\n", per_cu); }
        (void)hipGetLastError();
        grid = cus;
        if (grid > 256) grid = 256;
    }
    if (grid < 0) return;
    if (hipMemsetAsync((char*)d_ws + WS_CTL, 0, CTL_ZERO_BYTES, stream) != hipSuccess) return;
    Args a{};
    for (int i = 0; i < 20; ++i) a.in[i] = (const float*)d_in[i];
    a.out = (float*)d_out; a.ws = (unsigned char*)d_ws;
    hipLaunchKernelGGL(hybrid_fwd, dim3(grid), dim3(NWAVES * 64), LDS_BYTES, stream, a);
}
```

```cpp
#include <hip/hip_runtime.h>
#include <cstdio>
#include <cstdint>

#define GAS __attribute__((address_space(1)))
#define LAS __attribute__((address_space(3)))
typedef unsigned short bf16_t;
typedef short bf16x8 __attribute__((ext_vector_type(8)));
typedef float f32x4 __attribute__((ext_vector_type(4)));
typedef float f32x2 __attribute__((ext_vector_type(2)));
typedef unsigned u32x4 __attribute__((ext_vector_type(4)));
typedef unsigned u32x2 __attribute__((ext_vector_type(2)));
typedef GAS unsigned gu32;
typedef int i32x4 __attribute__((ext_vector_type(4)));
typedef int i32x8 __attribute__((ext_vector_type(8)));
#define RLX_AGENT __ATOMIC_RELAXED, __HIP_MEMORY_SCOPE_AGENT
#define LDS_WAIT() asm volatile("s_waitcnt lgkmcnt(0)" ::: "memory")
#define VM_WAIT() asm volatile("s_waitcnt vmcnt(0)" ::: "memory")

constexpr int NB = 4, SEQ = 4096, DM = 1024, NTOK = NB * SEQ, NMETA = 16, MROWS = 16640, LP = 4224;
constexpr int HD = 64, NE = 32, INW = 4360, NPHYS = 4352;
constexpr int MAXTILES = 288, MAXROWS = MAXTILES * 256, ECAP = 16384;
constexpr float RMS_EPS = 1e-6f, LOG2E = 1.4426950408889634f, C2 = 0.125f * LOG2E, BIGB = 1e30f;
constexpr int NWAVES = 8;
constexpr float SC_W = 256.f, SC_H = 16.f, SC_A = 4.f, SC_Y = 64.f;

constexpr size_t MiB = 1u << 20;
constexpr size_t WS_CTL = 0, CTL_ZERO_BYTES = 1 * MiB;
constexpr size_t WS_WIN = 2 * MiB, WS_WFO = 11 * MiB, WS_WSO = 12 * MiB, WS_WOUT = 13 * MiB, WS_WUP = 16 * MiB, WS_WDN = 144 * MiB;
constexpr size_t WS_XN = 208 * MiB, WS_LOGF = 241 * MiB, WS_FB = 242 * MiB, WS_SBIAS = 243 * MiB;
constexpr size_t WS_FQ = 244 * MiB, WS_FK = 260 * MiB, WS_FV = 277 * MiB, WS_SQ = 294 * MiB, WS_SK = 310 * MiB, WS_SV = 315 * MiB;
constexpr size_t WS_GA = 320 * MiB, WS_GB = 352 * MiB, WS_OA = 384 * MiB, WS_OB = 400 * MiB, WS_MIX = 416 * MiB, WS_HRES = 448 * MiB, WS_H2 = 512 * MiB;
constexpr size_t WS_TOKDEST = 544 * MiB, WS_ROWTOK = 545 * MiB, WS_ROWW = 547 * MiB, WS_ACT = 550 * MiB, WS_YS = 694 * MiB, WS_END = 838 * MiB;
constexpr int CW_TMO = 0, CW_CODE = 1, CW_BAR = 4096, CW_CNT = 8192, CW_QUEUE = 12288;

constexpr int RING_OFF = 0, RING_BYTES = 131072;
constexpr int ROWS_OFF = RING_BYTES;
constexpr int ROWS_BYTES = 10 * 1024;
constexpr int LDSCTL_OFF = ROWS_OFF + ROWS_BYTES;
constexpr int MISC_OFF = LDSCTL_OFF;
constexpr int TAB_OFF = MISC_OFF + 256;
constexpr int UTAB_OFF = TAB_OFF + 1024;
constexpr int LDS_BYTES = 147456;
static_assert(UTAB_OFF + 256 <= LDS_BYTES, "LDS map");

__device__ __forceinline__ unsigned f2bf(float f) { unsigned u = __builtin_bit_cast(unsigned, f); return (u + 0x7fffu + ((u >> 16) & 1u)) >> 16; }
__device__ __forceinline__ unsigned pk2(float lo, float hi) { return f2bf(lo) | (f2bf(hi) << 16); }
__device__ __forceinline__ float bf2f(unsigned short b) { return __builtin_bit_cast(float, (unsigned)b << 16); }
__device__ __forceinline__ float bflo(unsigned w) { return __builtin_bit_cast(float, w << 16); }
__device__ __forceinline__ float bfhi(unsigned w) { return __builtin_bit_cast(float, w & 0xffff0000u); }
__device__ __forceinline__ float wave_sum(float v) {
#pragma unroll
    for (int o = 1; o < 64; o <<= 1) v += __shfl_xor(v, o);
    return v;
}
__device__ __forceinline__ float wave_max(float v) {
#pragma unroll
    for (int o = 1; o < 64; o <<= 1) v = fmaxf(v, __shfl_xor(v, o));
    return v;
}
__device__ __forceinline__ int fresh_tid() { int t = threadIdx.x; asm volatile("" : "+v"(t)); return t; }
__device__ __forceinline__ unsigned pk4_fp8(float a, float b, float c, float d) { int w = __builtin_amdgcn_cvt_pk_fp8_f32(a, b, 0, false); w = __builtin_amdgcn_cvt_pk_fp8_f32(c, d, w, true); return (unsigned)w; }
__device__ __forceinline__ float sigmoidf_fast(float x) { return __builtin_amdgcn_rcpf(1.f + __builtin_amdgcn_exp2f(-x * LOG2E)); }

namespace pg8 {
constexpr int BM = 256, BK = 64, HALF = 128, HTB = HALF * BK * 2, STAGE_BYTES = 8 * HTB;
__host__ __device__ __forceinline__ int lds_byte(int r, int c) { const int st = (r >> 4) * 2 + (c >> 5), rr = r & 15, cc = c & 31, ob = rr * 64 + cc * 2; return st * 1024 + (ob ^ (((ob >> 9) & 1) << 5)); }
__host__ __device__ __forceinline__ void stage_rc(int b, int& R, int& C) { const int st = b / 1024, sb = b % 1024, swz = sb ^ (((sb >> 9) & 1) << 5); R = (st >> 1) * 16 + swz / 64; C = (st & 1) * 32 + (swz % 64) / 2; }
__host__ __device__ __forceinline__ int perm32(int rho) { const int n = rho >> 4, i = rho & 15; return 8 * (i >> 2) + 4 * n + (i & 3); }

struct Unit { const char* A; const char* B; int rows_lds; int i0, i1, i2, i3; };

template <int PB, bool FP8, bool GATHER, class Epi, class Sched>
__device__ __forceinline__ void gemm_phase(LAS unsigned char* lds, const Sched& S, const Epi& E) {
    int tid_ = threadIdx.x; asm volatile("" : "+v"(tid_));
    const int tid = tid_, wid = __builtin_amdgcn_readfirstlane(tid >> 6), lane = tid & 63, wr = wid >> 2, wc = wid & 3, fr = lane & 15, fq = lane >> 4;
    constexpr int nt = PB / 128;
    int Rs[2], Cs[2]; unsigned voffB[2];
#pragma unroll
    for (int i = 0; i < 2; ++i) { int R, C; stage_rc(tid * 16 + i * 8192, R, C); Rs[i] = R; Cs[i] = C; const int Rb = (R & ~31) + perm32(R & 31); voffB[i] = (unsigned)(Rb * PB + C * 2); }
    constexpr size_t kstep = (size_t)(BK * 2);
    constexpr size_t hstep = (size_t)HALF * PB;
    const unsigned ldsw = (unsigned)wid * 1024u;
    const int aoff = lds_byte(wr * 64 + fr, fq * 8), boff = lds_byte(wc * 32 + fr, fq * 8);
#define PG8_SA(b, h) (((b) * 2 + (h)) * HTB)
#define PG8_SB(b, h) ((4 + (b) * 2 + (h)) * HTB)
#define PG8_STAGE(bufoff, gbase, v0, v1) do { \
        __builtin_amdgcn_global_load_lds((const unsigned*)((const char*)(gbase) + (v0)), (LAS unsigned*)(lds + (bufoff) + ldsw), 16, 0, 0); \
        __builtin_amdgcn_global_load_lds((const unsigned*)((const char*)(gbase) + (v1)), (LAS unsigned*)(lds + (bufoff) + ldsw + 8192), 16, 0, 0); } while (0)
#define PG8_STB(bufoff, gbase) PG8_STAGE(bufoff, gbase, voffB[0], voffB[1])
#define PG8_LDA(dst, b, h) do { _Pragma("unroll") for (int m = 0; m < 4; ++m) _Pragma("unroll") for (int k = 0; k < 2; ++k) dst[m][k] = *(const LAS bf16x8*)(lds + PG8_SA(b, h) + aoff + m * 2048 + k * 1024); } while (0)
#define PG8_LDB(dst, b, h) do { _Pragma("unroll") for (int n = 0; n < 2; ++n) _Pragma("unroll") for (int k = 0; k < 2; ++k) dst[n][k] = *(const LAS bf16x8*)(lds + PG8_SB(b, h) + boff + n * 2048 + k * 1024); } while (0)
#define PG8_CAT(x0, x1) __builtin_shufflevector(__builtin_bit_cast(i32x4, x0), __builtin_bit_cast(i32x4, x1), 0, 1, 2, 3, 4, 5, 6, 7)
#define PG8_MMA(ai, bj, At, Bt) do { __builtin_amdgcn_s_setprio(1); _Pragma("unroll") for (int m = 0; m < 4; ++m) _Pragma("unroll") for (int n = 0; n < 2; ++n) { \
        if constexpr (FP8) { asm volatile("v_mfma_scale_f32_16x16x128_f8f6f4 %0, %1, %2, %0, %3, %3 op_sel_hi:[0,0,0]" : "+v"(acc[ai][bj][m][n]) : "v"(PG8_CAT(Bt[n][0], Bt[n][1])), "v"(PG8_CAT(At[m][0], At[m][1])), "v"(scl)); }   \
        else { _Pragma("unroll") for (int k = 0; k < 2; ++k) acc[ai][bj][m][n] = __builtin_amdgcn_mfma_f32_16x16x32_bf16(Bt[n][k], At[m][k], acc[ai][bj][m][n], 0, 0, 0); } } \
        __builtin_amdgcn_s_setprio(0); } while (0)
#define PG8_WAIT_V(n) asm volatile("s_waitcnt vmcnt(" #n ")" ::: "memory")
#define PG8_WAIT_L(n) asm volatile("s_waitcnt lgkmcnt(" #n ")" ::: "memory")
#define PG8_BAR __builtin_amdgcn_s_barrier()
#define PG8_SCHED __builtin_amdgcn_sched_barrier(0)
#define PG8_SETA(v, u) do { _Pragma("unroll") for (int h = 0; h < 2; ++h) _Pragma("unroll") for (int i = 0; i < 2; ++i) { \
        if constexpr (GATHER) { const int tk = *(const LAS int*)(lds + (u).rows_lds + 4 * (h * HALF + Rs[i])); v[h][i] = (unsigned)(tk * PB + Cs[i] * 2); } \
        else v[h][i] = (unsigned)((h * HALF + Rs[i]) * PB + Cs[i] * 2); } } while (0)
    Unit cur, nxt; int ui = 0; bool relax_prev = false;
    if (!S.next(0, cur)) return;
    int scl = 0x7F7F7F7F; asm volatile("" : "+v"(scl));
    f32x4 acc[2][2][4][2];
#pragma unroll
    for (int a = 0; a < 2; ++a)
#pragma unroll
        for (int b = 0; b < 2; ++b)
#pragma unroll
            for (int m = 0; m < 4; ++m)
#pragma unroll
                for (int n = 0; n < 2; ++n) acc[a][b][m][n] = (f32x4){0.f, 0.f, 0.f, 0.f};
    bf16x8 At[4][2], B0[2][2], B1[2][2];
    unsigned vAc[2][2], vAn[2][2];
    PG8_SETA(vAc, cur);
    if constexpr (GATHER) { PG8_WAIT_L(0); }
    const char* cA = cur.A; const char* cB = cur.B;
    PG8_STB(PG8_SB(0, 0), cB); PG8_STB(PG8_SB(0, 1), cB + hstep); PG8_STAGE(PG8_SA(0, 0), cA, vAc[0][0], vAc[0][1]); PG8_STAGE(PG8_SA(0, 1), cA, vAc[1][0], vAc[1][1]);
    if (wr == 1) PG8_BAR;
    PG8_WAIT_V(2); PG8_BAR;
    PG8_STB(PG8_SB(1, 0), cB + kstep); PG8_STAGE(PG8_SA(1, 0), cA + kstep, vAc[0][0], vAc[0][1]); PG8_STB(PG8_SB(1, 1), cB + hstep + kstep);
    PG8_WAIT_V(6); PG8_BAR;
    for (;;) {
        const bool has_next = S.next(ui + 1, nxt);
        const char* nA = has_next ? nxt.A : cA; const char* nB = has_next ? nxt.B : cB;
        if constexpr (GATHER) { if (has_next) { PG8_SETA(vAn, nxt); } else {
#pragma unroll
            for (int h = 0; h < 2; ++h)
#pragma unroll
                for (int i = 0; i < 2; ++i) vAn[h][i] = vAc[h][i]; } }
#pragma unroll 1
        for (int t = 0; t < nt; t += 2) {
            const bool last = (t == nt - 2);
            const bool first = (t == 0) && (ui > 0), relax = first && relax_prev;
            const char* a1 = cA + (size_t)(t + 1) * kstep;
            const char* a2 = last ? nA : cA + (size_t)(t + 2) * kstep; const char* b2 = last ? nB : cB + (size_t)(t + 2) * kstep;
            const char* a3 = a2 + kstep; const char* b3 = b2 + kstep;
            unsigned w00, w01, w10, w11;
            if constexpr (GATHER) { w00 = last ? vAn[0][0] : vAc[0][0]; w01 = last ? vAn[0][1] : vAc[0][1]; w10 = last ? vAn[1][0] : vAc[1][0]; w11 = last ? vAn[1][1] : vAc[1][1]; }
            else { w00 = vAc[0][0]; w01 = vAc[0][1]; w10 = vAc[1][0]; w11 = vAc[1][1]; }
#define PG8_WAIT_VR() do { if (relax) asm volatile("s_waitcnt vmcnt(%0)" :: "n"(8 + Epi::NS) : "memory"); else PG8_WAIT_V(8); } while (0)
            PG8_LDB(B0, 0, 0); PG8_LDB(B1, 0, 1); PG8_SCHED; PG8_LDA(At, 0, 0); if (!first) PG8_STAGE(PG8_SA(1, 1), a1, vAc[1][0], vAc[1][1]);
            PG8_WAIT_VR(); PG8_WAIT_L(0); PG8_BAR; PG8_MMA(0, 0, At, B0); PG8_MMA(0, 1, At, B1); PG8_BAR; PG8_SCHED;
            PG8_LDA(At, 0, 1); PG8_STB(PG8_SB(0, 0), b2); PG8_STB(PG8_SB(0, 1), b2 + hstep); PG8_STAGE(PG8_SA(0, 0), a2, w00, w01);
            PG8_WAIT_VR(); PG8_WAIT_L(0); PG8_BAR; PG8_MMA(1, 0, At, B0); PG8_MMA(1, 1, At, B1); PG8_BAR; PG8_SCHED;
            PG8_LDB(B0, 1, 0); PG8_LDB(B1, 1, 1); PG8_SCHED; PG8_LDA(At, 1, 0); PG8_STAGE(PG8_SA(0, 1), a2, w10, w11);
            PG8_WAIT_VR(); PG8_WAIT_L(0); PG8_BAR; PG8_MMA(0, 0, At, B0); PG8_MMA(0, 1, At, B1); PG8_BAR; PG8_SCHED;
            PG8_LDA(At, 1, 1); PG8_STB(PG8_SB(1, 0), b3); PG8_STB(PG8_SB(1, 1), b3 + hstep); PG8_STAGE(PG8_SA(1, 0), a3, w00, w01);
            PG8_WAIT_V(8); PG8_WAIT_L(0); PG8_BAR; PG8_MMA(1, 0, At, B0); PG8_MMA(1, 1, At, B1); PG8_BAR; PG8_SCHED;
#undef PG8_WAIT_VR
        }
        if (has_next) { if constexpr (GATHER) PG8_STAGE(PG8_SA(1, 1), nA + kstep, vAn[1][0], vAn[1][1]); else PG8_STAGE(PG8_SA(1, 1), nA + kstep, vAc[1][0], vAc[1][1]); }
        asm volatile("" ::: "memory");
        relax_prev = E.relax_ok(cur);
        if (wr == 0) PG8_BAR;
        if constexpr (FP8) asm volatile("s_nop 15\n\ts_nop 7" ::: "memory");
        E(acc, cur, wr, wc, fr, fq);
        if (!has_next) break;
        if (!E.keep_acc(cur)) {
#pragma unroll
        for (int a = 0; a < 2; ++a)
#pragma unroll
            for (int b = 0; b < 2; ++b)
#pragma unroll
                for (int m = 0; m < 4; ++m)
#pragma unroll
                    for (int n = 0; n < 2; ++n) acc[a][b][m][n] = (f32x4){0.f, 0.f, 0.f, 0.f};
        }
        cur = nxt; cA = nA; cB = nB; ++ui;
        if constexpr (GATHER) {
#pragma unroll
            for (int h = 0; h < 2; ++h)
#pragma unroll
                for (int i = 0; i < 2; ++i) vAc[h][i] = vAn[h][i]; }
        if (wr == 1) PG8_BAR;
    }
    PG8_WAIT_V(0);
    PG8_BAR;
#undef PG8_SA
#undef PG8_SB
#undef PG8_STAGE
#undef PG8_STB
#undef PG8_LDA
#undef PG8_LDB
#undef PG8_MMA
#undef PG8_CAT
#undef PG8_WAIT_V
#undef PG8_WAIT_L
#undef PG8_BAR
#undef PG8_SCHED
#undef PG8_SETA
}
}

namespace attn {
using s16x4 = __attribute__((ext_vector_type(4))) short;
using f32x16 = __attribute__((ext_vector_type(16))) float;
constexpr int NW = 8, QBLK = 32, QB = QBLK * NW, KVBLK = 64, QP = 512;
__device__ __forceinline__ int crow(int r, int hi) { return (r & 3) + 8 * (r >> 2) + 4 * hi; }
#define SBAR() __builtin_amdgcn_sched_barrier(0)
__device__ __forceinline__ void cmask(f32x16& p0, f32x16& p1, int jb, int qrel, int hi) {
  const float NEG = -INFINITY; int kb = 64 * jb + 4 * hi;
  #pragma unroll
  for (int r = 0; r < 16; ++r) { int kv = kb + (r & 3) + 8 * (r >> 2); if (kv > qrel) p0[r] = NEG; if (kv + 32 > qrel) p1[r] = NEG; }
}
__device__ __forceinline__ void wmask(f32x16& p0, f32x16& p1, int t, int qrel, int hi) {
  const float NEG = -INFINITY; int kb = 64 * t + 4 * hi;
  #pragma unroll
  for (int r = 0; r < 16; ++r) { int kv = kb + (r & 3) + 8 * (r >> 2); if (kv <= qrel) p0[r] = NEG; if (kv + 32 <= qrel) p1[r] = NEG; }
}
constexpr int NSLOT = 3, SLOTB = 8192;
constexpr int LDS_K = 0, LDS_V = NSLOT * SLOTB, LDS_WS = 2 * NSLOT * SLOTB, LDS_OST = LDS_WS + NW * 64 * 4, LDS_BIAS = LDS_OST + NW * 4096, LDS_BYTES = LDS_BIAS + LP * 4;
__device__ __forceinline__ void glds16(const void* gsrc, unsigned lds_dst) { unsigned keep;
  asm volatile("s_mov_b32 %0, m0\n\ts_mov_b32 m0, %2\n\ts_nop 0\n\tglobal_load_lds_dwordx4 %1, off\n\ts_mov_b32 m0, %0" : "=&s"(keep) : "v"(gsrc), "s"(lds_dst) : "memory"); }
__device__ __forceinline__ float max3f(float a, float b, float c) { float r; asm("v_max3_f32 %0, %1, %2, %3" : "=v"(r) : "v"(a), "v"(b), "v"(c)); return r; }
__device__ __forceinline__ float max2f(float a, float b) { float r; asm("v_max_f32_e32 %0, %1, %2" : "=v"(r) : "v"(a), "v"(b)); return r; }
__device__ __forceinline__ float fadd_s(float a, float b) { float r; asm("v_add_f32_e32 %0, %1, %2" : "=v"(r) : "v"(a), "v"(b)); return r; }
__device__ __forceinline__ float fsub_s(float a, float b) { float r; asm("v_sub_f32_e32 %0, %1, %2" : "=v"(r) : "v"(a), "v"(b)); return r; }
typedef float f32x2_t __attribute__((ext_vector_type(2))); typedef __bf16 bf16x2_t __attribute__((ext_vector_type(2)));
__device__ __forceinline__ unsigned cvtpk_s(float lo, float hi) { f32x2_t v = {lo, hi}; bf16x2_t b = __builtin_convertvector(v, bf16x2_t); return __builtin_bit_cast(unsigned, b); }
#define WAIT_BAR(N) asm volatile("s_waitcnt vmcnt(" #N ") lgkmcnt(0)\n\ts_barrier" ::: "memory")
typedef __attribute__((address_space(3))) const char* lds_cptr;
typedef short v4i16_t __attribute__((ext_vector_type(4)));
__device__ __forceinline__ void qkt(f32x16& p0, f32x16& p1, lds_cptr Kslot, const bf16x8* qr, int r32, int hi) {
  lds_cptr kb = Kslot + hi * 1024 + r32 * 16;
  #pragma unroll
  for (int d0 = 0; d0 < 4; ++d0) {
    const bf16x8 b0 = *(const LAS bf16x8*)(kb + d0 * 2048);
    const bf16x8 b1 = *(const LAS bf16x8*)(kb + d0 * 2048 + 512);
    p0 = __builtin_amdgcn_mfma_f32_32x32x16_bf16(b0, qr[d0], p0, 0, 0, 0); p1 = __builtin_amdgcn_mfma_f32_32x32x16_bf16(b1, qr[d0], p1, 0, 0, 0); }
}
__device__ __forceinline__ void kload8(bf16x8* kf, lds_cptr kp) {
  kf[0] = *(const LAS bf16x8*)(kp);        kf[1] = *(const LAS bf16x8*)(kp + 512);
  kf[2] = *(const LAS bf16x8*)(kp + 2048); kf[3] = *(const LAS bf16x8*)(kp + 2560);
  kf[4] = *(const LAS bf16x8*)(kp + 4096); kf[5] = *(const LAS bf16x8*)(kp + 4608);
  kf[6] = *(const LAS bf16x8*)(kp + 6144); kf[7] = *(const LAS bf16x8*)(kp + 6656);
}
__device__ __forceinline__ void kload2(bf16x8* kf, lds_cptr kp, int j) { kf[2 * j] = *(const LAS bf16x8*)(kp + j * 2048); kf[2 * j + 1] = *(const LAS bf16x8*)(kp + j * 2048 + 512); }
__device__ __forceinline__ s16x4 vtr(lds_cptr p) { return __builtin_bit_cast(s16x4, __builtin_amdgcn_ds_read_tr16_b64_v4i16((LAS v4i16_t*)p)); }
__device__ __forceinline__ float rowmax(const f32x16& p0, const f32x16& p1) {
  float a = max3f(p0[0], p0[1], p1[0]), b = max3f(p0[2], p0[3], p1[1]); a = max3f(a, p1[2], p1[3]);
  #pragma unroll
  for (int r = 4; r < 16; r += 4) { a = max3f(a, p0[r], p0[r + 1]); b = max3f(b, p0[r + 2], p0[r + 3]); a = max3f(a, p1[r], p1[r + 1]); b = max3f(b, p1[r + 2], p1[r + 3]); }
  const float m = max2f(a, b);
  auto rr = __builtin_amdgcn_permlane32_swap(__float_as_uint(m), __float_as_uint(m), false, false);
  return max2f(__uint_as_float(rr[0]), __uint_as_float(rr[1]));
}
__device__ __forceinline__ void pv(f32x16* o, int vb, bf16x8 pa0, bf16x8 pa1, bf16x8 pa2, bf16x8 pa3) {
  #pragma unroll
  for (int d0 = 0; d0 < 2; ++d0) { s16x4 lo[4], hi[4];
    #pragma unroll
    for (int ks = 0; ks < 4; ++ks) {
      asm volatile("ds_read_b64_tr_b16 %0,%1 offset:%c2" : "=&v"(lo[ks]) : "v"(vb), "i"(d0 * 4096 + ks * 1024) : "memory");
      asm volatile("ds_read_b64_tr_b16 %0,%1 offset:%c2" : "=&v"(hi[ks]) : "v"(vb), "i"(d0 * 4096 + ks * 1024 + 512) : "memory"); }
    asm volatile("s_waitcnt lgkmcnt(0)" ::: "memory"); SBAR();
    #define PK(k) (bf16x8){lo[k][0], lo[k][1], lo[k][2], lo[k][3], hi[k][0], hi[k][1], hi[k][2], hi[k][3]}
    o[d0] = __builtin_amdgcn_mfma_f32_32x32x16_bf16(pa0, PK(0), o[d0], 0, 0, 0);
    o[d0] = __builtin_amdgcn_mfma_f32_32x32x16_bf16(pa1, PK(1), o[d0], 0, 0, 0);
    o[d0] = __builtin_amdgcn_mfma_f32_32x32x16_bf16(pa2, PK(2), o[d0], 0, 0, 0);
    o[d0] = __builtin_amdgcn_mfma_f32_32x32x16_bf16(pa3, PK(3), o[d0], 0, 0, 0);
    #undef PK
  }
}
template <int KP, bool SWA, int THRL>
__device__ __forceinline__ void attn_unit(const bf16_t* Qu, const bf16_t* __restrict__ Kh, const bf16_t* __restrict__ Vh, bf16_t* Ou, const int NT, const float* biasg, const int refidx, const float sink0, const float sinkstep, char* shm) {
  int tid_ = threadIdx.x; asm volatile("" : "+v"(tid_));
  const int tid = tid_, lane = tid & 63, r32 = lane & 31, hi = lane >> 5; const int wid = __builtin_amdgcn_readfirstlane(tid >> 6);
  const bf16_t* Qw = Qu + (size_t)(wid * QBLK) * QP;
  const unsigned lds0 = (unsigned)(uintptr_t)shm;
  float* wsf = (float*)(shm + LDS_WS) + wid * 64;
  const bf16_t* ksrc = Kh + (long)lane * KP + wid * 8;
  const bf16_t* vsrc = Vh + (long)(16 * (wid & 3) + (lane >> 2)) * KP + (wid >> 2) * 32 + (lane & 3) * 8;
  const unsigned kdst = lds0 + LDS_K + wid * 1024, vdst = lds0 + LDS_V + wid * 1024;
  #define DMA_K(t, slot) glds16(ksrc + (long)(t) * KVBLK * KP, (unsigned)__builtin_amdgcn_readfirstlane(kdst + (slot)))
  #define DMA_V(t, slot) glds16(vsrc + (long)(t) * KVBLK * KP, (unsigned)__builtin_amdgcn_readfirstlane(vdst + (slot)))
  const int vb0 = (int)(lds0 + LDS_V) + ((lane >> 4) & 1) * 32 + (lane & 3) * 8 + (4 * hi + ((lane & 15) >> 2)) * 64;
  bf16x8 kf[8];
  const lds_cptr shm3 = (lds_cptr)shm; const lds_cptr kp0 = shm3 + LDS_K + hi * 1024 + r32 * 16; const lds_cptr vp0 = shm3 + LDS_V + ((lane >> 4) & 1) * 32 + (lane & 3) * 8 + (4 * hi + ((lane & 15) >> 2)) * 64;
  const lds_cptr bp0 = shm3 + LDS_BIAS + hi * 16;
  const int nb4 = NT * 16; f32x4 bv[3];
  #pragma unroll
  for (int k = 0; k < 3; ++k) { const int idx = tid + 512 * k; bv[k] = (idx < nb4) ? *((const GAS f32x4*)biasg + idx) : (f32x4){0.f, 0.f, 0.f, 0.f}; }
  DMA_K(0, 0); DMA_V(0, 0); DMA_K(1, SLOTB);
  bf16x8 qr[4];
  #pragma unroll
  for (int d0 = 0; d0 < 4; ++d0) qr[d0] = *reinterpret_cast<const bf16x8*>(&Qw[(long)r32 * QP + d0 * 16 + hi * 8]);
  float mhat = 0.f, nmh = 0.f, bref = 0.f, l_reg = 0.f; f32x16 o[2]; o[0] = f32x16{}; o[1] = f32x16{};
  const int qrel = wid * QBLK + r32;
  #define CMASK(P0, P1, t) do { int jb_ = (t) - (NT - 4); if (jb_ >= 0) cmask(P0, P1, jb_, qrel, hi); } while (0)
  #define WMASK(P0, P1, t) do { if constexpr (SWA) { if ((t) < 4) wmask(P0, P1, (t), qrel, hi); } } while (0)
  #define BIASC(C0, C1, t) do { const LAS f32x4* bp_ = (const LAS f32x4*)(bp0 + (t) * 256); \
    _Pragma("unroll") for (int g_ = 0; g_ < 4; ++g_) { const f32x4 x0_ = bp_[2 * g_], x1_ = bp_[8 + 2 * g_]; \
      _Pragma("unroll") for (int c_ = 0; c_ < 4; ++c_) { C0[4 * g_ + c_] = nmh - x0_[c_]; C1[4 * g_ + c_] = nmh - x1_[c_]; } } } while (0)
  bool resc = false;
  #define START(P0, P1) do { const float rm = rowmax(P0, P1); resc = false; \
    { const float dl = (rm > -1e29f) ? rm : 0.f; mhat = fadd_s(mhat, dl); \
      _Pragma("unroll") for (int r = 0; r < 16; ++r) { P0[r] = fsub_s(P0[r], dl); P1[r] = fsub_s(P1[r], dl); } \
      nmh = bref - mhat; } \
    _Pragma("unroll") for (int r = 0; r < 16; ++r) P0[r] = __builtin_amdgcn_exp2f(P0[r]); } while (0)
  #define RESC() do { if (resc) { asm volatile("s_waitcnt lgkmcnt(0)" ::: "memory"); \
      _Pragma("unroll") for (int d_ = 0; d_ < 2; ++d_) _Pragma("unroll") for (int r = 0; r < 16; ++r) o[d_][r] *= wsf[crow(r, hi)]; } } while (0)
  f32x16 pA0, pA1, pB0, pB1;
  int sl_prev = 0, sl_cur = 0, sl_next = SLOTB;
  #define ROT() do { sl_prev = sl_cur; sl_cur = sl_next; sl_next = (sl_next == (NSLOT - 1) * SLOTB) ? 0 : sl_next + SLOTB; } while (0)
  DMA_K(2, 2 * SLOTB);
  #pragma unroll
  for (int k = 0; k < 3; ++k) { const int idx = tid + 512 * k; if (idx < nb4) *((LAS f32x4*)(shm3 + LDS_BIAS) + idx) = bv[k]; }
  WAIT_BAR(3);
  bref = *(const LAS float*)(shm3 + LDS_BIAS + refidx * 4); nmh = bref;
  BIASC(pA0, pA1, 0);
  qkt(pA0, pA1, shm3 + LDS_K, qr, r32, hi); asm volatile("s_nop 15\n\ts_nop 7" : "+v"(pA0), "+v"(pA1)); CMASK(pA0, pA1, 0); WMASK(pA0, pA1, 0);
  START(pA0, pA1);
  _Pragma("unroll") for (int r = 0; r < 16; ++r) pA1[r] = __builtin_amdgcn_exp2f(pA1[r]);
  WAIT_BAR(0);
  DMA_K(3, 0); DMA_V(1, SLOTB);
  ROT();
  kload8(kf, kp0 + sl_cur);
  WAIT_BAR(2);
  s16x4 vlo[8], vhi[8]; u32x4 pw0, pw1, pw2, pw3;
  #define PKW(P, B) cvtpk_s(P[B], P[B + 1])
  #define PAF(k) __builtin_bit_cast(bf16x8, pw##k)
  #define VFR(i) (bf16x8){vlo[i][0], vlo[i][1], vlo[i][2], vlo[i][3], vhi[i][0], vhi[i][1], vhi[i][2], vhi[i][3]}
  #define PIN(x) asm volatile("" : "+v"(x))
  #define MX3(a, b, c) __builtin_fmaxf(__builtin_fmaxf((a), (b)), (c))
  #define GAPA(MF, A0, A1, A2, A3, W0, W1, PW) do { MF; sacc += A0; sacc += A1; sacc += A2; sacc += A3; PIN(sacc); W0; W1; PIN(PW); SBAR(); } while (0)
  #define EX(v) __builtin_amdgcn_exp2f(v)
  #define GAPB(MF, X, B) do { MF; X[B] = EX(X[B]); X[B + 1] = EX(X[B + 1]); X[B + 2] = EX(X[B + 2]); X[B + 3] = EX(X[B + 3]); PIN(X); SBAR(); } while (0)
  #define VRD(i) do { vlo[i] = vtr(vp_ + (((i) >> 2) * 4096 + ((i) & 3) * 1024)); vhi[i] = vtr(vp_ + (((i) >> 2) * 4096 + ((i) & 3) * 1024 + 512)); } while (0)
  #define KRD(G, j) do { if (G) { kload2(kf, kp0 + sl_next, j); SBAR(); } } while (0)
  #define MF32(a, b, c) __builtin_amdgcn_mfma_f32_32x32x16_bf16(a, b, c, 0, 0, 0)
  #define STEP(C0, C1, P0, P1, t, GK, GV, GL) do { SBAR(); \
    BIASC(C0, C1, t); SBAR(); \
    const lds_cptr vp_ = vp0 + sl_prev; \
    VRD(0); SBAR(); float sacc = (P0[0] + P0[1]); \
    GAPA(C0 = MF32(kf[0], qr[0], C0), P0[2], P0[3], P0[4], P0[5],     pw0[0] = PKW(P0, 0), pw0[1] = PKW(P0, 2), pw0); \
    VRD(4); SBAR(); GAPA(C1 = MF32(kf[1], qr[0], C1), P0[6], P0[7], P0[8], P0[9],     pw0[2] = PKW(P0, 4), pw0[3] = PKW(P0, 6), pw0); \
    VRD(1); SBAR(); GAPA(C0 = MF32(kf[2], qr[1], C0), P0[10], P0[11], P0[12], P0[13], pw1[0] = PKW(P0, 8), pw1[1] = PKW(P0, 10), pw1); \
    VRD(5); SBAR(); GAPA(C1 = MF32(kf[3], qr[1], C1), P0[14], P0[15], P1[0], P1[1],   pw1[2] = PKW(P0, 12), pw1[3] = PKW(P0, 14), pw1); \
    VRD(2); SBAR(); GAPA(C0 = MF32(kf[4], qr[2], C0), P1[2], P1[3], P1[4], P1[5],     pw2[0] = PKW(P1, 0), pw2[1] = PKW(P1, 2), pw2); \
    VRD(6); SBAR(); GAPA(C1 = MF32(kf[5], qr[2], C1), P1[6], P1[7], P1[8], P1[9],     pw2[2] = PKW(P1, 4), pw2[3] = PKW(P1, 6), pw2); \
    VRD(3); SBAR(); GAPA(C0 = MF32(kf[6], qr[3], C0), P1[10], P1[11], P1[12], P1[13], pw3[0] = PKW(P1, 8), pw3[1] = PKW(P1, 10), pw3); \
    VRD(7); SBAR(); GAPA(C1 = MF32(kf[7], qr[3], C1), P1[14], P1[15], 0.f, 0.f,       pw3[2] = PKW(P1, 12), pw3[3] = PKW(P1, 14), pw3); \
    l_reg += sacc; \
    if (GK) { DMA_K((t) + 3, sl_cur); } if (GV) { DMA_V((t) + 1, sl_next); } \
    CMASK(C0, C1, t); WMASK(C0, C1, t); \
    { float a = MX3(C0[0], C0[1], C1[0]), b = MX3(C0[2], C0[3], C1[1]); a = MX3(a, C1[2], C1[3]); \
      _Pragma("unroll") for (int r = 4; r < 16; r += 4) { a = MX3(a, C0[r], C0[r + 1]); b = MX3(b, C0[r + 2], C0[r + 3]); a = MX3(a, C1[r], C1[r + 1]); b = MX3(b, C1[r + 2], C1[r + 3]); } \
      float rm = __builtin_fmaxf(a, b); { auto rr = __builtin_amdgcn_permlane32_swap(__float_as_uint(rm), __float_as_uint(rm), false, false); rm = __builtin_fmaxf(__uint_as_float(rr[0]), __uint_as_float(rr[1])); } \
      resc = false; \
      if (__builtin_expect(__any(rm > (float)THRL), 0)) { const float dl = __builtin_fmaxf(rm, 0.f); mhat += dl; \
        _Pragma("unroll") for (int r = 0; r < 16; ++r) { C0[r] -= dl; C1[r] -= dl; } \
        nmh = bref - mhat; \
        const float f = __builtin_amdgcn_exp2f(-dl); l_reg *= f; if (hi == 0) wsf[r32] = f; resc = true; } } \
    SBAR(); \
    GAPB(o[0] = MF32(PAF(0), VFR(0), o[0]), C0, 0); \
    GAPB(o[1] = MF32(PAF(0), VFR(4), o[1]), C0, 4); \
    KRD(GL, 0); GAPB(o[0] = MF32(PAF(1), VFR(1), o[0]), C0, 8); \
    KRD(GL, 1); GAPB(o[1] = MF32(PAF(1), VFR(5), o[1]), C0, 12); \
    KRD(GL, 2); GAPB(o[0] = MF32(PAF(2), VFR(2), o[0]), C1, 0); \
    KRD(GL, 3); GAPB(o[1] = MF32(PAF(2), VFR(6), o[1]), C1, 4); \
    GAPB(o[0] = MF32(PAF(3), VFR(3), o[0]), C1, 8); \
    GAPB(o[1] = MF32(PAF(3), VFR(7), o[1]), C1, 12); \
    } while (0)
  int t = 1;
  #undef CMASK
  #define CMASK(P0, P1, t) do {} while (0)
  for (; t + 5 < NT; t += 2) {
    STEP(pB0, pB1, pA0, pA1, t, true, true, true);     WAIT_BAR(2); RESC(); ROT();
    STEP(pA0, pA1, pB0, pB1, t + 1, true, true, true); WAIT_BAR(2); RESC(); ROT();
  }
  #undef CMASK
  #define CMASK(P0, P1, t) do { int jb_ = (t) - (NT - 4); if (jb_ >= 0) cmask(P0, P1, jb_, qrel, hi); } while (0)
  #define ENDW(tt) do { if ((tt) + 3 < NT) { WAIT_BAR(2); } else if ((tt) + 2 < NT) { WAIT_BAR(1); } else { WAIT_BAR(0); } } while (0)
  for (; t + 1 < NT; t += 2) {
    STEP(pB0, pB1, pA0, pA1, t, (t + 3 < NT), (t + 1 < NT), (t + 1 < NT));         ENDW(t);     RESC(); ROT();
    STEP(pA0, pA1, pB0, pB1, t + 1, (t + 4 < NT), (t + 2 < NT), (t + 2 < NT));     ENDW(t + 1); RESC(); ROT();
  }
  STEP(pB0, pB1, pA0, pA1, NT - 1, false, false, false); RESC();
  { float sacc = pB0[0] + pB0[1]; _Pragma("unroll") for (int r = 2; r < 16; ++r) sacc += pB0[r]; _Pragma("unroll") for (int r = 0; r < 16; ++r) sacc += pB1[r]; l_reg += sacc;
    pw0 = (u32x4){PKW(pB0, 0), PKW(pB0, 2), PKW(pB0, 4), PKW(pB0, 6)}; pw1 = (u32x4){PKW(pB0, 8), PKW(pB0, 10), PKW(pB0, 12), PKW(pB0, 14)}; pw2 = (u32x4){PKW(pB1, 0), PKW(pB1, 2), PKW(pB1, 4), PKW(pB1, 6)}; pw3 = (u32x4){PKW(pB1, 8), PKW(pB1, 10), PKW(pB1, 12), PKW(pB1, 14)};
    SBAR(); pv(o, vb0 + sl_cur, PAF(0), PAF(1), PAF(2), PAF(3)); }
  #undef PKW
  #undef PAF
  #undef VFR
  #undef PIN
  #undef MX3
  #undef GAPA
  #undef GAPB
  #undef EX
  #undef VRD
  #undef KRD
  #undef STEP
  #undef ENDW
  #undef MF32
  { auto rr = __builtin_amdgcn_permlane32_swap(__float_as_uint(l_reg), __float_as_uint(l_reg), false, false); l_reg = __uint_as_float(rr[0]) + __uint_as_float(rr[1]); }
  if constexpr (SWA) l_reg += __builtin_amdgcn_exp2f(sink0 + sinkstep * (float)qrel - mhat);
  if (hi == 0) wsf[32 + r32] = l_reg; asm volatile("s_waitcnt lgkmcnt(0)" ::: "memory");
  float rli[16];
  #pragma unroll
  for (int r = 0; r < 16; ++r) rli[r] = __builtin_amdgcn_rcpf(wsf[32 + crow(r, hi)]);
  bf16_t* Ow = Ou + (size_t)(wid * QBLK) * QP;
  { bf16_t* stg = (bf16_t*)(shm + LDS_OST) + wid * 2048;
    #pragma unroll
    for (int r = 0; r < 16; ++r) { const int orow = crow(r, hi);
      #pragma unroll
      for (int d0 = 0; d0 < 2; ++d0) stg[orow * 64 + d0 * 32 + r32] = (bf16_t)f2bf(o[d0][r] * rli[r]); }
    asm volatile("s_waitcnt lgkmcnt(0)" ::: "memory");
    #pragma unroll
    for (int i = 0; i < 4; ++i) { const int row = i * 8 + (lane >> 3), ch = lane & 7; const u32x4 v = *(const u32x4*)(stg + row * 64 + ch * 8); *(u32x4*)(Ow + (long)row * QP + ch * 8) = v; } }
  asm volatile("s_waitcnt lgkmcnt(0)\n\ts_barrier" ::: "memory");
  #undef DMA_K
  #undef DMA_V
  #undef CMASK
  #undef WMASK
  #undef BIASC
  #undef START
  #undef RESC
  #undef ROT
}
#undef SBAR
#undef WAIT_BAR
}

#define XB_TMO      128
#define XB_XCNT(j)  (256  + 64 * (j))
#define XB_XSUB(j)  (1280 + 64 * (j))
#define XB_XGEN(j)  (2304 + 64 * (j))
#define XB_TOP      3328
#define XB_TOPGEN   3392
#define XCD_BAR_WORDS 3456
#define XB_SPIN_CAP (1u << 18)
__device__ __forceinline__ unsigned xb_ld(unsigned* p)              { return __hip_atomic_load(p, __ATOMIC_RELAXED, __HIP_MEMORY_SCOPE_AGENT); }
__device__ __forceinline__ unsigned xb_add(unsigned* p, unsigned v) { return __hip_atomic_fetch_add(p, v, __ATOMIC_RELAXED, __HIP_MEMORY_SCOPE_AGENT); }
__device__ __forceinline__ unsigned xb_xcc_id() { return (unsigned)__builtin_amdgcn_s_getreg((3 << 11) | 20) & 0xFu; }
#define XB_SPIN(cond, bar) do { unsigned _sp = 0; while (cond) { __builtin_amdgcn_s_sleep(1); \
    if ((++_sp & 255u) == 0u) { if (xb_ld(&(bar)[XB_TMO])) break; if (_sp > XB_SPIN_CAP) { atomicAdd(&(bar)[XB_TMO], 1u); break; } } } } while (0)
struct XcdBarrier { unsigned* bar; unsigned x; volatile LAS unsigned* st; };
__device__ __forceinline__ XcdBarrier xcd_barrier_post(unsigned* bar, volatile LAS unsigned* st) {
    XcdBarrier b; b.bar = bar; b.x = xb_xcc_id(); b.st = st;
    if (threadIdx.x == 0) (void)xb_add(&bar[XB_XCNT(b.x)], 1u);
    return b;
}
__device__ __forceinline__ void xcd_barrier_complete(unsigned* bar, unsigned x, unsigned& nloc, unsigned& nx) {
    const unsigned G = gridDim.x * gridDim.y * gridDim.z;
    unsigned sum, cnt, mine, sp = 0u;
    for (;;) {
        sum = 0u; cnt = 0u; mine = 0u;
#pragma unroll
        for (unsigned j = 0; j < 16; ++j) { const unsigned c = xb_ld(&bar[XB_XCNT(j)]); sum += c; cnt += (c > 0u) ? 1u : 0u; mine = (j == x) ? c : mine; }
        if (sum == G) break;
        __builtin_amdgcn_s_sleep(1);
        if ((++sp & 255u) == 0u) { if (xb_ld(&bar[XB_TMO])) break; if (sp > XB_SPIN_CAP) { atomicAdd(&bar[XB_TMO], 1u); break; } }
    }
    nloc = mine > 0u ? mine : 1u; nx = cnt > 0u ? cnt : 1u;
}
__device__ __forceinline__ void xcd_barrier(const XcdBarrier& b) {
    asm volatile("s_waitcnt vmcnt(0)" ::: "memory");
    __syncthreads();
    if (threadIdx.x == 0) {
        unsigned* bar = b.bar;
        __builtin_amdgcn_s_waitcnt(0);
        unsigned nloc = b.st[0], nx = b.st[1];
        if (nloc == 0u) { xcd_barrier_complete(bar, b.x, nloc, nx); b.st[0] = nloc; b.st[1] = nx; }
        const unsigned old = xb_add(&bar[XB_XSUB(b.x)], 1u);
        const unsigned gen = old / nloc;
        if (old + 1u == (gen + 1u) * nloc) {
            __builtin_amdgcn_fence(__ATOMIC_RELEASE, "agent");
            asm volatile("s_waitcnt vmcnt(0)" ::: "memory");
            const unsigned og = xb_add(&bar[XB_TOP], 1u);
            const unsigned tg = og / nx;
            if (og + 1u == (tg + 1u) * nx) xb_add(&bar[XB_TOPGEN], 1u);
            else XB_SPIN(xb_ld(&bar[XB_TOPGEN]) == tg, bar);
            __builtin_amdgcn_fence(__ATOMIC_ACQUIRE, "agent");
            xb_add(&bar[XB_XGEN(b.x)], 1u);
            asm volatile("s_waitcnt vmcnt(0)" ::: "memory");
        } else {
            XB_SPIN(xb_ld(&bar[XB_XGEN(b.x)]) == gen, bar);
            __builtin_amdgcn_fence(__ATOMIC_ACQUIRE, "agent");
            asm volatile("s_waitcnt vmcnt(0)" ::: "memory");
        }
    }
    __syncthreads();
}

struct Args { const float* in[20]; float* out; unsigned char* ws; };

struct Frame {
    LAS unsigned char* lds; volatile LAS unsigned* MISC; gu32* ctl;
    int tid, lane, wave, G, gw, NGW;
    unsigned char* ws;
};

struct TrItem { const float* W; int ldw, col0, k0; bf16_t* WT; int ldt, row0; };
__device__ __forceinline__ void tr_load(const TrItem& t, f32x4 (&v)[8], int lane) {
    const float* p = t.W + (size_t)(t.k0 + (lane >> 3)) * t.ldw + t.col0 + 4 * (lane & 7);
#pragma unroll
    for (int i = 0; i < 8; ++i) v[i] = __builtin_nontemporal_load((const GAS f32x4*)(p + (size_t)(8 * i) * t.ldw));
}
__device__ __forceinline__ void tr_store(const TrItem& t, const f32x4 (&v)[8], LAS float* scr, int lane) {
    LAS float* w = scr + (lane >> 3) * 33 + 4 * (lane & 7);
#pragma unroll
    for (int i = 0; i < 8; ++i) { w[(8 * i) * 33 + 0] = v[i].x; w[(8 * i) * 33 + 1] = v[i].y; w[(8 * i) * 33 + 2] = v[i].z; w[(8 * i) * 33 + 3] = v[i].w; }
    LDS_WAIT(); asm volatile("" ::: "memory");
    const int c = lane & 7;
#pragma unroll
    for (int j = 0; j < 4; ++j) { const int n = (lane >> 3) + 8 * j; const LAS float* s = scr + (8 * c) * 33 + n;
        u32x4 o; o.x = pk2(s[0 * 33], s[1 * 33]); o.y = pk2(s[2 * 33], s[3 * 33]); o.z = pk2(s[4 * 33], s[5 * 33]); o.w = pk2(s[6 * 33], s[7 * 33]);
        *(GAS u32x4*)(t.WT + (size_t)(t.row0 + n) * t.ldt + t.k0 + 8 * c) = o; }
    LDS_WAIT(); asm volatile("" ::: "memory");
}
__device__ __forceinline__ void tr8_item(const float* W, int ldw, int col0, int k0, unsigned char* WT, int ldt, int row0, LAS float* scr, int lane) {
    const float* p = W + (size_t)(k0 + (lane >> 3)) * ldw + col0 + 4 * (lane & 7);
    f32x4 v[16];
#pragma unroll
    for (int i = 0; i < 16; ++i) v[i] = __builtin_nontemporal_load((const GAS f32x4*)(p + (size_t)(8 * i) * ldw));
    LAS float* w = scr + (lane >> 3) * 33 + 4 * (lane & 7);
#pragma unroll
    for (int i = 0; i < 16; ++i) { w[(8 * i) * 33 + 0] = v[i].x; w[(8 * i) * 33 + 1] = v[i].y; w[(8 * i) * 33 + 2] = v[i].z; w[(8 * i) * 33 + 3] = v[i].w; }
    LDS_WAIT(); asm volatile("" ::: "memory");
    const int c = lane & 7;
#pragma unroll
    for (int j = 0; j < 4; ++j) { const int n = (lane >> 3) + 8 * j; const LAS float* s = scr + (16 * c) * 33 + n;
        u32x4 o; o.x = pk4_fp8(s[0 * 33] * SC_W, s[1 * 33] * SC_W, s[2 * 33] * SC_W, s[3 * 33] * SC_W); o.y = pk4_fp8(s[4 * 33] * SC_W, s[5 * 33] * SC_W, s[6 * 33] * SC_W, s[7 * 33] * SC_W);
        o.z = pk4_fp8(s[8 * 33] * SC_W, s[9 * 33] * SC_W, s[10 * 33] * SC_W, s[11 * 33] * SC_W); o.w = pk4_fp8(s[12 * 33] * SC_W, s[13 * 33] * SC_W, s[14 * 33] * SC_W, s[15 * 33] * SC_W);
        __builtin_nontemporal_store(o, (GAS u32x4*)(WT + (size_t)(row0 + n) * ldt + k0 + 16 * c)); }
    LDS_WAIT(); asm volatile("" ::: "memory");
}
constexpr int NCB_P1 = 64, NCB_P6 = 160, NCB_P2 = 1024 - NCB_P1 - NCB_P6;
__device__ __forceinline__ void conv_batch(int bat, const float* w_up_, const float* w_down_, unsigned char* wup8, unsigned char* wdn8, LAS unsigned char* ring) {
    constexpr int I_UP = NE * 8 * 64; const int t2 = fresh_tid(), lane = t2 & 63, wv = __builtin_amdgcn_readfirstlane(t2 >> 6);
    LAS float* scr = (LAS float*)(ring + wv * 17664);
#pragma unroll 1
    for (int k3 = 0; k3 < 3; ++k3) { const int it = bat * 24 + 8 * k3 + wv;
        if (it < I_UP) { const int e = it / (8 * 64), q = it % (8 * 64), kb = q / 64, nb = q % 64;
            const int lcol = ((nb >> 2) & 1) * 1024 + (nb >> 3) * 128 + (nb & 3) * 32;
            tr8_item(w_up_ + (size_t)e * DM * 2048, 2048, lcol, kb * 128, wup8 + (size_t)e * 2048 * DM, DM, nb * 32, scr, lane); }
        else { const int r = it - I_UP, e = r / (8 * 32), q = r % (8 * 32), kb = q / 32, nb = q % 32;
            tr8_item(w_down_ + (size_t)e * DM * DM, DM, nb * 32, kb * 128, wdn8 + (size_t)e * DM * DM, DM, nb * 32, scr, lane); } }
}
__device__ __forceinline__ int win_logical_col(int p) {
    const int tile = p >> 8, q = p & 255, bj = q >> 7, hh = (q >> 5) & 3;
    if (tile >= 9) { return (q < 128 ? 2312 : 3336 - 128) + (tile - 9) * 128 + q; }
    const int hoff = hh * 64 + bj * 32;
    if (tile < 6) return tile * 256 + hoff;
    if (tile < 8) return 1544 + (tile - 6) * 256 + hoff;
    return 2056 + hoff;
}

struct SchedIn {
    int G, c, lo, hi; const char* A; const char* B;
    __device__ __forceinline__ bool next(int i, pg8::Unit& u) const {
        const int n = lo + i * G + c; int pm, pn;
        if (n >= hi) return false;
        if (n < 5) { pm = 64; pn = (n < 4) ? 2 + n : 8; }
        else { int wgid = n - 5; { const int q = 1088 / 8, xcd = wgid % 8, off = wgid / 8; wgid = xcd * q + off; }
            const int nig = 8 * 17, gid = wgid / nig, fm = gid * 8; pm = fm + ((wgid % nig) % 8); pn = (wgid % nig) / 8; }
        u.A = A + (size_t)pm * 256 * DM * 2; u.B = B + (size_t)pn * 256 * DM * 2; u.rows_lds = 0; u.i0 = pm; u.i1 = pn; u.i2 = 0; u.i3 = 0; return true;
    }
};
constexpr int IN_ALL = 1093, IN_P1 = 992;
struct SchedMix {
    int G, c; const char *OA, *OB, *WF, *WS;
    __device__ __forceinline__ bool next(int i, pg8::Unit& u) const {
        if (i >= 2 || c >= 256) return false;
        int wgid = c; { const int q = 256 / 8, xcd = wgid % 8, off = wgid / 8; wgid = xcd * q + off; }
        const int nig = 8 * 4, gid = wgid / nig, fm = gid * 8, pm = fm + ((wgid % nig) % 8), pn = (wgid % nig) / 8;
        u.A = (i == 0 ? OA : OB) + (size_t)pm * 256 * 512 * 2; u.B = (i == 0 ? WF : WS) + (size_t)pn * 256 * 512 * 2; u.rows_lds = 0; u.i0 = pm; u.i1 = pn; u.i2 = i; u.i3 = 0; return true;
    }
};
struct SchedOut {
    int G, c; const char *A, *B;
    __device__ __forceinline__ bool next(int i, pg8::Unit& u) const {
        if (i >= 1 || c >= 256) return false;
        int wgid = c; { const int q = 256 / 8, xcd = wgid % 8, off = wgid / 8; wgid = xcd * q + off; }
        const int nig = 8 * 4, gid = wgid / nig, fm = gid * 8, pm = fm + ((wgid % nig) % 8), pn = (wgid % nig) / 8;
        u.A = A + (size_t)pm * 256 * DM * 2; u.B = B + (size_t)pn * 256 * DM * 2; u.rows_lds = 0; u.i0 = pm; u.i1 = pn; u.i2 = 0; u.i3 = 0; return true;
    }
};
struct SchedMoe {
    int G, c, NPN; const LAS int* utab; const char* A; const char* B; int gather, pb;
    __device__ __forceinline__ bool next(int i, pg8::Unit& u) const {
        if (i >= 10) return false;
        const i32x4 t = *(const LAS i32x4*)(utab + 4 * i);
        if (__builtin_amdgcn_readfirstlane(t.w) == 0) return false;
        const int tau = __builtin_amdgcn_readfirstlane(t.x), e = __builtin_amdgcn_readfirstlane(t.y), pn = __builtin_amdgcn_readfirstlane(t.w) - 1;
        u.i0 = tau; u.i1 = pn; u.i2 = e; u.i3 = __builtin_amdgcn_readfirstlane(t.z);
        u.rows_lds = ROWS_OFF + i * 1024;
        u.A = gather ? A : A + (size_t)tau * 256 * pb;
        u.B = B + ((size_t)e * (NPN * 256) + (size_t)pn * 256) * pb;
        return true;
    }
};
__device__ __forceinline__ void moe_units(LAS int* utab, const LAS int* tab, int T, int NPN, int G, int c, int tid) {
    if (tid < 10) { const int x = c & 7, k = c >> 3, nx = (G - x + 7) >> 3, t0 = (T * x) >> 3, t1 = (T * (x + 1)) >> 3;
        const int L = t0 * NPN + tid * nx + k; i32x4 t = {0, 0, 0, 0};
        if (L < t1 * NPN) { const int tau = L / NPN; int e = 0;
            for (int j = 1; j < NE; ++j) e += (tab[32 + j] <= tau) ? 1 : 0;
            t = (i32x4){tau, e, tab[e] - (tau - tab[32 + e]) * 256, 1 + L % NPN}; }
        *(LAS i32x4*)(utab + 4 * tid) = t; }
    __syncthreads();
}

struct EpiIn {
    __device__ __forceinline__ bool keep_acc(const pg8::Unit&) const { return false; }
    static constexpr int NS = 16;
    __device__ __forceinline__ bool relax_ok(const pg8::Unit& u) const { return u.i0 < 64; }
    bf16_t *FQ, *FK, *FV, *SQ, *SK, *SV, *GA, *GB; const float *gfq, *gfk, *gsq, *gsk;
    __device__ __forceinline__ void operator()(const f32x4 (&acc)[2][2][4][2], const pg8::Unit& u, int wr, int wc, int fr, int fq) const {
        const int pm = u.i0, pn = u.i1;
        if (pn >= 9) {
            const int colt = (pn - 9) * 128 + wc * 32 + 8 * fq;
#pragma unroll
            for (int ai = 0; ai < 2; ++ai)
#pragma unroll
                for (int m = 0; m < 4; ++m) { const int row = pm * 256 + ai * 128 + wr * 64 + m * 16 + fr; const size_t off = (size_t)row * DM + colt;
                    float ra[8], sb[8];
#pragma unroll
                    for (int i = 0; i < 8; ++i) { const float a_ = sigmoidf_fast(acc[ai][0][m][i >> 2][i & 3]); const float b_ = fmaxf(sigmoidf_fast(acc[ai][1][m][i >> 2][i & 3]), 0x1p-40f); sb[i] = b_; ra[i] = a_ * __builtin_amdgcn_rcpf(b_); }
                    u32x4 w, z; w.x = pk2(ra[0], ra[1]); w.y = pk2(ra[2], ra[3]); w.z = pk2(ra[4], ra[5]); w.w = pk2(ra[6], ra[7]);
                    z.x = pk2(sb[0], sb[1]); z.y = pk2(sb[2], sb[3]); z.z = pk2(sb[4], sb[5]); z.w = pk2(sb[6], sb[7]);
                    *(GAS u32x4*)(GA + off) = w; *(GAS u32x4*)(GB + off) = z; }
            return;
        }
        bf16_t* dst; int pitch, hcol, metaslot; bool kv, donorm; const float* gain; float scale = 1.f;
        if (pn < 2)      { dst = FQ; pitch = 512; hcol = (4 * pn + wc) * 64;       kv = false; donorm = true;  gain = gfq; scale = C2; metaslot = 0; }
        else if (pn < 4) { dst = FK; pitch = 512; hcol = (4 * (pn - 2) + wc) * 64; kv = true;  donorm = true;  gain = gfk; metaslot = 48; }
        else if (pn < 6) { dst = FV; pitch = 512; hcol = (4 * (pn - 4) + wc) * 64; kv = true;  donorm = false; gain = gfk; metaslot = 48; }
        else if (pn < 8) { dst = SQ; pitch = 512; hcol = (4 * (pn - 6) + wc) * 64; kv = false; donorm = true;  gain = gsq; scale = C2; metaslot = 0; }
        else if (wc < 2) { dst = SK; pitch = 128; hcol = wc * 64;                  kv = true;  donorm = true;  gain = gsk; metaslot = 112; }
        else             { dst = SV; pitch = 128; hcol = (wc - 2) * 64;            kv = true;  donorm = false; gain = gsk; metaslot = 112; }
        f32x4 gv[2][2];
#pragma unroll
        for (int bj = 0; bj < 2; ++bj)
#pragma unroll
            for (int n = 0; n < 2; ++n) { const f32x4 gl = *(const GAS f32x4*)(gain + 32 * bj + 8 * fq + 4 * n); gv[bj][n] = gl * (donorm ? scale : 0.f) + (donorm ? 0.f : 1.f); }
#pragma unroll
        for (int ai = 0; ai < 2; ++ai)
#pragma unroll
            for (int m = 0; m < 4; ++m) {
                float ss = 0.f;
#pragma unroll
                for (int bj = 0; bj < 2; ++bj)
#pragma unroll
                    for (int n = 0; n < 2; ++n) { const f32x4 x = acc[ai][bj][m][n]; ss += (x[0] * x[0] + x[1] * x[1]) + (x[2] * x[2] + x[3] * x[3]); }
                ss += __shfl_xor(ss, 16); ss += __shfl_xor(ss, 32);
                const float r = donorm ? __builtin_amdgcn_rsqf(ss * (1.f / 64.f) + RMS_EPS) : 1.f;
                u32x4 w[2];
#pragma unroll
                for (int bj = 0; bj < 2; ++bj) { const f32x4 v0 = acc[ai][bj][m][0] * gv[bj][0] * r, v1 = acc[ai][bj][m][1] * gv[bj][1] * r;
                    w[bj].x = pk2(v0[0], v0[1]); w[bj].y = pk2(v0[2], v0[3]); w[bj].z = pk2(v1[0], v1[1]); w[bj].w = pk2(v1[2], v1[3]); }
                const int lrow = ai * 128 + wr * 64 + m * 16 + fr;
                if (pm < 64) { const int tok = pm * 256 + lrow; const int drow = kv ? (tok >> 12) * LP + 128 + (tok & 4095) : tok;
                    bf16_t* rowp = dst + (size_t)drow * pitch + hcol + 8 * fq;
                    *(GAS u32x4*)(rowp) = w[0]; *(GAS u32x4*)(rowp + 32) = w[1]; }
                else if (lrow < NMETA && kv) {
#pragma unroll
                    for (int b = 0; b < NB; ++b) { bf16_t* rowp = dst + (size_t)(b * LP + metaslot + lrow) * pitch + hcol + 8 * fq;
                        *(GAS u32x4*)(rowp) = w[0]; *(GAS u32x4*)(rowp + 32) = w[1]; } }
            }
    }
};
struct EpiMix {
    static constexpr int NS = 16;
    __device__ __forceinline__ bool relax_ok(const pg8::Unit& u) const { return true; }
    bf16_t* MIX; const bf16_t *GA, *GB;
    __device__ __forceinline__ bool keep_acc(const pg8::Unit& u) const { return u.i2 == 0; }
    __device__ __forceinline__ void operator()(f32x4 (&acc)[2][2][4][2], const pg8::Unit& u, int wr, int wc, int fr, int fq) const {
        const int pm = u.i0, pn = u.i1, part = u.i2; const bf16_t* Gp = part ? GB : GA;
#pragma unroll
        for (int ai = 0; ai < 2; ++ai) {
            u32x4 g[4][2];
#pragma unroll
            for (int m = 0; m < 4; ++m) { const size_t off = (size_t)(pm * 256 + ai * 128 + wr * 64 + m * 16 + fr) * DM + pn * 256 + wc * 32 + 8 * fq;
#pragma unroll
                for (int bj = 0; bj < 2; ++bj) g[m][bj] = *(const GAS u32x4*)(Gp + off + bj * 128); }
#pragma unroll
            for (int m = 0; m < 4; ++m) { const size_t off = (size_t)(pm * 256 + ai * 128 + wr * 64 + m * 16 + fr) * DM + pn * 256 + wc * 32 + 8 * fq;
#pragma unroll
                for (int bj = 0; bj < 2; ++bj) { const u32x4 b_ = g[m][bj]; f32x4& v0 = acc[ai][bj][m][0]; f32x4& v1 = acc[ai][bj][m][1];
                    if (part == 0) {
                        v0[0] *= bflo(b_.x); v0[1] *= bfhi(b_.x); v0[2] *= bflo(b_.y); v0[3] *= bfhi(b_.y); v1[0] *= bflo(b_.z); v1[1] *= bfhi(b_.z); v1[2] *= bflo(b_.w); v1[3] *= bfhi(b_.w);
                    } else {
                        u32x4 w; w.x = pk2(v0[0] * bflo(b_.x), v0[1] * bfhi(b_.x)); w.y = pk2(v0[2] * bflo(b_.y), v0[3] * bfhi(b_.y)); w.z = pk2(v1[0] * bflo(b_.z), v1[1] * bfhi(b_.z)); w.w = pk2(v1[2] * bflo(b_.w), v1[3] * bfhi(b_.w));
                        *(GAS u32x4*)(MIX + off + bj * 128) = w; } } }
        }
    }
};
struct EpiOut {
    __device__ __forceinline__ bool keep_acc(const pg8::Unit&) const { return false; }
    static constexpr int NS = 48;
    __device__ __forceinline__ bool relax_ok(const pg8::Unit& u) const { return true; }
    bf16_t* H; const float* X;
    __device__ __forceinline__ void operator()(const f32x4 (&acc)[2][2][4][2], const pg8::Unit& u, int wr, int wc, int fr, int fq) const {
        const int pm = u.i0, pn = u.i1;
#pragma unroll
        for (int ai = 0; ai < 2; ++ai) {
            f32x4 xv[4][2][2];
#pragma unroll
            for (int m = 0; m < 4; ++m) { const size_t off = (size_t)(pm * 256 + ai * 128 + wr * 64 + m * 16 + fr) * DM + pn * 256 + wc * 32 + 8 * fq;
#pragma unroll
                for (int bj = 0; bj < 2; ++bj)
#pragma unroll
                    for (int n = 0; n < 2; ++n) xv[m][bj][n] = __builtin_nontemporal_load((const GAS f32x4*)(X + off + bj * 128 + 4 * n)); }
#pragma unroll
            for (int m = 0; m < 4; ++m) { const size_t off = (size_t)(pm * 256 + ai * 128 + wr * 64 + m * 16 + fr) * DM + pn * 256 + wc * 32 + 8 * fq;
#pragma unroll
                for (int bj = 0; bj < 2; ++bj) { const f32x4 v0 = xv[m][bj][0] + acc[ai][bj][m][0], v1 = xv[m][bj][1] + acc[ai][bj][m][1];
                    u32x4 w; w.x = pk2(v0[0], v0[1]); w.y = pk2(v0[2], v0[3]); w.z = pk2(v1[0], v1[1]); w.w = pk2(v1[2], v1[3]);
                    *(GAS u32x4*)(H + off + bj * 128) = w; } }
        }
    }
};
__device__ __forceinline__ float swiglu_act(float g, float u) {
    g = fminf(g, 7.f); u = fminf(fmaxf(u, -7.f), 7.f);
    return (u + 1.f) * (g * __builtin_amdgcn_rcpf(1.f + __builtin_amdgcn_exp2f(-1.702f * LOG2E * g)));
}
struct EpiUp {
    __device__ __forceinline__ bool keep_acc(const pg8::Unit&) const { return false; }
    static constexpr int NS = 12;
    __device__ __forceinline__ bool relax_ok(const pg8::Unit& u) const { return true; }
    unsigned char* ACT; const float* bup;
    __device__ __forceinline__ void operator()(const f32x4 (&acc)[2][2][4][2], const pg8::Unit& u, int wr, int wc, int fr, int fq) const {
        const int tau = u.i0, pn = u.i1, e = u.i2; const int gcol = pn * 128 + wc * 32 + 8 * fq; constexpr float us = 1.f / (SC_H * SC_W);
        f32x2 bg[4], bu[4];
#pragma unroll
        for (int n = 0; n < 2; ++n) { const f32x4 g4 = *(const GAS f32x4*)(bup + (size_t)e * 2048 + gcol + 4 * n), u4 = *(const GAS f32x4*)(bup + (size_t)e * 2048 + 1024 + gcol + 4 * n);
            bg[2 * n] = (f32x2){g4.x, g4.y}; bg[2 * n + 1] = (f32x2){g4.z, g4.w}; bu[2 * n] = (f32x2){u4.x, u4.y} * SC_A + SC_A; bu[2 * n + 1] = (f32x2){u4.z, u4.w} * SC_A + SC_A; }
#pragma unroll
        for (int ai = 0; ai < 2; ++ai)
#pragma unroll
            for (int m = 0; m < 4; ++m) { const size_t off = (size_t)(tau * 256 + ai * 128 + wr * 64 + m * 16 + fr) * DM + gcol;
                f32x2 o[4];
#pragma unroll
                for (int p = 0; p < 4; ++p) { const f32x4 ag = acc[ai][0][m][p >> 1], au = acc[ai][1][m][p >> 1];
                    f32x2 g = ((p & 1) ? (f32x2){ag.z, ag.w} : (f32x2){ag.x, ag.y}) * us + bg[p];
                    f32x2 uu = ((p & 1) ? (f32x2){au.z, au.w} : (f32x2){au.x, au.y}) * (us * SC_A) + bu[p];
                    g.x = fminf(g.x, 7.f); g.y = fminf(g.y, 7.f);
                    uu.x = __builtin_amdgcn_fmed3f(uu.x, -6.f * SC_A, 8.f * SC_A); uu.y = __builtin_amdgcn_fmed3f(uu.y, -6.f * SC_A, 8.f * SC_A);
                    const f32x2 t = g * (-1.702f * LOG2E); f32x2 d; d.x = __builtin_amdgcn_exp2f(t.x); d.y = __builtin_amdgcn_exp2f(t.y); d = d + 1.f;
                    f32x2 r; r.x = __builtin_amdgcn_rcpf(d.x); r.y = __builtin_amdgcn_rcpf(d.y);
                    o[p] = uu * (g * r); }
                u32x2 w; w.x = pk4_fp8(o[0].x, o[0].y, o[1].x, o[1].y); w.y = pk4_fp8(o[2].x, o[2].y, o[3].x, o[3].y);
                *(GAS u32x2*)(ACT + off) = w; }
    }
};
struct EpiDown {
    __device__ __forceinline__ bool keep_acc(const pg8::Unit&) const { return false; }
    static constexpr int NS = 20;
    __device__ __forceinline__ bool relax_ok(const pg8::Unit& u) const { return true; }
    unsigned char* YS; const float* bdn; const float* roww; const LAS int* tab;
    __device__ __forceinline__ void operator()(const f32x4 (&acc)[2][2][4][2], const pg8::Unit& u, int wr, int wc, int fr, int fq) const {
        const int tau = u.i0, pn = u.i1, e = u.i2, nvalid = u.i3; const int col = pn * 256 + wc * 32 + 8 * fq; const int lt0 = (tau - tab[32 + e]) * 256;
        f32x4 bv[2][2];
#pragma unroll
        for (int bj = 0; bj < 2; ++bj)
#pragma unroll
            for (int n = 0; n < 2; ++n) bv[bj][n] = *(const GAS f32x4*)(bdn + (size_t)e * DM + col + bj * 128 + 4 * n);
        float wv[8];
#pragma unroll
        for (int q = 0; q < 8; ++q) { const int lrow = (q >> 2) * 128 + wr * 64 + (q & 3) * 16 + fr; const int lr = lrow < nvalid ? lrow : 0; wv[q] = roww[(size_t)e * ECAP + lt0 + lr]; wv[q] = lrow < nvalid ? wv[q] : 0.f; }
#pragma unroll
        for (int ai = 0; ai < 2; ++ai)
#pragma unroll
            for (int m = 0; m < 4; ++m) { const int lrow = ai * 128 + wr * 64 + m * 16 + fr; const size_t off = (size_t)(tau * 256 + lrow) * DM + col;
                const float w = wv[ai * 4 + m];
#pragma unroll
                for (int bj = 0; bj < 2; ++bj) { constexpr float us = 1.f / (SC_A * SC_W); const float ws = w * SC_Y; const f32x4 lim = {448.f, 448.f, 448.f, 448.f};
                    const f32x4 v0 = __builtin_elementwise_min(__builtin_elementwise_max((acc[ai][bj][m][0] * us + bv[bj][0]) * ws, -lim), lim), v1 = __builtin_elementwise_min(__builtin_elementwise_max((acc[ai][bj][m][1] * us + bv[bj][1]) * ws, -lim), lim);
                    u32x2 o; o.x = pk4_fp8(v0[0], v0[1], v0[2], v0[3]); o.y = pk4_fp8(v1[0], v1[1], v1[2], v1[3]);
                    *(GAS u32x2*)(YS + off + bj * 128) = o; } }
    }
};
__device__ __forceinline__ void router_finish(float (&p)[32], float brt, int lane, int lt, LAS int* hist, LAS int* sel_e, LAS float* sel_g, LAS int* sel_r) {
#pragma unroll
    for (int e = 0; e < 16; ++e) { const bool up = (lane & 32) != 0; const float send = up ? p[e] : p[e + 16]; const float keep = up ? p[e + 16] : p[e]; p[e] = keep + __shfl_xor(send, 32); }
#pragma unroll
    for (int e = 0; e < 8; ++e) { const bool up = (lane & 16) != 0; const float send = up ? p[e] : p[e + 8]; const float keep = up ? p[e + 8] : p[e]; p[e] = keep + __shfl_xor(send, 16); }
#pragma unroll
    for (int e = 0; e < 4; ++e) { const bool up = (lane & 8) != 0; const float send = up ? p[e] : p[e + 4]; const float keep = up ? p[e + 4] : p[e]; p[e] = keep + __shfl_xor(send, 8); }
#pragma unroll
    for (int e = 0; e < 2; ++e) { const bool up = (lane & 4) != 0; const float send = up ? p[e] : p[e + 2]; const float keep = up ? p[e + 2] : p[e]; p[e] = keep + __shfl_xor(send, 4); }
    { const bool up = (lane & 2) != 0; const float send = up ? p[0] : p[1]; const float keep = up ? p[1] : p[0]; p[0] = keep + __shfl_xor(send, 2); }
    const float logit = p[0] + __shfl_xor(p[0], 1) + brt;
    const int my_e = lane >> 1;
    float cur = (lane & 1) ? -INFINITY : logit; int rank = 4; float vmax = 0.f;
#pragma unroll
    for (int r = 0; r < 4; ++r) { const float mx = wave_max(cur); const unsigned long long bal = __ballot(cur == mx); const int win = __ffsll((long long)bal) - 1;
        if (r == 0) vmax = mx;
        if (lane == win) { rank = r; cur = -INFINITY; } }
    const bool selected = rank < 4;
    const float ex = selected ? expf(logit - vmax) : 0.f;
    const float den = wave_sum(ex);
    if (selected) { const int lr = __hip_atomic_fetch_add(hist + my_e, 1, __ATOMIC_RELAXED, __HIP_MEMORY_SCOPE_WORKGROUP); sel_e[lt * 4 + rank] = my_e; sel_g[lt * 4 + rank] = ex / den; sel_r[lt * 4 + rank] = lr; }
}
__device__ __forceinline__ void naive_attn_row(const bf16_t* q, const bf16_t* Kb, const bf16_t* Vb, int pitch, const float* bias, int k0, int k1, bool has_sink, float sinkv, bf16_t* out, int lane) {
    u32x4 qw[8];
#pragma unroll
    for (int j = 0; j < 8; ++j) qw[j] = *(const GAS u32x4*)(q + 8 * j);
    float m = -1e20f, l = 0.f, o = 0.f;
    for (int kb = k0; kb <= k1; kb += 64) {
        const int k = kb + lane; const bool valid = k <= k1; const int kc = valid ? k : k1;
        const bf16_t* kr = Kb + (size_t)kc * pitch;
        float s = 0.f;
#pragma unroll
        for (int j = 0; j < 8; ++j) { const u32x4 kw = *(const GAS u32x4*)(kr + 8 * j);
            s += bflo(qw[j].x) * bflo(kw.x) + bfhi(qw[j].x) * bfhi(kw.x) + bflo(qw[j].y) * bflo(kw.y) + bfhi(qw[j].y) * bfhi(kw.y)
               + bflo(qw[j].z) * bflo(kw.z) + bfhi(qw[j].z) * bfhi(kw.z) + bflo(qw[j].w) * bflo(kw.w) + bfhi(qw[j].w) * bfhi(kw.w); }
        s = valid ? s - bias[kc] : -BIGB;
        const float mn = fmaxf(m, wave_max(s));
        const float alpha = __builtin_amdgcn_exp2f(m - mn);
        const float p = __builtin_amdgcn_exp2f(s - mn);
        l = l * alpha + wave_sum(p); o *= alpha; m = mn;
        const int nk = (k1 - kb + 1 < 64) ? (k1 - kb + 1) : 64;
        for (int j = 0; j < nk; ++j) { const float pj = __shfl(p, j); o += pj * bf2f(Vb[(size_t)(kb + j) * pitch + lane]); }
    }
    if (has_sink) l += __builtin_amdgcn_exp2f(sinkv - m);
    out[lane] = (bf16_t)f2bf(o / l);
}

#define in_x     (args.in[0])
#define meta     (args.in[1])
#define g1       (args.in[2])
#define w_in     (args.in[3])
#define b_forget (args.in[4])
#define gfq      (args.in[5])
#define gfk      (args.in[6])
#define gsq      (args.in[7])
#define gsk      (args.in[8])
#define sinks    (args.in[9])
#define w_fo     (args.in[10])
#define w_so     (args.in[11])
#define w_out    (args.in[12])
#define g2       (args.in[13])
#define w_router (args.in[14])
#define b_router (args.in[15])
#define w_up     (args.in[16])
#define b_up     (args.in[17])
#define w_down   (args.in[18])
#define b_down   (args.in[19])
#define WIN  ((bf16_t*)(ws + WS_WIN))
#define WFO  ((bf16_t*)(ws + WS_WFO))
#define WSO  ((bf16_t*)(ws + WS_WSO))
#define WOUT ((bf16_t*)(ws + WS_WOUT))
#define WUP  ((unsigned char*)(ws + WS_WUP))
#define WDN  ((unsigned char*)(ws + WS_WDN))
#define XN   ((bf16_t*)(ws + WS_XN))
#define LOGF ((float*)(ws + WS_LOGF))
#define FB   ((float*)(ws + WS_FB))
#define SBIAS ((float*)(ws + WS_SBIAS))
#define FQ   ((bf16_t*)(ws + WS_FQ))
#define FK   ((bf16_t*)(ws + WS_FK))
#define FV   ((bf16_t*)(ws + WS_FV))
#define SQ   ((bf16_t*)(ws + WS_SQ))
#define SK   ((bf16_t*)(ws + WS_SK))
#define SV   ((bf16_t*)(ws + WS_SV))
#define GA   ((bf16_t*)(ws + WS_GA))
#define GB   ((bf16_t*)(ws + WS_GB))
#define OA   ((bf16_t*)(ws + WS_OA))
#define OB   ((bf16_t*)(ws + WS_OB))
#define MIX  ((bf16_t*)(ws + WS_MIX))
#define HRES ((bf16_t*)(ws + WS_HRES))
#define H2   ((unsigned char*)(ws + WS_H2))
#define TOKDEST ((int*)(ws + WS_TOKDEST))
#define ROWTOK ((int*)(ws + WS_ROWTOK))
#define ROWW ((float*)(ws + WS_ROWW))
#define ACT  ((unsigned char*)(ws + WS_ACT))
#define YS   ((unsigned char*)(ws + WS_YS))
__global__ void __launch_bounds__(NWAVES * 64, 2) hybrid_fwd(Args args) {
    extern __shared__ __attribute__((aligned(16))) unsigned char lds_raw[];
    Frame F;
    F.lds = (LAS unsigned char*)lds_raw;
    F.MISC = (volatile LAS unsigned*)(F.lds + MISC_OFF);
    F.tid = threadIdx.x; F.lane = F.tid & 63; F.wave = __builtin_amdgcn_readfirstlane(F.tid >> 6);
    F.G = gridDim.x; F.gw = blockIdx.x * NWAVES + F.wave; F.NGW = F.G * NWAVES;
    F.ws = args.ws; F.ctl = (gu32*)(F.ws + WS_CTL);
    unsigned char* ws = args.ws;
    const int tid = F.tid, lane = F.lane, wave = F.wave, gw = F.gw, NGW = F.NGW, c = blockIdx.x, G = F.G;
    for (int u = tid; u < (LDS_BYTES - LDSCTL_OFF) / 4; u += NWAVES * 64) ((LAS unsigned*)(F.lds + LDSCTL_OFF))[u] = 0u;
    __syncthreads();
    XcdBarrier bar = xcd_barrier_post((unsigned*)(F.ctl + CW_BAR), F.MISC + 8);

    LAS int* tab = (LAS int*)(F.lds + TAB_OFF);

#ifndef NO_P0
    {
        LAS float* scr = (LAS float*)(F.lds + RING_OFF + wave * 17664);
        for (int i = gw; i < NB * 112; i += NGW) { const int b = i / 112, r = i % 112, slot = (r < 48) ? r : r + 16;
            GAS u32x4* pk = (GAS u32x4*)(FK + (size_t)(b * LP + slot) * 512) + lane; GAS u32x4* pv = (GAS u32x4*)(FV + (size_t)(b * LP + slot) * 512) + lane;
            *pk = (u32x4){0u, 0u, 0u, 0u}; *pv = (u32x4){0u, 0u, 0u, 0u};
            if (lane < 16) { *((GAS u32x4*)(SK + (size_t)(b * LP + r) * 128) + lane) = (u32x4){0u, 0u, 0u, 0u}; *((GAS u32x4*)(SV + (size_t)(b * LP + r) * 128) + lane) = (u32x4){0u, 0u, 0u, 0u}; } }
        for (int i = gw * 64 + lane; i < 8 * LP; i += NGW * 64) { const int h = i / LP, slot = i % LP; const float slope = exp2f(-(float)(h + 1));
            SBIAS[i] = (slot < 112) ? BIGB : -slope * (float)slot * LOG2E; }
        for (int m = NTOK + NMETA + gw; m < MROWS; m += NGW) { GAS u32x2* o8 = (GAS u32x2*)(XN + (size_t)m * DM) + lane;
#pragma unroll
            for (int j = 0; j < 4; ++j) o8[64 * j] = (u32x2){0u, 0u}; }
        {
            f32x4 wf[16][2];
            {
                LAS f32x4* wfa = (LAS f32x4*)(F.lds + RING_OFF); LAS f32x4* wfb = wfa + 1024;
                for (int r = tid; r < DM; r += NWAVES * 64) { const float* wp = w_in + (size_t)r * INW + 1536; const int ql = (((r >> 8) * 4 + (r & 3)) << 6) + ((r & 255) >> 2);
                    wfa[ql] = *(const GAS f32x4*)wp; wfb[ql] = *(const GAS f32x4*)(wp + 4); }
                __syncthreads();
#pragma unroll
                for (int q = 0; q < 16; ++q) { wf[q][0] = wfa[q * 64 + lane]; wf[q][1] = wfb[q * 64 + lane]; }
                __syncthreads();
            }
            const int NRW = G * 8;
            for (int m0 = c * 8 + wave; m0 < NTOK + NMETA; m0 += 2 * NRW) {
                const int m1 = m0 + NRW; const bool has1 = m1 < NTOK + NMETA; const int mm[2] = {m0, has1 ? m1 : m0};
                f32x4 v[2][4]; float s2[2] = {0.f, 0.f};
#pragma unroll
                for (int r = 0; r < 2; ++r) { const float* xrow = (mm[r] < NTOK) ? in_x + (size_t)mm[r] * DM : meta + (size_t)(mm[r] - NTOK) * DM; const GAS f32x4* xr = (const GAS f32x4*)xrow + lane;
#pragma unroll
                    for (int j = 0; j < 4; ++j) v[r][j] = __builtin_nontemporal_load(xr + 64 * j); }
#pragma unroll
                for (int r = 0; r < 2; ++r)
#pragma unroll
                    for (int j = 0; j < 4; ++j) s2[r] += (v[r][j].x * v[r][j].x + v[r][j].y * v[r][j].y) + (v[r][j].z * v[r][j].z + v[r][j].w * v[r][j].w);
                s2[0] = wave_sum(s2[0]); s2[1] = wave_sum(s2[1]);
                float fl[2][8];
#pragma unroll
                for (int r = 0; r < 2; ++r) { const float rstd = 1.f / sqrtf(s2[r] * (1.f / DM) + RMS_EPS);
#pragma unroll
                    for (int h = 0; h < 8; ++h) fl[r][h] = 0.f;
                    GAS u32x2* o8 = (GAS u32x2*)(XN + (size_t)mm[r] * DM) + lane;
#pragma unroll
                    for (int j = 0; j < 4; ++j) { const f32x4 gg = *((const GAS f32x4*)g1 + lane + 64 * j); v[r][j] = v[r][j] * rstd * gg;
                        if (r == 0 || has1) o8[64 * j] = (u32x2){pk2(v[r][j].x, v[r][j].y), pk2(v[r][j].z, v[r][j].w)};
#pragma unroll
                        for (int cc = 0; cc < 4; ++cc) { const float hv = v[r][j][cc]; const f32x4 w0 = wf[4 * j + cc][0], w1 = wf[4 * j + cc][1];
                            fl[r][0] += hv * w0.x; fl[r][1] += hv * w0.y; fl[r][2] += hv * w0.z; fl[r][3] += hv * w0.w; fl[r][4] += hv * w1.x; fl[r][5] += hv * w1.y; fl[r][6] += hv * w1.z; fl[r][7] += hv * w1.w; } } }
#pragma unroll
                for (int r = 0; r < 2; ++r)
#pragma unroll
                    for (int h = 0; h < 8; ++h) fl[r][h] = wave_sum(fl[r][h]);
#pragma unroll
                for (int r = 0; r < 2; ++r)
                    if (lane < 8 && (r == 0 || has1)) { float z = 0.f;
#pragma unroll
                        for (int h = 0; h < 8; ++h) z = (lane == h) ? fl[r][h] : z;
                        z += b_forget[lane];
                        LOGF[(size_t)mm[r] * 8 + lane] = fminf(z, 0.f) - log1pf(expf(-fabsf(z))); }
            }
        }
        constexpr int I_IN = 16 * (NPHYS / 32), I_FO = 8 * 32, I_SO = 8 * 32, I_OUT = 16 * 32, NITEMS = I_IN + I_FO + I_SO + I_OUT;
        constexpr int I_UP = NE * 8 * 64, I_DN = NE * 8 * 32;
        const int fp8_per_wg = 0, ntask = (NITEMS / 2 + G - 1) / G;
        (void)I_UP; (void)I_DN;
        LAS int* qctr = (LAS int*)(F.lds + MISC_OFF + 132);
        for (;;) {
            int t = 0; if (lane == 0) t = __hip_atomic_fetch_add(qctr, 1, __ATOMIC_RELAXED, __HIP_MEMORY_SCOPE_WORKGROUP);
            t = __builtin_amdgcn_readfirstlane(t);
            if (t >= ntask) break;
            if (t < fp8_per_wg) { const int it = c * fp8_per_wg + t;
                if (it < I_UP) { const int e = it / (8 * 64), q = it % (8 * 64), kb = q / 64, nb = q % 64;
                    const int lcol = ((nb >> 2) & 1) * 1024 + (nb >> 3) * 128 + (nb & 3) * 32;
                    tr8_item(w_up + (size_t)e * DM * 2048, 2048, lcol, kb * 128, WUP + (size_t)e * 2048 * DM, DM, nb * 32, scr, lane); }
                else { const int r = it - I_UP, e = r / (8 * 32), q = r % (8 * 32), kb = q / 32, nb = q % 32;
                    tr8_item(w_down + (size_t)e * DM * DM, DM, nb * 32, kb * 128, WDN + (size_t)e * DM * DM, DM, nb * 32, scr, lane); }
            } else { const int it = 2 * (c + (t - fp8_per_wg) * G); if (it >= NITEMS) continue;
                TrItem ti[2];
#pragma unroll
                for (int q2 = 0; q2 < 2; ++q2) { int r = it + q2; TrItem tt;
                    if (r < I_IN) { const int kb = r / (NPHYS / 32), nb = r % (NPHYS / 32); tt = TrItem{w_in, INW, win_logical_col(nb * 32), kb * 64, WIN, DM, nb * 32}; }
                    else if ((r -= I_IN) < I_FO) { const int kb = r / 32, nb = r % 32; tt = TrItem{w_fo, DM, nb * 32, kb * 64, WFO, 512, nb * 32}; }
                    else if ((r -= I_FO) < I_SO) { const int kb = r / 32, nb = r % 32; tt = TrItem{w_so, DM, nb * 32, kb * 64, WSO, 512, nb * 32}; }
                    else { r -= I_SO; const int kb = r / 32, nb = r % 32; tt = TrItem{w_out, DM, nb * 32, kb * 64, WOUT, DM, nb * 32}; }
                    ti[q2] = tt; }
                f32x4 va[8], vb[8];
                tr_load(ti[0], va, lane); tr_load(ti[1], vb, lane);
                tr_store(ti[0], va, scr, lane); tr_store(ti[1], vb, scr, lane);
            }
        }
    }
#endif
    xcd_barrier(bar);

#ifndef NO_P1
    if (c >= G - 32) {
        const int tid = fresh_tid(), lane = tid & 63;
        const int bh_ = c - (G - 32), b = bh_ >> 3, h = bh_ & 7; LAS float* sc = (LAS float*)(F.lds + RING_OFF);
        float v[9]; float run = 0.f;
#pragma unroll
        for (int j = 0; j < 9; ++j) { const int t = 9 * tid + j; float lf = 0.f;
            if (t < NMETA + SEQ) lf = (t < NMETA) ? LOGF[(size_t)(NTOK + t) * 8 + h] : LOGF[(size_t)(b * SEQ + t - NMETA) * 8 + h];
            run += lf; v[j] = run; }
        sc[tid] = run; __syncthreads();
        if (wave == 0) { float carry = 0.f;
            for (int k = 0; k < 8; ++k) { float xv = sc[k * 64 + lane]; float inc = xv;
#pragma unroll
                for (int o = 1; o < 64; o <<= 1) { const float y = __shfl_up(inc, o); if (lane >= o) inc += y; }
                sc[k * 64 + lane] = carry + inc - xv; carry += __shfl(inc, 63); } }
        __syncthreads();
        const float base = sc[tid]; float* fb = FB + (size_t)(b * 8 + h) * LP;
#pragma unroll
        for (int j = 0; j < 9; ++j) { const int t = 9 * tid + j; if (t < NMETA + SEQ) { const int slot = (t < NMETA) ? 48 + t : 128 + (t - NMETA); fb[slot] = (base + v[j]) * LOG2E; } }
        if (tid < 112) fb[(tid < 48) ? tid : tid + 16] = BIGB;
        __syncthreads();
    }
    {
        SchedIn S{G, c, 0, IN_P1, (const char*)XN, (const char*)WIN};
        EpiIn E{FQ, FK, FV, SQ, SK, SV, GA, GB, gfq, gfk, gsq, gsk};
        pg8::gemm_phase<2 * DM, false, false, EpiIn, SchedIn>(F.lds + RING_OFF, S, E);
    }
    if (c >= G - 32) {
        conv_batch(2 * (c - (G - 32)), w_up, w_down, WUP, WDN, F.lds + RING_OFF);
        conv_batch(2 * (c - (G - 32)) + 1, w_up, w_down, WUP, WDN, F.lds + RING_OFF);
    }
#endif
    xcd_barrier(bar);

#ifndef NO_P2
#ifdef NAIVE_ATTN
    for (int T = gw; T < 2 * NTOK * 8; T += NGW) {
        const int which = T / (NTOK * 8), r = T % (NTOK * 8), h = r & 7, tokp = r >> 3;
        const int tok = tokp; const int b = tok >> 12, s = tok & 4095;
        if (which == 0) naive_attn_row(FQ + (size_t)tok * 512 + h * 64, FK + (size_t)b * LP * 512 + h * 64, FV + (size_t)b * LP * 512 + h * 64, 512, FB + (size_t)(b * 8 + h) * LP, 0, 128 + s, false, 0.f, OA + (size_t)tok * 512 + h * 64, lane);
        else { const int p = 128 + s; const float slope = exp2f(-(float)(h + 1));
            naive_attn_row(SQ + (size_t)tok * 512 + h * 64, SK + (size_t)b * LP * 128 + (h >> 2) * 64, SV + (size_t)b * LP * 128 + (h >> 2) * 64, 128, SBIAS + (size_t)h * LP, p - 127, p, true, (sinks[h] + slope * (float)p) * LOG2E, OB + (size_t)tok * 512 + h * 64, lane); }
    }
#else
    {
        {
            SchedIn S{G, c, IN_P1, IN_ALL, (const char*)XN, (const char*)WIN};
            EpiIn E{FQ, FK, FV, SQ, SK, SV, GA, GB, gfq, gfk, gsq, gsk};
            pg8::gemm_phase<2 * DM, false, false, EpiIn, SchedIn>(F.lds + RING_OFF, S, E);
        }
        char* shm = (char*)lds_raw + RING_OFF;
        const int tid = fresh_tid(), lane = tid & 63;
        float gq = fabsf(gfq[lane]), gk = fabsf(gfk[lane]); gq = wave_max(gq); gk = wave_max(gk);
        const float prune_thr = 2.f * (64.f * gq * gk * C2) + 40.f;
        volatile LAS int* qslot = (volatile LAS int*)(F.lds + MISC_OFF + 128);
        int unext = 0;
        if (tid == 0) unext = (int)__hip_atomic_fetch_add((unsigned*)(F.ctl + CW_QUEUE), 1u, __ATOMIC_RELAXED, __HIP_MEMORY_SCOPE_AGENT);
        for (;;) {
            if (tid == 0) *qslot = unext;
            __syncthreads();
            const int uq = __builtin_amdgcn_readfirstlane(*qslot);
            if (uq >= 1024 + NCB_P2) break;
            if (tid == 0) unext = (int)__hip_atomic_fetch_add((unsigned*)(F.ctl + CW_QUEUE), 1u, __ATOMIC_RELAXED, __HIP_MEMORY_SCOPE_AGENT);
            if (uq < 2 * NCB_P2 && (uq & 1)) { conv_batch(NCB_P1 + (uq >> 1), w_up, w_down, WUP, WDN, F.lds + RING_OFF); continue; }
            const int u = (uq < 2 * NCB_P2) ? (uq >> 1) : uq - NCB_P2;
            if (u < 512) {
                const int j = 15 - (u >> 5), b = (u >> 3) & 3, h = u & 7; int NT = 4 * j + 6;
                const float* fb = FB + (size_t)(b * 8 + h) * LP; const int refidx = 128 + 256 * j;
                int ts = 0;
                { const float bref = fb[refidx]; bool c0 = false, c1 = false; const int t0 = lane, t1 = lane + 64;
                  if (t0 >= 2 && t0 <= NT - 7) c0 = (fb[64 * t0 + 63] - bref) >= prune_thr;
                  if (t1 <= NT - 7) c1 = (fb[64 * t1 + 63] - bref) >= prune_thr;
                  const unsigned long long m0 = __ballot(c0), m1 = __ballot(c1);
                  if (m1) ts = 64 + (63 - __builtin_clzll(m1)) + 1; else if (m0) ts = (63 - __builtin_clzll(m0)) + 1;
                  ts &= ~1; ts = __builtin_amdgcn_readfirstlane(ts); }
                NT -= ts;
                attn::attn_unit<512, false, 8>(FQ + (size_t)(b * SEQ + 256 * j) * 512 + h * 64, FK + ((size_t)b * LP + 64 * ts) * 512 + h * 64, FV + ((size_t)b * LP + 64 * ts) * 512 + h * 64,
                                               OA + (size_t)(b * SEQ + 256 * j) * 512 + h * 64, NT, fb + 64 * ts, refidx - 64 * ts, 0.f, 0.f, shm);
            } else {
                const int w = u - 512, b = w >> 7, h = (w >> 4) & 7, j = w & 15, g = h >> 2; const float slope = exp2f(-(float)(h + 1));
                attn::attn_unit<128, true, 8>(SQ + (size_t)(b * SEQ + 256 * j) * 512 + h * 64, SK + ((size_t)b * LP + 256 * j) * 128 + g * 64, SV + ((size_t)b * LP + 256 * j) * 128 + g * 64,
                                              OB + (size_t)(b * SEQ + 256 * j) * 512 + h * 64, 6, SBIAS + (size_t)h * LP + 256 * j, 128, sinks[h] * LOG2E, slope * LOG2E, shm);
            }
        }
    }
#endif
#endif
    xcd_barrier(bar);

#ifndef NO_P3
    {
        SchedMix S{G, c, (const char*)OA, (const char*)OB, (const char*)WFO, (const char*)WSO};
        EpiMix E{MIX, GA, GB};
        pg8::gemm_phase<2 * 512, false, false, EpiMix, SchedMix>(F.lds + RING_OFF, S, E);
    }
#endif
    xcd_barrier(bar);

#ifndef NO_P4
    {
        SchedOut S{G, c, (const char*)MIX, (const char*)WOUT};
        EpiOut E{HRES, in_x};
        pg8::gemm_phase<2 * DM, false, false, EpiOut, SchedOut>(F.lds + RING_OFF, S, E);
    }
#endif
    xcd_barrier(bar);

#if defined(STOP_AFTER) && STOP_AFTER == 4
    for (int tok = gw; tok < NTOK; tok += NGW) {
#pragma unroll
        for (int j = 0; j < 4; ++j) *((GAS f32x4*)(args.out + (size_t)tok * DM) + lane + 64 * j) = *((const GAS f32x4*)(HRES + (size_t)tok * DM) + lane + 64 * j); }
    return;
#endif
#ifndef NO_P5
    {
        const int tid = fresh_tid(), lane = tid & 63;
        LAS float* WRT = (LAS float*)(F.lds + RING_OFF);
        { f32x4 wv_[16];
#pragma unroll
          for (int k = 0; k < 16; ++k) wv_[k] = *((const GAS f32x4*)w_router + tid + 512 * k);
#pragma unroll
          for (int k = 0; k < 16; ++k) { const int i4 = (tid + 512 * k) * 4, d = i4 >> 5, e0 = i4 & 31; WRT[(e0 + 0) * DM + d] = wv_[k].x; WRT[(e0 + 1) * DM + d] = wv_[k].y; WRT[(e0 + 2) * DM + d] = wv_[k].z; WRT[(e0 + 3) * DM + d] = wv_[k].w; } }
        LAS int* hist = tab + 96; LAS int* basee = tab + 128;
        LAS int* sel_e = (LAS int*)(F.lds + ROWS_OFF); LAS float* sel_g = (LAS float*)(F.lds + ROWS_OFF + 1024); LAS int* sel_r = (LAS int*)(F.lds + ROWS_OFF + 2048);
        if (tid < 32) hist[tid] = 0;
        __syncthreads();
        const int ntb = NTOK / G;
        constexpr int NTK = 4;
        for (int lt0 = wave * NTK; lt0 < ntb; lt0 += NWAVES * NTK) {
            f32x4 v[NTK][4]; float s2[NTK];
#pragma unroll
            for (int q = 0; q < NTK; ++q) { const GAS u32x2* hr = (const GAS u32x2*)(HRES + (size_t)(c * ntb + lt0 + q) * DM) + lane;
#pragma unroll
                for (int j = 0; j < 4; ++j) { const u32x2 w = hr[64 * j]; v[q][j] = (f32x4){bflo(w.x), bfhi(w.x), bflo(w.y), bfhi(w.y)}; } }
#pragma unroll
            for (int q = 0; q < NTK; ++q) { float a = 0.f;
#pragma unroll
                for (int j = 0; j < 4; ++j) a += (v[q][j].x * v[q][j].x + v[q][j].y * v[q][j].y) + (v[q][j].z * v[q][j].z + v[q][j].w * v[q][j].w);
                s2[q] = a; }
#pragma unroll
            for (int q = 0; q < NTK; ++q) s2[q] = wave_sum(s2[q]);
#pragma unroll
            for (int q = 0; q < NTK; ++q) { const float rstd = 1.f / sqrtf(s2[q] * (1.f / DM) + RMS_EPS);
                GAS unsigned* o8 = (GAS unsigned*)(H2 + (size_t)(c * ntb + lt0 + q) * DM) + lane;
#pragma unroll
                for (int j = 0; j < 4; ++j) { const f32x4 gg = *((const GAS f32x4*)g2 + lane + 64 * j); v[q][j] = v[q][j] * rstd * gg; const f32x4 qq = __builtin_elementwise_min(__builtin_elementwise_max(v[q][j] * SC_H, (f32x4){-448.f, -448.f, -448.f, -448.f}), (f32x4){448.f, 448.f, 448.f, 448.f}); o8[64 * j] = pk4_fp8(qq.x, qq.y, qq.z, qq.w); } }
            float pe[NTK][32];
            unsigned wb0 = (unsigned)(RING_OFF + 16 * lane), wb1 = wb0 + 65536u; asm volatile("" : "+v"(wb0), "+v"(wb1));
#pragma unroll
            for (int e = 0; e < 32; ++e) { float a[NTK]; _Pragma("unroll") for (int q = 0; q < NTK; ++q) a[q] = 0.f; const unsigned wb = (e < 16) ? wb0 : wb1;
#pragma unroll
                for (int j = 0; j < 4; ++j) { const f32x4 w = *(const LAS f32x4*)(F.lds + wb + ((e & 15) * 4096 + j * 1024));
#pragma unroll
                    for (int q = 0; q < NTK; ++q) a[q] += (v[q][j].x * w.x + v[q][j].y * w.y) + (v[q][j].z * w.z + v[q][j].w * w.w); }
#pragma unroll
                for (int q = 0; q < NTK; ++q) { asm volatile("" : "+v"(a[q])); pe[q][e] = a[q]; } }
            const int my_e = lane >> 1;
            const float brt = b_router[my_e];
            router_finish(pe[0], brt, lane, lt0 + 0, hist, sel_e, sel_g, sel_r);
            if constexpr (NTK > 1) router_finish(pe[1 % NTK], brt, lane, lt0 + 1, hist, sel_e, sel_g, sel_r);
            if constexpr (NTK > 2) { router_finish(pe[2 % NTK], brt, lane, lt0 + 2, hist, sel_e, sel_g, sel_r); router_finish(pe[3 % NTK], brt, lane, lt0 + 3, hist, sel_e, sel_g, sel_r); }
        }
        __syncthreads();
        if (tid < 32) basee[tid] = (int)atomicAdd((unsigned*)(F.ctl + CW_CNT + 64 * tid), (unsigned)hist[tid]);
        __syncthreads();
        for (int i = tid; i < ntb * 4; i += NWAVES * 64) { const int tok = c * ntb + (i >> 2); const int e = sel_e[i]; const int pos = basee[e] + sel_r[i];
            ROWTOK[(size_t)e * ECAP + pos] = tok; ROWW[(size_t)e * ECAP + pos] = sel_g[i]; TOKDEST[(size_t)tok * 4 + (i & 3)] = e * ECAP + pos; }
    }
#endif
    xcd_barrier(bar);

    int T_tiles;
    {
        const int tid = fresh_tid();
        if (tid < 32) tab[tid] = (int)__hip_atomic_load(F.ctl + CW_CNT + 64 * tid, RLX_AGENT);
        __syncthreads();
        if (tid < 64) { const int nt_ = (tid < NE) ? ((tab[tid] + 255) >> 8) : 0; int inc = nt_;
#pragma unroll
            for (int o = 1; o < 32; o <<= 1) { const int y = __shfl_up(inc, o); if ((tid & 63) >= o) inc += y; }
            if (tid < NE) tab[32 + tid] = inc - nt_; if (tid == NE - 1) tab[32 + NE] = inc; }
        __syncthreads();
        T_tiles = tab[32 + NE];
    }
#ifndef NO_P6
    {
        const int tid = fresh_tid();
        LAS int* utab = (LAS int*)(F.lds + UTAB_OFF); moe_units(utab, tab, T_tiles, 8, G, c, tid);
        SchedMoe S{G, c, 8, utab, (const char*)H2, (const char*)WUP, 1, DM};
        for (int i = 0; i < 10; ++i) { pg8::Unit u; if (!S.next(i, u)) break;
            if (tid < 256) { const int e = u.i2, lt0 = (u.i0 - tab[32 + e]) * 256; ((LAS int*)(F.lds + ROWS_OFF + i * 1024))[tid] = (tid < u.i3) ? ROWTOK[(size_t)e * ECAP + lt0 + tid] : 0; } }
        __syncthreads();
        EpiUp E{ACT, b_up};
        pg8::gemm_phase<DM, true, true, EpiUp, SchedMoe>(F.lds + RING_OFF, S, E);
        volatile LAS int* qslot = (volatile LAS int*)(F.lds + MISC_OFF + 128);
        for (;;) {
            if (fresh_tid() == 0) *qslot = (int)__hip_atomic_fetch_add((unsigned*)(F.ctl + CW_QUEUE + 64), 1u, __ATOMIC_RELAXED, __HIP_MEMORY_SCOPE_AGENT);
            __syncthreads();
            const int b6 = __builtin_amdgcn_readfirstlane(*qslot);
            __syncthreads();
            if (b6 >= NCB_P6) break;
            conv_batch(1024 - NCB_P6 + b6, w_up, w_down, WUP, WDN, F.lds + RING_OFF);
        }
    }
#endif
    xcd_barrier(bar);

#ifndef NO_P7
    {
        LAS int* utab = (LAS int*)(F.lds + UTAB_OFF); moe_units(utab, tab, T_tiles, 4, G, c, fresh_tid());
        SchedMoe S{G, c, 4, utab, (const char*)ACT, (const char*)WDN, 0, DM};
        EpiDown E{YS, b_down, ROWW, tab};
        pg8::gemm_phase<DM, true, false, EpiDown, SchedMoe>(F.lds + RING_OFF, S, E);
    }
#endif
    xcd_barrier(bar);

#ifndef NO_P8
    {
        const int lane = fresh_tid() & 63;
        const bool poison = (__hip_atomic_load(F.ctl + CW_BAR + XB_TMO, RLX_AGENT) != 0u) || (T_tiles > MAXTILES);
        for (int tok0 = gw; tok0 < NTOK; tok0 += 2 * NGW) {
            const int tk[2] = {tok0, tok0 + NGW};
            u32x4 y[2][4]; u32x4 hb[2][2];
#pragma unroll
            for (int q = 0; q < 2; ++q) {
#pragma unroll
                for (int k = 0; k < 4; ++k) { const int d = TOKDEST[(size_t)tk[q] * 4 + k]; const int e = d / ECAP, pos = d % ECAP; const int row = tab[32 + e] * 256 + pos;
                    y[q][k] = __builtin_nontemporal_load((const GAS u32x4*)(YS + (size_t)row * DM) + lane); }
#pragma unroll
                for (int j = 0; j < 2; ++j) hb[q][j] = *((const GAS u32x4*)(HRES + (size_t)tk[q] * DM) + 2 * lane + j); }
#pragma unroll
            for (int q = 0; q < 2; ++q)
#pragma unroll
                for (int j = 0; j < 4; ++j) { f32x2 lo = {0.f, 0.f}, hi = {0.f, 0.f};
#pragma unroll
                    for (int k = 0; k < 4; ++k) { const unsigned w = y[q][k][j]; lo += __builtin_amdgcn_cvt_pk_f32_fp8((int)w, false); hi += __builtin_amdgcn_cvt_pk_f32_fp8((int)w, true); }
                    const unsigned h0 = hb[q][j >> 1][2 * (j & 1)], h1 = hb[q][j >> 1][2 * (j & 1) + 1]; f32x4 a = {bflo(h0), bfhi(h0), bflo(h1), bfhi(h1)}; a.x += lo.x * (1.f / SC_Y); a.y += lo.y * (1.f / SC_Y); a.z += hi.x * (1.f / SC_Y); a.w += hi.y * (1.f / SC_Y);
                    if (poison) a = (f32x4){__builtin_nanf(""), __builtin_nanf(""), __builtin_nanf(""), __builtin_nanf("")};
                    __builtin_nontemporal_store(a, (GAS f32x4*)(args.out + (size_t)tk[q] * DM) + 4 * lane + j); }
        }
    }
#endif
}

extern "C" void kernel_launch(void* const* d_in, const int* in_sizes, int n_in, void* d_out, int out_size, void* d_ws, size_t ws_size, hipStream_t stream) {
    static int grid = 0;
    if (grid == 0) {
        if (n_in != 20 || in_sizes[0] != NTOK * DM || out_size != NTOK * DM || ws_size < WS_END) { fprintf(stderr, "kernel_launch: unexpected shapes / workspace (%d inputs, ws %zu)\n", n_in, ws_size); grid = -1; return; }
        int dev = 0, cus = 0, per_cu = 0;
        if (hipGetDevice(&dev) != hipSuccess || hipDeviceGetAttribute(&cus, hipDeviceAttributeMultiprocessorCount, dev) != hipSuccess) { grid = -1; return; }
        if (hipFuncSetAttribute((const void*)hybrid_fwd, hipFuncAttributeMaxDynamicSharedMemorySize, LDS_BYTES) != hipSuccess) { grid = -1; return; }
        if (hipOccupancyMaxActiveBlocksPerMultiprocessor(&per_cu, (const void*)hybrid_fwd, NWAVES * 64, LDS_BYTES) != hipSuccess || per_cu < 1) { fprintf(stderr, "kernel_launch: occupancy query says %d\n", per_cu); }
        (void)hipGetLastError();
        grid = cus;
        if (grid > 256) grid = 256;
    }
    if (grid < 0) return;
    if (hipMemsetAsync((char*)d_ws + WS_CTL, 0, CTL_ZERO_BYTES, stream) != hipSuccess) return;
    Args a{};
    for (int i = 0; i < 20; ++i) a.in[i] = (const float*)d_in[i];
    a.out = (float*)d_out; a.ws = (unsigned char*)d_ws;
    hipLaunchKernelGGL(hybrid_fwd, dim3(grid), dim3(NWAVES * 64), LDS_BYTES, stream, a);
}
```
